# Optimizing an MI355X kernel written in HIP

```python
import math
import jax, jax.numpy as jnp
from jax import lax
import numpy as np

D_MODEL = 1024
BATCH = 8
SEQ = 2048
DEPTH = 1

EPS = 1e-6
CONV_WIDTH = D_MODEL
CONV_K = 3
N_HEADS = 8
HEAD_DIM = 128
N_KV_HEADS = 2
GROUP = N_HEADS // N_KV_HEADS
ATTN_WIDTH = N_HEADS * HEAD_DIM
KV_WIDTH = N_KV_HEADS * HEAD_DIM
IDX_HEADS = 8
IDX_DIM = 64
INDEX_TOPK = 256
Q_BLOCK = 128
ATTN_SCALE = HEAD_DIM ** -0.5
IDX_SCALE = IDX_DIM ** -0.5
IDX_W_SCALE = IDX_HEADS ** -0.5
ROPE_THETA = 500000.0
ROPE_FRACTION = 4
PEER_HEADS = 8
PEER_KEY_DIM = 256
PEER_HALF = PEER_KEY_DIM // 2
N_KEYS = 128
N_EXPERTS = N_KEYS * N_KEYS
PEER_TOPK = 16
TOKEN_BLOCK = 128

COL_SIZES = (
    CONV_WIDTH,
    CONV_WIDTH,
    CONV_WIDTH,
    ATTN_WIDTH,
    KV_WIDTH,
    KV_WIDTH,
    IDX_HEADS * IDX_DIM,
    IDX_DIM,
    IDX_HEADS,
    D_MODEL,
    D_MODEL,
)
IN_COLS = sum(COL_SIZES)
SPLIT_POINTS = [int(c) for c in np.cumsum(COL_SIZES)[:-1]]

kernel_name = "hybrid_shortconv_dsa_peer_block"


def rms_norm(x, g):
    xf = x.astype(jnp.float32)
    y = xf * lax.rsqrt(jnp.mean(xf * xf, axis=-1, keepdims=True) + EPS)
    return (y * g.astype(jnp.float32)).astype(x.dtype)


def partial_rope(x, pos):
    d = x.shape[-1]
    r = d // ROPE_FRACTION
    half = r // 2
    inv_freq = ROPE_THETA ** (-jnp.arange(half, dtype=jnp.float32) / half)
    ang = pos.astype(jnp.float32)[:, None] * inv_freq[None, :]
    cos = jnp.cos(ang)[:, None, :]
    sin = jnp.sin(ang)[:, None, :]
    xf = x.astype(jnp.float32)
    x1, x2, rest = xf[..., :half], xf[..., half:r], xf[..., r:]
    out = jnp.concatenate([x1 * cos - x2 * sin, x2 * cos + x1 * sin, rest], axis=-1)
    return out.astype(x.dtype)


def short_conv_mixer(b_gate, c_gate, xt, conv_w):
    seq = xt.shape[1]
    u = c_gate * xt
    up = jnp.pad(u, ((0, 0), (CONV_K - 1, 0), (0, 0)))
    conv = sum(conv_w[j] * up[:, j:j + seq] for j in range(CONV_K))
    return b_gate * conv


def to_blocks(t, nblk):
    b = t.shape[0]
    t = t.reshape((b, nblk, Q_BLOCK) + t.shape[2:])
    return jnp.moveaxis(t, 1, 0)


def dsa_attention(q, k, v, qi, ki, wi):
    b, seq = q.shape[0], q.shape[1]
    n_keys_visible = seq
    k_sel = min(INDEX_TOPK, n_keys_visible // 4)
    nblk = seq // Q_BLOCK
    key_pos = jnp.arange(n_keys_visible)
    gather = jax.vmap(lambda tb, ib: tb[ib])

    def attend_block(args):
        qb, qib, wib, t0 = args
        tq = t0 + jnp.arange(Q_BLOCK)
        dots = jnp.einsum('bqhd,bsd->bqhs', qib, ki) * IDX_SCALE
        iscore = jnp.einsum('bqh,bqhs->bqs', wib, jax.nn.relu(dots)).astype(jnp.float32)
        causal = key_pos[None, :] <= tq[:, None]
        iscore = jnp.where(causal[None], iscore, -jnp.inf)
        _, sel = lax.top_k(iscore, k_sel)
        valid = sel <= tq[None, :, None]
        ks = gather(k, sel)
        vs = gather(v, sel)
        qg = qb.reshape(b, Q_BLOCK, N_KV_HEADS, GROUP, HEAD_DIM)
        s = jnp.einsum('bqgnd,bqkgd->bqgnk', qg, ks).astype(jnp.float32) * ATTN_SCALE
        s = jnp.where(valid[:, :, None, None, :], s, -jnp.inf)
        p = jax.nn.softmax(s, axis=-1).astype(vs.dtype)
        o = jnp.einsum('bqgnk,bqkgd->bqgnd', p, vs)
        return o.reshape(b, Q_BLOCK, ATTN_WIDTH)

    starts = jnp.arange(nblk) * Q_BLOCK
    out = lax.map(attend_block, (to_blocks(q, nblk), to_blocks(qi, nblk),
                                 to_blocks(wi, nblk), starts))
    return jnp.moveaxis(out, 0, 1).reshape(b, seq, ATTN_WIDTH)


def peer_layer(xn, peer_wq, peer_k1, peer_k2, peer_u, peer_v):
    b, seq, d = xn.shape
    xt = xn.reshape(-1, TOKEN_BLOCK, d)

    def block(xc):
        q = (xc @ peer_wq).reshape(TOKEN_BLOCK, PEER_HEADS, 2, PEER_HALF)
        s1 = jnp.einsum('thd,hnd->thn', q[:, :, 0], peer_k1).astype(jnp.float32)
        s2 = jnp.einsum('thd,hnd->thn', q[:, :, 1], peer_k2).astype(jnp.float32)
        v1, i1 = lax.top_k(s1, PEER_TOPK)
        v2, i2 = lax.top_k(s2, PEER_TOPK)
        cand = (v1[..., :, None] + v2[..., None, :]).reshape(TOKEN_BLOCK, PEER_HEADS, PEER_TOPK * PEER_TOPK)
        cidx = (i1[..., :, None] * N_KEYS + i2[..., None, :]).reshape(TOKEN_BLOCK, PEER_HEADS, PEER_TOPK * PEER_TOPK)
        top_s, pos = lax.top_k(cand, PEER_TOPK)
        eidx = jnp.take_along_axis(cidx, pos, axis=-1)
        g = jax.nn.softmax(top_s, axis=-1)
        ue = peer_u[eidx]
        ve = peer_v[eidx]
        act = jax.nn.gelu(jnp.einsum('td,thkd->thk', xc, ue).astype(jnp.float32), approximate=False)
        return jnp.einsum('thk,thkd->td', (g * act).astype(ve.dtype), ve)

    out = lax.map(block, xt)
    return out.reshape(b, seq, d)


def setup_inputs(seed: int = 0) -> dict:
    key = jax.random.key(seed)
    ks = jax.random.split(key, 14)
    f32 = jnp.float32
    x = jax.random.normal(ks[0], (BATCH, SEQ, D_MODEL), f32)
    norm1_g = 1.0 + 0.02 * jax.random.normal(ks[1], (D_MODEL,), f32)
    w_in = jax.random.normal(ks[2], (D_MODEL, IN_COLS), f32) * D_MODEL ** -0.5
    conv_w = jax.random.normal(ks[3], (CONV_K, CONV_WIDTH), f32) * CONV_K ** -0.5
    q_norm_g = 1.0 + 0.02 * jax.random.normal(ks[4], (HEAD_DIM,), f32)
    k_norm_g = 1.0 + 0.02 * jax.random.normal(ks[5], (HEAD_DIM,), f32)
    w_o = jax.random.normal(ks[6], (D_MODEL, D_MODEL), f32) * D_MODEL ** -0.5
    norm2_g = 1.0 + 0.02 * jax.random.normal(ks[7], (D_MODEL,), f32)
    peer_wq = jax.random.normal(ks[8], (D_MODEL, PEER_HEADS * PEER_KEY_DIM), f32) * D_MODEL ** -0.5
    peer_k1 = jax.random.normal(ks[9], (PEER_HEADS, N_KEYS, PEER_HALF), f32) * PEER_HALF ** -0.5
    peer_k2 = jax.random.normal(ks[10], (PEER_HEADS, N_KEYS, PEER_HALF), f32) * PEER_HALF ** -0.5
    peer_u = jax.random.normal(ks[11], (N_EXPERTS, D_MODEL), f32) * D_MODEL ** -0.5
    peer_v = jax.random.normal(ks[12], (N_EXPERTS, D_MODEL), f32) * PEER_HEADS ** -0.5
    return {"x": x, "norm1_g": norm1_g, "w_in": w_in, "conv_w": conv_w,
            "q_norm_g": q_norm_g, "k_norm_g": k_norm_g, "w_o": w_o,
            "norm2_g": norm2_g, "peer_wq": peer_wq, "peer_k1": peer_k1,
            "peer_k2": peer_k2, "peer_u": peer_u, "peer_v": peer_v}


def reference(x, norm1_g, w_in, conv_w, q_norm_g, k_norm_g, w_o, norm2_g,
              peer_wq, peer_k1, peer_k2, peer_u, peer_v):
    b, seq, _ = x.shape
    pos = jnp.arange(seq)
    h = x
    for _layer in range(DEPTH):
        xn = rms_norm(h, norm1_g)
        proj = xn @ w_in
        (b_gate, c_gate, xt, q, k, v, qi, ki, wi, ga, gb) = jnp.split(proj, SPLIT_POINTS, axis=-1)
        y_a = short_conv_mixer(b_gate, c_gate, xt, conv_w)
        q = q.reshape(b, seq, N_HEADS, HEAD_DIM)
        k = k.reshape(b, seq, N_KV_HEADS, HEAD_DIM)
        v = v.reshape(b, seq, N_KV_HEADS, HEAD_DIM)
        q = partial_rope(rms_norm(q, q_norm_g), pos)
        k = partial_rope(rms_norm(k, k_norm_g), pos)
        qi = partial_rope(qi.reshape(b, seq, IDX_HEADS, IDX_DIM), pos)
        ki = partial_rope(ki.reshape(b, seq, 1, IDX_DIM), pos)[:, :, 0]
        wi = wi * IDX_W_SCALE
        y_b = dsa_attention(q, k, v, qi, ki, wi)
        merged = jax.nn.sigmoid(ga) * y_a + jax.nn.sigmoid(gb) * y_b
        h = h + merged @ w_o
        hn = rms_norm(h, norm2_g)
        h = h + peer_layer(hn, peer_wq, peer_k1, peer_k2, peer_u, peer_v)
    return h
```

```cpp
#include <hip/hip_runtime.h>
#include <hip/hip_cooperative_groups.h>
#include <cstdio>
#include <cstdint>
namespace cg = cooperative_groups;

namespace pg8 {
#define PG8_LAS __attribute__((address_space(3)))
typedef unsigned short bf16_t;
typedef short bf16x8 __attribute__((ext_vector_type(8)));
typedef float f32x4 __attribute__((ext_vector_type(4)));
typedef unsigned u32x4 __attribute__((ext_vector_type(4)));
constexpr int BM = 256, BK = 64, HALF = 128, HTB = HALF * BK * 2  , STAGE_BYTES = 8 * HTB, NXCD = 8, WGM = 8;

__host__ __device__ __forceinline__ int lds_byte(int r, int c) { const int st = (r >> 4) * 2 + (c >> 5), rr = r & 15, cc = c & 31, ob = rr * 64 + cc * 2; return st * 1024 + (ob ^ (((ob >> 9) & 1) << 5)); }
__host__ __device__ __forceinline__ void stage_rc(int b, int& R, int& C) { const int st = b / 1024, sb = b % 1024, swz = sb ^ (((sb >> 9) & 1) << 5); R = (st >> 1) * 16 + swz / 64; C = (st & 1) * 32 + (swz % 64) / 2; }
__host__ __device__ __forceinline__ int perm32(int rho) { const int n = rho >> 4, i = rho & 15; return 8 * (i >> 2) + 4 * n + (i & 3); }

struct Unit { int pm, pn; };
struct Gemm { const bf16_t* A; const bf16_t* Bt; int M, N, K; };

struct StaticOrder {
    int nM, nN, nwg, G, c;
    __host__ __device__ void init(int M, int N, int G_, int c_) { nM = M / BM; nN = N / BM; nwg = nM * nN; G = G_; c = c_; }
    __host__ __device__ __forceinline__ bool next(int i, Unit& u) const {
        const long L = (long)i * G + c; if (L >= nwg) return false;
        int wgid = (int)L; { const int q = nwg / NXCD, r = nwg % NXCD, xcd = wgid % NXCD, off = wgid / NXCD; wgid = (xcd < r ? xcd * (q + 1) : r * (q + 1) + (xcd - r) * q) + off; }
        const int nig = WGM * nN, gid = wgid / nig, fm = gid * WGM, gsz = (nM - fm) < WGM ? (nM - fm) : WGM;
        u.pm = fm + ((wgid % nig) % gsz); u.pn = (wgid % nig) / gsz; return true;
    }
    __device__ __forceinline__ void a_ready(const Unit&) const {}
    __device__ __forceinline__ void done(const Unit&) const {}
};

__device__ __forceinline__ unsigned cvt_pk_bf16(float lo, float hi) { unsigned r; asm volatile("v_cvt_pk_bf16_f32 %0, %1, %2" : "=v"(r) : "v"(lo), "v"(hi)); return r; }
typedef float f32x2 __attribute__((ext_vector_type(2)));
__device__ __forceinline__ float sigm(float x) { return __builtin_amdgcn_rcpf(1.0f + __expf(-x)); }
__device__ __forceinline__ void st8(bf16_t* p, const f32x4& v0, const f32x4& v1) {
    u32x4 w; w.x = cvt_pk_bf16(v0[0], v0[1]); w.y = cvt_pk_bf16(v0[2], v0[3]); w.z = cvt_pk_bf16(v1[0], v1[1]); w.w = cvt_pk_bf16(v1[2], v1[3]); *(u32x4*)p = w; }
__device__ __forceinline__ f32x4 sigm4(const f32x4& v) { return (f32x4){sigm(v[0]), sigm(v[1]), sigm(v[2]), sigm(v[3])}; }
struct EpiProj {
    static constexpr bool PERM = true, AFTER_DRAIN = false;
    bf16_t *U, *P1, *Q, *K, *V, *QI, *SGB;
    __device__ __forceinline__ void operator()(const f32x4 (&acc)[2][2][4][2], const Unit& u, int wr, int wc, int fr, int fq) const {
        const int row0 = u.pm * BM + wr * 64 + fr, pn = u.pn, cw = wc * 32 + 8 * fq;
        if (pn < 16) {
            bf16_t* base = (pn < 8 ? U : P1) + (size_t)(pn & 7) * 128 + cw;
#pragma unroll
            for (int ai = 0; ai < 2; ++ai)
#pragma unroll
                for (int m = 0; m < 4; ++m) {
                    f32x4 a0 = acc[ai][0][m][0], a1 = acc[ai][0][m][1], b0 = acc[ai][1][m][0], b1 = acc[ai][1][m][1];
                    if (pn >= 8) { b0 = sigm4(b0); b1 = sigm4(b1); }
                    st8(base + (size_t)(row0 + ai * HALF + m * 16) * 1024, a0 * b0, a1 * b1); }
        } else if (pn < 22 || (pn >= 24 && pn < 28)) {
            bf16_t* base; int ld; bool sg = false;
            if (pn < 20) { base = Q + (pn - 16) * 256; ld = 1024; }
            else if (pn == 20) { base = K; ld = 256; }
            else if (pn == 21) { base = V; ld = 256; }
            else { base = SGB + (pn - 24) * 256; ld = 1024; sg = true; }
#pragma unroll
            for (int ai = 0; ai < 2; ++ai)
#pragma unroll
                for (int m = 0; m < 4; ++m) { bf16_t* rowp = base + (size_t)(row0 + ai * HALF + m * 16) * ld + cw;
#pragma unroll
                    for (int bj = 0; bj < 2; ++bj) { f32x4 v0 = acc[ai][bj][m][0], v1 = acc[ai][bj][m][1];
                        if (sg) { v0 = sigm4(v0); v1 = sigm4(v1); }
                        st8(rowp + bj * HALF, v0, v1); } }
        } else {
            const bool isx1 = (fq == 0), roped = (((32 * wc + 8 * fq) & 63) < 16);
#pragma unroll
            for (int ai = 0; ai < 2; ++ai)
#pragma unroll
                for (int m = 0; m < 4; ++m) { const int row = row0 + ai * HALF + m * 16; const float pos = (float)(row & 2047);
                    float cs[8], sn[8];
#pragma unroll
                    for (int i = 0; i < 8; ++i) { const float inv = exp2f(-(float)i * (18.931568569324174f / 8.f)), ang = pos * inv; float rev = ang * 0.15915494309189535f; rev -= floorf(rev);
                        sn[i] = __builtin_amdgcn_sinf(rev); cs[i] = __builtin_amdgcn_cosf(rev); }
#pragma unroll
                    for (int bj = 0; bj < 2; ++bj) {
                        f32x4 v0 = acc[ai][bj][m][0], v1 = acc[ai][bj][m][1]; f32x4 o0, o1;
#pragma unroll
                        for (int i = 0; i < 4; ++i) { o0[i] = __shfl_xor(v0[i], 16); o1[i] = __shfl_xor(v1[i], 16); }
                        if (roped) {
#pragma unroll
                            for (int i = 0; i < 4; ++i) { v0[i] = isx1 ? v0[i] * cs[i] - o0[i] * sn[i] : v0[i] * cs[i] + o0[i] * sn[i]; v1[i] = isx1 ? v1[i] * cs[4 + i] - o1[i] * sn[4 + i] : v1[i] * cs[4 + i] + o1[i] * sn[4 + i]; } }
                        st8(QI + (size_t)row * 512 + (pn - 22) * 256 + bj * HALF + cw, v0, v1); } }
        }
    }
};
struct EpiBf16 {
    static constexpr bool PERM = true, AFTER_DRAIN = false;
    bf16_t* O; int ldc;
    __device__ __forceinline__ void operator()(const f32x4 (&acc)[2][2][4][2], const Unit& u, int wr, int wc, int fr, int fq) const {
        const int row0 = u.pm * BM + wr * 64 + fr, col0 = u.pn * BM + wc * 32 + 8 * fq;
#pragma unroll
        for (int ai = 0; ai < 2; ++ai)
#pragma unroll
            for (int m = 0; m < 4; ++m) { bf16_t* rowp = O + (size_t)(row0 + ai * HALF + m * 16) * ldc + col0;
#pragma unroll
                for (int bj = 0; bj < 2; ++bj) st8(rowp + bj * HALF, acc[ai][bj][m][0], acc[ai][bj][m][1]); }
    }
};
struct EpiResF32 {
    static constexpr bool PERM = false, AFTER_DRAIN = false;
    const float* base; float* out; int ldc;
    __device__ __forceinline__ void operator()(const f32x4 (&acc)[2][2][4][2], const Unit& u, int wr, int wc, int fr, int fq) const {
        const int row0 = u.pm * BM + wr * 64 + fr, col0 = u.pn * BM + wc * 32 + 4 * fq;
#pragma unroll
        for (int ai = 0; ai < 2; ++ai)
#pragma unroll
            for (int m = 0; m < 4; ++m) { const size_t off = (size_t)(row0 + ai * HALF + m * 16) * ldc + col0;
#pragma unroll
                for (int bj = 0; bj < 2; ++bj)
#pragma unroll
                    for (int n = 0; n < 2; ++n) { const size_t o = off + bj * HALF + n * 16; *(f32x4*)(out + o) = *(const f32x4*)(base + o) + acc[ai][bj][m][n]; } }
    }
};

__device__ __forceinline__ void epi_ld16(u32x4& d, unsigned off, const void* base) { asm volatile("global_load_dwordx4 %0, %1, %2" : "=&v"(d) : "v"(off), "s"(base) : "memory"); }
__device__ __forceinline__ u32x4 epi_mov4(const u32x4& s) { u32x4 d; asm volatile("v_mov_b32 %0, %4\n\tv_mov_b32 %1, %5\n\tv_mov_b32 %2, %6\n\tv_mov_b32 %3, %7" : "=&v"(d.x), "=&v"(d.y), "=&v"(d.z), "=&v"(d.w) : "v"(s.x), "v"(s.y), "v"(s.z), "v"(s.w)); return d; }
struct EpiResNorm {
    static constexpr bool PERM = false, AFTER_DRAIN = false;
    const float* base; bf16_t* HB; float* SSQ; int ldc;
    __device__ __forceinline__ void operator()(const f32x4 (&acc)[2][2][4][2], const Unit& u, int wr, int wc, int fr, int fq) const {
        const int row0 = u.pm * BM + wr * 64 + fr, col0 = u.pn * BM + wc * 32 + 4 * fq;
        const void* xb = base;
        u32x4 bufA[8], bufB[8];
#define EPI_ISSUE(BUF, G) do { _Pragma("unroll") for (int q_ = 0; q_ < 2; ++q_) { const int rg_ = 2 * (G) + q_, row_ = row0 + (rg_ >> 2) * HALF + (rg_ & 3) * 16; \
            _Pragma("unroll") for (int bj = 0; bj < 2; ++bj) _Pragma("unroll") for (int n = 0; n < 2; ++n) epi_ld16(BUF[q_ * 4 + bj * 2 + n], (unsigned)(row_ * ldc + col0 + bj * HALF + n * 16) * 4u, xb); } } while (0)
#define EPI_PROC(BUF, G) do { _Pragma("unroll") for (int q_ = 0; q_ < 2; ++q_) { const int rg_ = 2 * (G) + q_, ai = rg_ >> 2, m = rg_ & 3, row = row0 + ai * HALF + m * 16; const size_t off = (size_t)row * ldc + col0; float ss = 0.f; \
            _Pragma("unroll") for (int bj = 0; bj < 2; ++bj) _Pragma("unroll") for (int n = 0; n < 2; ++n) { const size_t o = off + bj * HALF + n * 16; const u32x4 xw_ = epi_mov4(BUF[q_ * 4 + bj * 2 + n]); \
                const f32x4 v = __builtin_bit_cast(f32x4, xw_) + acc[ai][bj][m][n]; \
                ss += (v[0] * v[0] + v[1] * v[1]) + (v[2] * v[2] + v[3] * v[3]); \
                f32x2 w; w.x = __builtin_bit_cast(float, cvt_pk_bf16(v[0], v[1])); w.y = __builtin_bit_cast(float, cvt_pk_bf16(v[2], v[3])); *(f32x2*)(HB + o) = w; } \
            ss += __shfl_xor(ss, 16); ss += __shfl_xor(ss, 32); \
            if (fq == 0) SSQ[(size_t)row * 16 + u.pn * 4 + wc] = ss; } } while (0)
#define EPI_WAIT(N) asm volatile("s_waitcnt vmcnt(" #N ")" ::: "memory")
        EPI_ISSUE(bufA, 0); EPI_ISSUE(bufB, 1);
        EPI_WAIT(8); EPI_PROC(bufA, 0); EPI_ISSUE(bufA, 2);
        EPI_WAIT(8); EPI_PROC(bufB, 1); EPI_ISSUE(bufB, 3);
        EPI_WAIT(8); EPI_PROC(bufA, 2);
        EPI_WAIT(0); EPI_PROC(bufB, 3);
#undef EPI_ISSUE
#undef EPI_PROC
#undef EPI_WAIT
    }
};
struct EpiBf16Scale {
    static constexpr bool PERM = true, AFTER_DRAIN = false;
    bf16_t* O; int ldc; const float* SSQ; float* RSTD; const PG8_LAS float* tab; int pm0, pn0; bool use_tab;
    __device__ __forceinline__ void operator()(const f32x4 (&acc)[2][2][4][2], const Unit& u, int wr, int wc, int fr, int fq) const {
        const int row0 = u.pm * BM + wr * 64 + fr, col0 = u.pn * BM + wc * 32 + 8 * fq;
        const PG8_LAS float* tb = tab + ((u.pm == pm0 && u.pn == pn0) ? 0 : 256) + wr * 64 + fr;
#pragma unroll
        for (int ai = 0; ai < 2; ++ai)
#pragma unroll
            for (int m = 0; m < 4; ++m) { const int row = row0 + ai * HALF + m * 16; float r;
                if (use_tab) r = tb[ai * HALF + m * 16];
                else { const f32x4* sp = (const f32x4*)(SSQ + (size_t)row * 16); const f32x4 s4 = (sp[0] + sp[1]) + (sp[2] + sp[3]); r = __builtin_amdgcn_rsqf(((s4[0] + s4[1]) + (s4[2] + s4[3])) * (1.f / 1024.f) + 1e-6f);
                    if (u.pn == 0 && wc == 0 && fq == 0) RSTD[row] = r; }
#pragma unroll
                for (int bj = 0; bj < 2; ++bj) { const int dim = wc * 32 + 8 * fq + bj * HALF;
                    st8(O + (((((size_t)(row >> 5) * 8 + u.pn) * 16 + (dim >> 4)) * 64 + ((dim >> 3) & 1) * 32 + (row & 31)) * 8), acc[ai][bj][m][0] * r, acc[ai][bj][m][1] * r); } }
    }
};

template <class Epi, class Sched, bool ALIGN_EPI = false, bool SP2 = false>
__device__ __forceinline__ void gemm_phase(PG8_LAS unsigned char* lds, const Gemm g, const Sched& S, const Epi& E) {
    const int tid = threadIdx.x, wid = __builtin_amdgcn_readfirstlane(tid >> 6), lane = tid & 63, wr = wid >> 2, wc = wid & 3, fr = lane & 15, fq = lane >> 4;
    const int K = g.K, nt = K / BK;
    unsigned voffA[2], voffB[2];
#pragma unroll
    for (int i = 0; i < 2; ++i) { int R, C; stage_rc(tid * 16 + i * 8192, R, C); const int Rb = Epi::PERM ? ((R & ~31) + perm32(R & 31)) : R;
        voffA[i] = (unsigned)(R * K + C) * 2u; voffB[i] = (unsigned)(Rb * K + C) * 2u; }
    const size_t kstep = (size_t)(BK * 2);
    const size_t hstep = (size_t)HALF * K * 2;
    const size_t tstep = 2 * hstep;
    const unsigned ldsw = (unsigned)wid * 1024u;
    const int aoff = lds_byte(wr * 64 + fr, fq * 8), boff = lds_byte(wc * 32 + fr, fq * 8);
#define PG8_SA(b, h) (((b) * 2 + (h)) * HTB)
#define PG8_SB(b, h) ((4 + (b) * 2 + (h)) * HTB)
#define PG8_STAGE(bufoff, gbase, voff) do { _Pragma("unroll") for (int _i = 0; _i < 2; ++_i) \
        __builtin_amdgcn_global_load_lds((const unsigned*)((const char*)(gbase) + (voff)[_i]), (PG8_LAS unsigned*)(lds + (bufoff) + ldsw + _i * 8192), 16, 0, 0); } while (0)
#define PG8_LDA(dst, b, h) do { _Pragma("unroll") for (int m = 0; m < 4; ++m) _Pragma("unroll") for (int k = 0; k < 2; ++k) dst[m][k] = *(const PG8_LAS bf16x8*)(lds + PG8_SA(b, h) + aoff + m * 2048 + k * 1024); } while (0)
#define PG8_LDB(dst, b, h) do { _Pragma("unroll") for (int n = 0; n < 2; ++n) _Pragma("unroll") for (int k = 0; k < 2; ++k) dst[n][k] = *(const PG8_LAS bf16x8*)(lds + PG8_SB(b, h) + boff + n * 2048 + k * 1024); } while (0)
#define PG8_MMA(ai, bj, At, Bt) do { __builtin_amdgcn_s_setprio(1); _Pragma("unroll") for (int m = 0; m < 4; ++m) _Pragma("unroll") for (int n = 0; n < 2; ++n) _Pragma("unroll") for (int k = 0; k < 2; ++k) \
        acc[ai][bj][m][n] = __builtin_amdgcn_mfma_f32_16x16x32_bf16(Bt[n][k], At[m][k], acc[ai][bj][m][n], 0, 0, 0); __builtin_amdgcn_s_setprio(0); } while (0)
#define PG8_WAIT_V(n) asm volatile("s_waitcnt vmcnt(" #n ")" ::: "memory")
#define PG8_WAIT_L(n) asm volatile("s_waitcnt lgkmcnt(" #n ")" ::: "memory")
#define PG8_BAR __builtin_amdgcn_s_barrier()
#define PG8_SCHED __builtin_amdgcn_sched_barrier(0)
    Unit cur, nxt; int ui = 0;
    if (!S.next(0, cur)) return;
    f32x4 acc[2][2][4][2];
#pragma unroll
    for (int a = 0; a < 2; ++a)
#pragma unroll
        for (int b = 0; b < 2; ++b)
#pragma unroll
            for (int m = 0; m < 4; ++m)
#pragma unroll
                for (int n = 0; n < 2; ++n) acc[a][b][m][n] = (f32x4){0.f, 0.f, 0.f, 0.f};
    bf16x8 At[4][2], B0[2][2], B1[2][2];
    const char* cA = (const char*)g.A + (size_t)cur.pm * tstep; const char* cB = (const char*)g.Bt + (size_t)cur.pn * tstep;
    S.a_ready(cur);
    if constexpr (SP2) {
        PG8_STAGE(PG8_SB(0, 0), cB, voffB); PG8_STAGE(PG8_SB(0, 1), cB + hstep, voffB); PG8_STAGE(PG8_SA(0, 0), cA, voffA); PG8_STAGE(PG8_SA(0, 1), cA + hstep, voffA);
        if (wr == 1) PG8_BAR;
        PG8_WAIT_V(2); PG8_BAR;
        PG8_STAGE(PG8_SB(1, 0), cB + kstep, voffB); PG8_STAGE(PG8_SA(1, 0), cA + kstep, voffA); PG8_STAGE(PG8_SB(1, 1), cB + hstep + kstep, voffB);
        PG8_WAIT_V(6); PG8_BAR;
    } else {
        PG8_STAGE(PG8_SB(0, 0), cB, voffB); PG8_STAGE(PG8_SA(0, 0), cA, voffA); PG8_STAGE(PG8_SB(0, 1), cB + hstep, voffB); PG8_STAGE(PG8_SA(0, 1), cA + hstep, voffA);
        if (wr == 1) PG8_BAR;
        PG8_WAIT_V(4); PG8_BAR;
        PG8_STAGE(PG8_SB(1, 0), cB + kstep, voffB); PG8_STAGE(PG8_SA(1, 0), cA + kstep, voffA); PG8_STAGE(PG8_SB(1, 1), cB + hstep + kstep, voffB);
        PG8_WAIT_V(6); PG8_BAR;
    }
    for (;;) {
        const bool has_next = S.next(ui + 1, nxt);
        const char* nA = has_next ? (const char*)g.A + (size_t)nxt.pm * tstep : cA; const char* nB = has_next ? (const char*)g.Bt + (size_t)nxt.pn * tstep : cB;
        for (int t = 0; t < nt; t += 2) {
            const bool last = (t == nt - 2);
            const char* a1 = cA + (size_t)(t + 1) * kstep;
            const char* a2 = last ? nA : cA + (size_t)(t + 2) * kstep; const char* b2 = last ? nB : cB + (size_t)(t + 2) * kstep;
            const char* a3 = a2 + kstep; const char* b3 = b2 + kstep;
            if (last && has_next) S.a_ready(nxt);
            if constexpr (SP2) {
            PG8_LDB(B0, 0, 0); PG8_LDB(B1, 0, 1); PG8_SCHED; PG8_LDA(At, 0, 0); PG8_STAGE(PG8_SA(1, 1), a1 + hstep, voffA);
            PG8_WAIT_V(8); PG8_WAIT_L(0); PG8_BAR; PG8_MMA(0, 0, At, B0); PG8_MMA(0, 1, At, B1); PG8_BAR; PG8_SCHED;
            PG8_LDA(At, 0, 1); PG8_STAGE(PG8_SB(0, 0), b2, voffB); PG8_STAGE(PG8_SB(0, 1), b2 + hstep, voffB); PG8_STAGE(PG8_SA(0, 0), a2, voffA);
            PG8_WAIT_V(8); PG8_WAIT_L(0); PG8_BAR; PG8_MMA(1, 0, At, B0); PG8_MMA(1, 1, At, B1); PG8_BAR; PG8_SCHED;
            PG8_LDB(B0, 1, 0); PG8_LDB(B1, 1, 1); PG8_SCHED; PG8_LDA(At, 1, 0); PG8_STAGE(PG8_SA(0, 1), a2 + hstep, voffA);
            PG8_WAIT_V(8); PG8_WAIT_L(0); PG8_BAR; PG8_MMA(0, 0, At, B0); PG8_MMA(0, 1, At, B1); PG8_BAR; PG8_SCHED;
            PG8_LDA(At, 1, 1); PG8_STAGE(PG8_SB(1, 0), b3, voffB); PG8_STAGE(PG8_SB(1, 1), b3 + hstep, voffB); PG8_STAGE(PG8_SA(1, 0), a3, voffA);
            PG8_WAIT_V(8); PG8_WAIT_L(0); PG8_BAR; PG8_MMA(1, 0, At, B0); PG8_MMA(1, 1, At, B1); PG8_BAR; PG8_SCHED;
            } else {
            PG8_LDB(B0, 0, 0); PG8_SCHED; PG8_LDA(At, 0, 0); PG8_STAGE(PG8_SA(1, 1), a1 + hstep, voffA);
            PG8_WAIT_L(8); PG8_BAR; PG8_WAIT_L(0); PG8_MMA(0, 0, At, B0); PG8_BAR; PG8_SCHED;
            PG8_LDB(B1, 0, 1); PG8_STAGE(PG8_SB(0, 0), b2, voffB);
            PG8_BAR; PG8_WAIT_L(0); PG8_MMA(0, 1, At, B1); PG8_BAR;
            PG8_LDA(At, 0, 1); PG8_STAGE(PG8_SA(0, 0), a2, voffA);
            PG8_BAR; PG8_WAIT_L(0); PG8_MMA(1, 0, At, B0); PG8_BAR; PG8_SCHED;
            PG8_STAGE(PG8_SB(0, 1), b2 + hstep, voffB);
            PG8_WAIT_V(6); PG8_BAR; PG8_MMA(1, 1, At, B1); PG8_BAR;
            PG8_LDB(B0, 1, 0); PG8_SCHED; PG8_LDA(At, 1, 0); PG8_STAGE(PG8_SA(0, 1), a2 + hstep, voffA);
            PG8_WAIT_L(8); PG8_BAR; PG8_WAIT_L(0); PG8_MMA(0, 0, At, B0); PG8_BAR; PG8_SCHED;
            PG8_LDB(B1, 1, 1); PG8_STAGE(PG8_SB(1, 0), b3, voffB);
            PG8_BAR; PG8_WAIT_L(0); PG8_MMA(0, 1, At, B1); PG8_BAR;
            PG8_LDA(At, 1, 1); PG8_STAGE(PG8_SA(1, 0), a3, voffA);
            PG8_BAR; PG8_WAIT_L(0); PG8_MMA(1, 0, At, B0); PG8_BAR; PG8_SCHED;
            PG8_STAGE(PG8_SB(1, 1), b3 + hstep, voffB);
            PG8_WAIT_V(6); PG8_BAR; PG8_MMA(1, 1, At, B1); PG8_BAR;
            }
        }
        if constexpr (ALIGN_EPI) { if (wr == 0) PG8_BAR; }
        if constexpr (!Epi::AFTER_DRAIN) { E(acc, cur, wr, wc, fr, fq); S.done(cur); }
        if (!has_next) break;
#pragma unroll
        for (int a = 0; a < 2; ++a)
#pragma unroll
            for (int b = 0; b < 2; ++b)
#pragma unroll
                for (int m = 0; m < 4; ++m)
#pragma unroll
                    for (int n = 0; n < 2; ++n) acc[a][b][m][n] = (f32x4){0.f, 0.f, 0.f, 0.f};
        cur = nxt; cA = nA; cB = nB; ++ui;
        if constexpr (ALIGN_EPI) { if (wr == 1) PG8_BAR; }
    }
    PG8_WAIT_V(0);
    if constexpr (!ALIGN_EPI) { if (wr == 0) PG8_BAR; }
    PG8_BAR;
    if constexpr (Epi::AFTER_DRAIN) { E.fused(acc, cur, wr, wc, fr, fq, lds, wid, lane); S.done(cur); }
#undef PG8_SA
#undef PG8_SB
#undef PG8_STAGE
#undef PG8_LDA
#undef PG8_LDB
#undef PG8_MMA
#undef PG8_WAIT_V
#undef PG8_WAIT_L
#undef PG8_BAR
#undef PG8_SCHED
}
}
constexpr int T = 16384, D = 1024, SEQ = 2048, NBATCH = 8;
constexpr int NPROJ = 7168;
constexpr int NPROJ_T = 7264;
constexpr float EPS = 1e-6f;
constexpr float ATTN_SCALE = 0.08838834764831845f, IDX_SCALE = 0.125f, IDX_W_SCALE = 0.35355339059327373f;
constexpr float LOG2_THETA = 18.931568569324174f;
constexpr int NWAVES = 8, NTHR = 512;

constexpr size_t MiB = 1u << 20;
constexpr size_t WS_CTL = 0, CTL_ZERO_BYTES = 64 * 1024;
constexpr size_t WS_WIN = 1 * MiB;
constexpr size_t WS_WO = 16 * MiB;
constexpr size_t WS_WQ = 18 * MiB;
constexpr size_t WS_K1 = 22 * MiB, WS_K2 = WS_K1 + 256 * 1024;
constexpr size_t WS_UB = 24 * MiB, WS_VB = 56 * MiB;
constexpr size_t WS_XN = 88 * MiB;
constexpr size_t WS_P1 = 120 * MiB;
constexpr size_t WS_U = 152 * MiB;
constexpr size_t WS_Q = 184 * MiB;
constexpr size_t WS_K = 216 * MiB, WS_V = 224 * MiB;
constexpr size_t WS_QI = 232 * MiB;
constexpr size_t WS_KI = 248 * MiB;
constexpr size_t WS_WI = 250 * MiB;
constexpr size_t WS_MASK = 251 * MiB;
constexpr size_t WS_END = 256 * MiB;
constexpr size_t WS_PQ = 120 * MiB;
constexpr size_t WS_EIDX = 184 * MiB, WS_GATE = 192 * MiB;

constexpr int LDS_BYTES = 147456;
constexpr int MISC_OFF = 147456 - 256;
constexpr int CW_RANK = 8192;
constexpr int CW_BAR = 1024;

#define LAS __attribute__((address_space(3)))
typedef unsigned short bf16;
typedef unsigned v4u __attribute__((ext_vector_type(4)));
typedef unsigned v2u __attribute__((ext_vector_type(2)));
typedef float f32x4 __attribute__((ext_vector_type(4)));
typedef __bf16 bf16x2_t __attribute__((ext_vector_type(2)));

__device__ __forceinline__ unsigned f2bf(float f) { unsigned u = __builtin_bit_cast(unsigned, f); return (u + 0x7fffu + ((u >> 16) & 1u)) >> 16; }
__device__ __forceinline__ unsigned pk2(float lo, float hi) { return f2bf(lo) | (f2bf(hi) << 16); }
__device__ __forceinline__ float bflo(unsigned w) { return __builtin_bit_cast(float, w << 16); }
__device__ __forceinline__ float bfhi(unsigned w) { return __builtin_bit_cast(float, w & 0xffff0000u); }
__device__ __forceinline__ float bf1(bf16 h) { return __builtin_bit_cast(float, (unsigned)h << 16); }
__device__ __forceinline__ float dot2bf(unsigned a, unsigned b, float acc) { return __builtin_amdgcn_fdot2_f32_bf16(__builtin_bit_cast(bf16x2_t, a), __builtin_bit_cast(bf16x2_t, b), acc, false); }
#define DPP_XOR1 0xB1
#define DPP_XOR2 0x4E
#define DPP_ROR(n) (0x120 + (n))
__device__ __forceinline__ float wave_sum(float v) {
#pragma unroll
    for (int o = 1; o < 64; o <<= 1) v += __shfl_xor(v, o);
    return v; }
__device__ __forceinline__ float wave_max(float v) {
#pragma unroll
    for (int o = 1; o < 64; o <<= 1) v = fmaxf(v, __shfl_xor(v, o));
    return v; }
__device__ __forceinline__ int wave_sumi(int v) {
#pragma unroll
    for (int o = 1; o < 64; o <<= 1) v += __shfl_xor(v, o);
    return v; }
__device__ __forceinline__ int wave_mini(int v) {
#pragma unroll
    for (int o = 1; o < 64; o <<= 1) v = min(v, __shfl_xor(v, o));
    return v; }
__device__ __forceinline__ int wave_incl_scan(int v, int lane) {
#pragma unroll
    for (int o = 1; o < 64; o <<= 1) { const int x = __shfl_up(v, o); if (lane >= o) v += x; }
    return v; }
#define LDS_WAIT() asm volatile("s_waitcnt lgkmcnt(0)" ::: "memory")

struct Args { const float* in[13]; float* out; unsigned char* ws; int ph_lo, ph_hi; };

struct Ctx {
    unsigned char* lds; int tid, lane, wave, G, bid;
    const float *x, *g1, *w_in, *conv_w, *qg, *kg, *w_o, *g2, *pwq, *pk1, *pk2, *pu, *pv; float* out;
    bf16 *WIN, *WO, *WQ, *K1, *K2, *UB, *VB, *XN, *P1, *U, *Q, *K, *V, *QI, *KI, *SGB, *PQ;
    float *WI, *GATE, *PD; unsigned* MASK; int* EIDX;
    bool late_jobs;
    int cls, crank, cnb;
};

#define HB_OF(F) ((bf16*)((unsigned char*)(F).Q + 16 * MiB))
#define SSQ_OF(F) ((float*)((unsigned char*)(F).MASK + 4 * MiB))
#define RSTD_OF(F) ((float*)((unsigned char*)(F).K1 + 512 * 1024))
__device__ __forceinline__ int win_src_col(int n) {
    if (n < 2048) { const int ch = ((n >> 8) << 7) + (n & 127); return ((n >> 7) & 1) ? 2048 + ch : 1024 + ch; }
    if (n < 4096) { const int m = n - 2048, ch = ((m >> 8) << 7) + (m & 127); return ((m >> 7) & 1) ? 5192 + ch : ch; }
    if (n < 5120) return 3072 + (n - 4096);
    if (n < 5376) return 4096 + (n - 5120);
    if (n < 5632) return 4352 + (n - 5376);
    if (n < 6144) return 4608 + (n - 5632);
    if (n < 7168) return 6216 + (n - 6144);
    if (n < 7232) return 5120 + (n - 7168);
    if (n < 7240) return 5184 + (n - 7232);
    return -1;
}

template <bool MAPPED, bool GAIN = false>
__device__ __forceinline__ void transpose_item(const float* W, int K, int N, bf16* WT, float* scr, int item, int nblk, int lane, const float* gain = nullptr) {
    const int kb = item / nblk, nb = item % nblk, k0 = 64 * kb, n0 = 32 * nb;
    int src = n0 + (lane & 31); if (MAPPED) src = win_src_col(src);
    float tv[32];
#pragma unroll
    for (int i = 0; i < 32; ++i) { const int kk = 2 * i + (lane >> 5); tv[i] = (src >= 0) ? W[(size_t)(k0 + kk) * N + src] : 0.f; }
#pragma unroll
    for (int i = 0; i < 32; ++i) { const int kk = 2 * i + (lane >> 5); scr[kk * 33 + (lane & 31)] = tv[i]; }
    LDS_WAIT(); asm volatile("" ::: "memory");
    const int c = lane & 7;
    f32x4 ga = {1.f, 1.f, 1.f, 1.f}, gb = ga; if (GAIN) { ga = *(const f32x4*)(gain + k0 + 8 * c); gb = *(const f32x4*)(gain + k0 + 8 * c + 4); }
#pragma unroll
    for (int j = 0; j < 4; ++j) { const int n = (lane >> 3) + 8 * j; const float* s = scr + (8 * c) * 33 + n;
        v4u o; o.x = pk2(s[0 * 33] * ga[0], s[1 * 33] * ga[1]); o.y = pk2(s[2 * 33] * ga[2], s[3 * 33] * ga[3]); o.z = pk2(s[4 * 33] * gb[0], s[5 * 33] * gb[1]); o.w = pk2(s[6 * 33] * gb[2], s[7 * 33] * gb[3]);
        size_t wo = (size_t)(n0 + n) * K + k0 + 8 * c;
        if (MAPPED && n0 >= NPROJ) { const int nr = n0 + n - NPROJ, kc = (k0 >> 3) + c;
            wo = (size_t)NPROJ * K + ((((size_t)(nr >> 4) * 32 + (kc >> 2)) * 64 + (kc & 3) * 16 + (nr & 15)) * 8); }
        *(v4u*)(WT + wo) = o; }
    LDS_WAIT(); asm volatile("" ::: "memory");
}
__device__ __forceinline__ void cvt8(const float* src, bf16* dst, size_t i) {
    const f32x4 a = *(const f32x4*)(src + i), b = *(const f32x4*)(src + i + 4);
    v4u o; o.x = pk2(a[0], a[1]); o.y = pk2(a[2], a[3]); o.z = pk2(b[0], b[1]); o.w = pk2(b[2], b[3]); *(v4u*)(dst + i) = o;
}
constexpr float U8_SCALE = 64.f, V8_SCALE = 8.f;
__device__ __forceinline__ size_t tbl8_off(size_t c16) { const size_t e = c16 >> 6, q = c16 & 63; return (q >> 3) * (size_t)(16384 * 128) + e * 128 + (q & 7) * 16; }
__device__ __forceinline__ unsigned pk4_fp8(const f32x4& a, float s) { int p = 0; p = __builtin_amdgcn_cvt_pk_fp8_f32(a[0] * s, a[1] * s, p, false); p = __builtin_amdgcn_cvt_pk_fp8_f32(a[2] * s, a[3] * s, p, true); return (unsigned)p; }
__device__ __forceinline__ void cvt16_fp8(const float* src, unsigned char* dst, size_t i, float s) {
    const f32x4 a = *(const f32x4*)(src + i), b = *(const f32x4*)(src + i + 4), c = *(const f32x4*)(src + i + 8), d = *(const f32x4*)(src + i + 12);
    v4u o; o.x = pk4_fp8(a, s); o.y = pk4_fp8(b, s); o.z = pk4_fp8(c, s); o.w = pk4_fp8(d, s); *(v4u*)(dst + i) = o;
}
__device__ __forceinline__ void rms_row2_to_bf16(const float* xrow0, const float* xrow1, const float* g, bf16* orow0, bf16* orow1, int lane) {
    const f32x4* xa = (const f32x4*)xrow0 + lane; const f32x4* xb = (const f32x4*)xrow1 + lane; f32x4 va[4], vb[4]; float sa = 0.f, sb = 0.f;
#pragma unroll
    for (int j = 0; j < 4; ++j) { va[j] = xa[64 * j]; vb[j] = xb[64 * j]; }
#pragma unroll
    for (int j = 0; j < 4; ++j) { sa += (va[j].x * va[j].x + va[j].y * va[j].y) + (va[j].z * va[j].z + va[j].w * va[j].w); sb += (vb[j].x * vb[j].x + vb[j].y * vb[j].y) + (vb[j].z * vb[j].z + vb[j].w * vb[j].w); }
#pragma unroll
    for (int o = 1; o < 64; o <<= 1) { sa += __shfl_xor(sa, o); sb += __shfl_xor(sb, o); }
    const float ra = rsqrtf(sa * (1.f / 1024.f) + EPS), rb = rsqrtf(sb * (1.f / 1024.f) + EPS);
    v2u* oa = (v2u*)orow0 + lane; v2u* ob = (v2u*)orow1 + lane;
#pragma unroll
    for (int j = 0; j < 4; ++j) { const f32x4 gv = ((const f32x4*)g)[lane + 64 * j]; v2u w;
        w.x = pk2(va[j].x * ra * gv.x, va[j].y * ra * gv.y); w.y = pk2(va[j].z * ra * gv.z, va[j].w * ra * gv.w); oa[64 * j] = w;
        w.x = pk2(vb[j].x * rb * gv.x, vb[j].y * rb * gv.y); w.y = pk2(vb[j].z * rb * gv.z, vb[j].w * rb * gv.w); ob[64 * j] = w; }
}
__device__ __forceinline__ void rms_rows(const float* X, const float* g, bf16* O, int gw, int NGW, int lane) {
    f32x4 gq[4];
#pragma unroll
    for (int q = 0; q < 4; ++q) gq[q] = ((const f32x4*)g)[lane + 64 * q];
    for (int m0 = gw; m0 < T; m0 += 4 * NGW) {
        int mr[4]; f32x4 v[4][4]; float ss[4];
#pragma unroll
        for (int j = 0; j < 4; ++j) { mr[j] = (m0 + j * NGW < T) ? m0 + j * NGW : m0; const f32x4* xr = (const f32x4*)(X + (size_t)mr[j] * D) + lane;
#pragma unroll
            for (int q = 0; q < 4; ++q) v[j][q] = xr[64 * q]; }
#pragma unroll
        for (int j = 0; j < 4; ++j) { float s = 0.f;
#pragma unroll
            for (int q = 0; q < 4; ++q) s += (v[j][q].x * v[j][q].x + v[j][q].y * v[j][q].y) + (v[j][q].z * v[j][q].z + v[j][q].w * v[j][q].w);
            ss[j] = s; }
#pragma unroll
        for (int o = 1; o < 64; o <<= 1) {
#pragma unroll
            for (int j = 0; j < 4; ++j) ss[j] += __shfl_xor(ss[j], o); }
#pragma unroll
        for (int j = 0; j < 4; ++j) { const float r = rsqrtf(ss[j] * (1.f / 1024.f) + EPS); v2u* op = (v2u*)(O + (size_t)mr[j] * D) + lane;
#pragma unroll
            for (int q = 0; q < 4; ++q) { const f32x4 gv = gq[q]; v2u w;
                w.x = pk2(v[j][q].x * r * gv.x, v[j][q].y * r * gv.y); w.y = pk2(v[j][q].z * r * gv.z, v[j][q].w * r * gv.w); op[64 * q] = w; } }
    }
}
__device__ __forceinline__ void rms_row_to_bf16(const float* xrow, const float* g, bf16* orow, int lane) {
    const f32x4* xr = (const f32x4*)xrow + lane; f32x4 v[4]; float s = 0.f;
#pragma unroll
    for (int j = 0; j < 4; ++j) { v[j] = xr[64 * j]; s += (v[j].x * v[j].x + v[j].y * v[j].y) + (v[j].z * v[j].z + v[j].w * v[j].w); }
    const float rstd = rsqrtf(wave_sum(s) * (1.f / 1024.f) + EPS);
    v2u* o8 = (v2u*)orow + lane;
#pragma unroll
    for (int j = 0; j < 4; ++j) { const f32x4 gv = ((const f32x4*)g)[lane + 64 * j]; v2u w; w.x = pk2(v[j].x * rstd * gv.x, v[j].y * rstd * gv.y); w.y = pk2(v[j].z * rstd * gv.z, v[j].w * rstd * gv.w); o8[64 * j] = w; }
}
constexpr float U4_SCALE = 64.f, V4_SCALE = 5.656854249f;
__device__ __forceinline__ size_t tbl4_off(size_t c32) { const size_t e = c32 >> 5, q = c32 & 31; return (q >> 3) * (size_t)(16384 * 128) + e * 128 + (q & 7) * 16; }
__device__ __forceinline__ unsigned pk8_fp4(const f32x4& a, const f32x4& b, float s) { unsigned p = 0;
    p = __builtin_amdgcn_cvt_scalef32_pk_fp4_f32(p, a[0] * s, a[1] * s, 1.0f, 0); p = __builtin_amdgcn_cvt_scalef32_pk_fp4_f32(p, a[2] * s, a[3] * s, 1.0f, 1);
    p = __builtin_amdgcn_cvt_scalef32_pk_fp4_f32(p, b[0] * s, b[1] * s, 1.0f, 2); p = __builtin_amdgcn_cvt_scalef32_pk_fp4_f32(p, b[2] * s, b[3] * s, 1.0f, 3); return p; }
__device__ __forceinline__ void tables_job(Ctx& F, size_t gt, size_t NGT) {
    const int lane = (int)(gt & 63); const size_t wv = gt >> 6, NWV = NGT >> 6;
    constexpr size_t NIT = (size_t)16384 * 4;
    f32x4 gc[4];
#pragma unroll
    for (int c = 0; c < 4; ++c) gc[c] = *(const f32x4*)(F.g2 + c * 256 + lane * 4);
    for (size_t i0 = wv; i0 < NIT; i0 += 8 * NWV) {
        size_t it[8]; f32x4 a[8], b[8];
#pragma unroll
        for (int j = 0; j < 8; ++j) { it[j] = (i0 + j * NWV < NIT) ? i0 + j * NWV : i0; const size_t src = it[j] * 256 + lane * 4;
            a[j] = *(const f32x4*)(F.pu + src); b[j] = *(const f32x4*)(F.pv + src); }
#pragma unroll
        for (int j = 0; j < 8; ++j) { const size_t e = it[j] >> 2, c = it[j] & 3; const size_t dst = c * (size_t)(16384 * 128) + e * 128 + lane * 2;
            const f32x4 gq = (c == 0) ? gc[0] : (c == 1) ? gc[1] : (c == 2) ? gc[2] : gc[3]; const f32x4 au = a[j] * gq;
            unsigned pu4 = 0, pv4 = 0;
            pu4 = __builtin_amdgcn_cvt_scalef32_pk_fp4_f32(pu4, au[0] * U4_SCALE, au[1] * U4_SCALE, 1.0f, 0); pu4 = __builtin_amdgcn_cvt_scalef32_pk_fp4_f32(pu4, au[2] * U4_SCALE, au[3] * U4_SCALE, 1.0f, 1);
            pv4 = __builtin_amdgcn_cvt_scalef32_pk_fp4_f32(pv4, b[j][0] * V4_SCALE, b[j][1] * V4_SCALE, 1.0f, 0); pv4 = __builtin_amdgcn_cvt_scalef32_pk_fp4_f32(pv4, b[j][2] * V4_SCALE, b[j][3] * V4_SCALE, 1.0f, 1);
            *(unsigned short*)((unsigned char*)F.UB + dst) = (unsigned short)pu4; *(unsigned short*)((unsigned char*)F.VB + dst) = (unsigned short)pv4; }
    }
}
__device__ __forceinline__ void late_weights_job(Ctx& F, float* scr, int gw, int NGW, size_t gt, size_t NGT) {
    constexpr int I_O = 16 * 32, I_Q = 16 * 64;
    for (int it = gw; it < I_O + I_Q; it += NGW) {
        if (it < I_O) transpose_item<false>(F.w_o, 1024, 1024, F.WO, scr, it, 32, F.lane);
        else transpose_item<false, true>(F.pwq, 1024, 2048, F.WQ, scr, it - I_O, 64, F.lane, F.g2); }
    for (size_t i = gt; i < (size_t)(8 * 128 * 128) / 8; i += NGT) { cvt8(F.pk1, F.K1, i * 8); cvt8(F.pk2, F.K2, i * 8); }
}
__device__ __forceinline__ void phase_prologue(Ctx& F) {
    float* scr = (float*)(F.lds + F.wave * 16384);
    const int gw = F.bid * NWAVES + F.wave, NGW = F.G * NWAVES;
    constexpr int I_IN = 16 * (NPROJ_T / 32);
    const size_t gt = (size_t)F.bid * NTHR + F.tid, NGT = (size_t)F.G * NTHR;
    for (int st = 0; st < 2; ++st) { const int which = (st + F.wave) & 1;
    if (which == 0) {
    for (int it = gw; it < I_IN; it += NGW) transpose_item<true>(F.w_in, 1024, 7240, F.WIN, scr, it, NPROJ_T / 32, F.lane);
    } else {
    rms_rows(F.x, F.g1, F.XN, gw, NGW, F.lane);
    } }
    if (!F.late_jobs) { late_weights_job(F, scr, gw, NGW, gt, NGT); tables_job(F, gt, NGT); }
}

__device__ __forceinline__ void rope_cs(float pos, int i, float inv_half, float& c, float& s) {
    const float inv = exp2f(-(float)i * inv_half * LOG2_THETA), ang = pos * inv;
    float rev = ang * 0.15915494309189535f; rev -= floorf(rev);
    s = __builtin_amdgcn_sinf(rev); c = __builtin_amdgcn_cosf(rev);
}
__device__ __forceinline__ void phase_ki(Ctx& F) {
    typedef short bf16x8 __attribute__((ext_vector_type(8)));
    int lane = F.lane; asm volatile("" : "+v"(lane));
    const int w = F.wave, fr = lane & 15, fq = lane >> 4;
    LAS f32x4* red = (LAS f32x4*)F.lds;
    for (int tb = F.bid; tb < T / 64; tb += F.G) {
        const char* Ab = (const char*)F.XN + ((size_t)(tb * 64 + fr) * 1024 + w * 128 + fq * 8) * 2;
        const char* Bb = (const char*)F.WIN + ((size_t)NPROJ * 1024 + ((size_t)(4 * w) * 64 + lane) * 8) * 2;
        bf16x8 a[4][4], b[5][4];
#pragma unroll
        for (int kk = 0; kk < 4; ++kk) {
#pragma unroll
            for (int m = 0; m < 4; ++m) a[m][kk] = *(const bf16x8*)(Ab + m * (16 * 2048) + kk * 64);
#pragma unroll
            for (int n = 0; n < 5; ++n) b[n][kk] = *(const bf16x8*)(Bb + (n * 32 + kk) * 1024); }
        __builtin_amdgcn_sched_barrier(0);
        f32x4 acc[4][5];
#pragma unroll
        for (int m = 0; m < 4; ++m)
#pragma unroll
            for (int n = 0; n < 5; ++n) acc[m][n] = (f32x4){0.f, 0.f, 0.f, 0.f};
#pragma unroll
        for (int kk = 0; kk < 4; ++kk)
#pragma unroll
            for (int m = 0; m < 4; ++m)
#pragma unroll
                for (int n = 0; n < 5; ++n) acc[m][n] = __builtin_amdgcn_mfma_f32_16x16x32_bf16(b[n][kk], a[m][kk], acc[m][n], 0, 0, 0);
        LAS f32x4* mine = red + (w & 3) * (20 * 64) + lane;
        if (w >= 4) {
#pragma unroll
            for (int m = 0; m < 4; ++m)
#pragma unroll
                for (int n = 0; n < 5; ++n) mine[(m * 5 + n) * 64] = acc[m][n]; }
        __syncthreads();
        if (w < 4) {
#pragma unroll
            for (int m = 0; m < 4; ++m)
#pragma unroll
                for (int n = 0; n < 5; ++n) mine[(m * 5 + n) * 64] = acc[m][n] + mine[(m * 5 + n) * 64]; }
        __syncthreads();
        const int mf = w & 3, token = tb * 64 + mf * 16 + fr, nf0 = (w < 4) ? 0 : 3, nfn = (w < 4) ? 3 : 2;
        for (int q = 0; q < nfn; ++q) { const int nf = nf0 + q; LAS f32x4* rp = red + (mf * 5 + nf) * 64 + lane;
            f32x4 v = (rp[0] + rp[20 * 64]) + (rp[40 * 64] + rp[60 * 64]);
            if (nf == 0) { const float pos = (float)(token & 2047);
#pragma unroll
                for (int r = 0; r < 4; ++r) { const float o = __shfl_xor(v[r], 32); float c, s; rope_cs(pos, 4 * (fq & 1) + r, 1.f / 8.f, c, s); v[r] = (fq < 2) ? v[r] * c - o * s : v[r] * c + o * s; } }
            if (nf < 4) { v2u o; o.x = pk2(v[0], v[1]); o.y = pk2(v[2], v[3]);
                *(v2u*)(F.KI + ((((size_t)(token >> 5) * 4 + nf) * 64 + ((fq >> 1) & 1) * 32 + (token & 31)) * 8 + (fq & 1) * 4)) = o; }
            else if (fq < 2) *(f32x4*)(F.WI + (size_t)token * 8 + fq * 4) = v * IDX_W_SCALE; }
        __syncthreads();
    }
}

__device__ __forceinline__ void phase_post(Ctx& F) {
    const int gw = F.bid * NWAVES + F.wave, NGW = F.G * NWAVES, lane = F.lane;
    const int gt = F.bid * NTHR + F.tid, NGT = F.G * NTHR;
    for (int st = 0; st < 2; ++st) { const int which = (st + F.wave) & 1;
    if (which == 0) {
    { constexpr int NWI = T * 2 / 8; const int sub = lane & 7;
      for (int wi0 = gw; wi0 < NWI; wi0 += 4 * NGW) {
        bf16* p[4]; const float* g[4]; v4u a[4], b[4]; float pos[4];
#pragma unroll
        for (int j = 0; j < 4; ++j) { const int wi = (wi0 + j * NGW < NWI) ? wi0 + j * NGW : wi0; const int unit = wi * 8 + (lane >> 3), t = unit >> 1, hh = unit & 1;
            p[j] = F.K + (size_t)t * 256 + hh * 128 + sub * 16;
            g[j] = F.kg + sub * 16; pos[j] = (float)(t & (SEQ - 1));
            a[j] = *(const v4u*)p[j]; b[j] = *(const v4u*)(p[j] + 8); }
#pragma unroll
        for (int j = 0; j < 4; ++j) {
            float v[16];
            v[0] = bflo(a[j].x); v[1] = bfhi(a[j].x); v[2] = bflo(a[j].y); v[3] = bfhi(a[j].y); v[4] = bflo(a[j].z); v[5] = bfhi(a[j].z); v[6] = bflo(a[j].w); v[7] = bfhi(a[j].w);
            v[8] = bflo(b[j].x); v[9] = bfhi(b[j].x); v[10] = bflo(b[j].y); v[11] = bfhi(b[j].y); v[12] = bflo(b[j].z); v[13] = bfhi(b[j].z); v[14] = bflo(b[j].w); v[15] = bfhi(b[j].w);
            float ss = 0.f;
#pragma unroll
            for (int i = 0; i < 16; ++i) ss += v[i] * v[i];
            ss += __int_as_float(__builtin_amdgcn_mov_dpp(__float_as_int(ss), DPP_XOR1, 0xF, 0xF, true)); ss += __int_as_float(__builtin_amdgcn_mov_dpp(__float_as_int(ss), DPP_XOR2, 0xF, 0xF, true)); ss += __shfl_xor(ss, 4);
            const float rstd = rsqrtf(ss * (1.f / 128.f) + EPS);
#pragma unroll
            for (int i = 0; i < 16; ++i) v[i] = v[i] * rstd * g[j][i];
#pragma unroll
            for (int i = 0; i < 16; ++i) { const float o = __int_as_float(__builtin_amdgcn_mov_dpp(__float_as_int(v[i]), DPP_XOR1, 0xF, 0xF, true)); float c, s; rope_cs(pos[j], i, 1.f / 16.f, c, s);
                if (sub == 0) v[i] = v[i] * c - o * s; else if (sub == 1) v[i] = v[i] * c + o * s; }
            v4u oa, ob;
            oa.x = pk2(v[0], v[1]); oa.y = pk2(v[2], v[3]); oa.z = pk2(v[4], v[5]); oa.w = pk2(v[6], v[7]);
            ob.x = pk2(v[8], v[9]); ob.y = pk2(v[10], v[11]); ob.z = pk2(v[12], v[13]); ob.w = pk2(v[14], v[15]);
            if (j == 0 || wi0 + j * NGW < NWI) { *(v4u*)p[j] = oa; *(v4u*)(p[j] + 8) = ob; }
        }
      } }
    } else {
    for (int id0 = gt; id0 < T * 128; id0 += 4 * NGT) {
        v4u p1[4], u0[4], u1[4], u2[4]; f32x4 w[4][6]; size_t o[4];
#pragma unroll
        for (int j = 0; j < 4; ++j) { int id = id0 + j * NGT; if (id >= T * 128) id = id0; const int t = id >> 7, c8 = (id & 127) * 8, s = t & (SEQ - 1); o[j] = (size_t)t * 1024 + c8;
            p1[j] = *(const v4u*)(F.P1 + o[j]); u0[j] = *(const v4u*)(F.U + o[j]);
            u1[j] = (s >= 1) ? *(const v4u*)(F.U + o[j] - 1024) : (v4u){0u, 0u, 0u, 0u};
            u2[j] = (s >= 2) ? *(const v4u*)(F.U + o[j] - 2048) : (v4u){0u, 0u, 0u, 0u};
#pragma unroll
            for (int r = 0; r < 3; ++r) { w[j][2 * r] = *(const f32x4*)(F.conv_w + r * 1024 + c8); w[j][2 * r + 1] = *(const f32x4*)(F.conv_w + r * 1024 + c8 + 4); } }
#pragma unroll
        for (int j = 0; j < 4; ++j) { v4u r;
#define CV(pw, a0, a1, a2, i0, i1, W0, W1, W2) pk2(bflo(pw) * (W0[i0] * bflo(a2) + W1[i0] * bflo(a1) + W2[i0] * bflo(a0)), bfhi(pw) * (W0[i1] * bfhi(a2) + W1[i1] * bfhi(a1) + W2[i1] * bfhi(a0)))
            r.x = CV(p1[j].x, u0[j].x, u1[j].x, u2[j].x, 0, 1, w[j][0], w[j][2], w[j][4]); r.y = CV(p1[j].y, u0[j].y, u1[j].y, u2[j].y, 2, 3, w[j][0], w[j][2], w[j][4]);
            r.z = CV(p1[j].z, u0[j].z, u1[j].z, u2[j].z, 0, 1, w[j][1], w[j][3], w[j][5]); r.w = CV(p1[j].w, u0[j].w, u1[j].w, u2[j].w, 2, 3, w[j][1], w[j][3], w[j][5]);
#undef CV
            if (j == 0 || id0 + j * NGT < T * 128) *(v4u*)(F.P1 + o[j]) = r; }
    }
    } }
}

__device__ __forceinline__ unsigned f2key(float f) { const unsigned u = __builtin_bit_cast(unsigned, f); return (u >> 31) ? ~u : (u | 0x80000000u); }
__device__ __forceinline__ unsigned causal_word(int j, int s) { const int lo = 32 * j; return (lo + 31 <= s) ? 0xffffffffu : (lo > s ? 0u : ((1u << (s - lo + 1)) - 1u)); }
__device__ __forceinline__ void phase_indexer_simple(Ctx& F) {
    float* qf = (float*)F.lds; float* wsc = qf + 512; int* cnts = (int*)(wsc + 8); unsigned* gew = (unsigned*)(cnts + 16); unsigned* gtw = gew + 64;
    const int tid = F.tid, lane = F.lane, wave = F.wave;
    for (int t = F.bid; t < T; t += F.G) {
        const int s = t & (SEQ - 1), b = t >> 11;
        unsigned* mrow = F.MASK + (size_t)t * 64;
        if (s < 256) { if (tid < 64) mrow[tid] = causal_word(tid, s); continue; }
        qf[tid] = bf1(F.QI[(size_t)t * 512 + tid]); if (tid < 8) wsc[tid] = F.WI[(size_t)t * 8 + tid] * IDX_SCALE;
        __syncthreads();
        unsigned key[4];
#pragma unroll 1
        for (int j = 0; j < 4; ++j) {
            const int sk = tid + 512 * j; key[j] = 0u;
            if (sk <= s) {
                const v4u* kr = (const v4u*)(F.KI + ((size_t)b * SEQ + sk) * 64);
                float kf[64];
#pragma unroll
                for (int c = 0; c < 8; ++c) { const v4u w = kr[c]; kf[8 * c] = bflo(w.x); kf[8 * c + 1] = bfhi(w.x); kf[8 * c + 2] = bflo(w.y); kf[8 * c + 3] = bfhi(w.y); kf[8 * c + 4] = bflo(w.z); kf[8 * c + 5] = bfhi(w.z); kf[8 * c + 6] = bflo(w.w); kf[8 * c + 7] = bfhi(w.w); }
                float sc = 0.f;
#pragma unroll
                for (int h = 0; h < 8; ++h) { float d = 0.f;
#pragma unroll
                    for (int e = 0; e < 64; ++e) d += qf[h * 64 + e] * kf[e];
                    sc += wsc[h] * fmaxf(d, 0.f); }
                key[j] = f2key(sc);
            }
        }
        unsigned thr = 0u;
        for (int bit = 31; bit >= 0; --bit) {
            const unsigned cand = thr | (1u << bit);
            int c = (key[0] >= cand) + (key[1] >= cand) + (key[2] >= cand) + (key[3] >= cand);
            c = wave_sumi(c);
            if (lane == 0) cnts[(bit & 1) * 8 + wave] = c;
            __syncthreads();
            int tot = 0;
#pragma unroll
            for (int w = 0; w < 8; ++w) tot += cnts[(bit & 1) * 8 + w];
            if (tot >= 256) thr = cand;
        }
#pragma unroll
        for (int j = 0; j < 4; ++j) { const unsigned long long ge = __ballot(key[j] >= thr), gt = __ballot(key[j] > thr);
            if (lane == 0) { const int w = 16 * j + 2 * wave; gew[w] = (unsigned)ge; gew[w + 1] = (unsigned)(ge >> 32); gtw[w] = (unsigned)gt; gtw[w + 1] = (unsigned)(gt >> 32); } }
        __syncthreads();
        if (wave == 0) {
            const unsigned ge = gew[lane], gt = gtw[lane], eq = ge & ~gt;
            const int need = 256 - wave_sumi(__popc(gt)), pe = __popc(eq), excl = wave_incl_scan(pe, lane) - pe;
            const int keep = min(max(need - excl, 0), pe);
            unsigned kept = 0u, e = eq;
            for (int i = 0; i < keep; ++i) { const unsigned bb = e & (0u - e); kept |= bb; e ^= bb; }
            mrow[lane] = (gt | kept) & causal_word(lane, s);
        }
        __syncthreads();
    }
}

__device__ __forceinline__ unsigned idx_fixup(unsigned ge, unsigned gt, int lane) {
    const unsigned eq = ge & ~gt;
    const int need = 256 - wave_sumi(__popc(gt)), pe = __popc(eq), excl = wave_incl_scan(pe, lane) - pe;
    const int keep = min(max(need - excl, 0), pe);
    unsigned kept = 0u, e = eq;
    for (int i = 0; i < keep; ++i) { const unsigned bb = e & (0u - e); kept |= bb; e ^= bb; }
    return gt | kept;
}
__device__ __forceinline__ void phase_indexer(Ctx& F) {
    typedef short bf16x8 __attribute__((ext_vector_type(8)));
    typedef float f32x16 __attribute__((ext_vector_type(16)));
    for (int vw = F.bid * NWAVES + F.wave; vw < 2048; vw += F.G * NWAVES) {
        const int vb = vw >> 3, batch = vb & 7, p = (vb >> 3) * 8 + (vw & 7);
#pragma unroll 1
        for (int pass = 0; pass < 2; ++pass) {
            int lane = F.lane; asm volatile("" : "+v"(lane));
            const int r32 = lane & 31, hi = lane >> 5;
            const int gi = ((pass != 0) != (F.wave >= 4)) ? 511 - p : p, s0 = gi * 4; const size_t tok0 = (size_t)batch * SEQ + s0;
            unsigned* mrow = F.MASK + tok0 * 64;
            if (s0 + 3 < 256) {
#pragma unroll
                for (int tk = 0; tk < 4; ++tk) mrow[tk * 64 + lane] = causal_word(lane, s0 + tk);
                continue;
            }
            bf16x8 aq[4];
            { const size_t trow = tok0 + 2 * ((r32 >> 2) & 1) + (r32 >> 4); const int hrow = (r32 & 3) + 4 * ((r32 >> 3) & 1);
              const bf16* qp = F.QI + trow * 512 + hrow * 64 + 8 * hi;
#pragma unroll
              for (int s = 0; s < 4; ++s) aq[s] = *(const bf16x8*)(qp + 16 * s); }
            float w0[8], w1[8];
            { const f32x4* wp = (const f32x4*)(F.WI + (tok0 + 2 * hi) * 8); const f32x4 a = wp[0], b = wp[1], c = wp[2], d = wp[3];
              w0[0] = a[0] * IDX_SCALE; w0[1] = a[1] * IDX_SCALE; w0[2] = a[2] * IDX_SCALE; w0[3] = a[3] * IDX_SCALE; w0[4] = b[0] * IDX_SCALE; w0[5] = b[1] * IDX_SCALE; w0[6] = b[2] * IDX_SCALE; w0[7] = b[3] * IDX_SCALE;
              w1[0] = c[0] * IDX_SCALE; w1[1] = c[1] * IDX_SCALE; w1[2] = c[2] * IDX_SCALE; w1[3] = c[3] * IDX_SCALE; w1[4] = d[0] * IDX_SCALE; w1[5] = d[1] * IDX_SCALE; w1[6] = d[2] * IDX_SCALE; w1[7] = d[3] * IDX_SCALE; }
            const int jmax = (s0 + 3) >> 5;
            const bf16* kp = F.KI + (size_t)batch * SEQ * 64 + lane * 8;
            unsigned ka[64], kb[64];
            bf16x8 bq[2][4];
#pragma unroll
            for (int s = 0; s < 4; ++s) bq[0][s] = *(const bf16x8*)(kp + 512 * s);
#pragma unroll
            for (int j = 0; j < 64; ++j) {
                unsigned k0 = 0u, k1 = 0u;
                if (j <= jmax) {
                    if (j + 1 <= jmax) {
#pragma unroll
                        for (int s = 0; s < 4; ++s) bq[(j + 1) & 1][s] = *(const bf16x8*)(kp + (size_t)(j + 1) * 2048 + 512 * s); }
                    f32x16 acc = {};
#pragma unroll
                    for (int s = 0; s < 4; ++s) acc = __builtin_amdgcn_mfma_f32_32x32x16_bf16(aq[s], bq[j & 1][s], acc, 0, 0, 0);
                    float sc0 = 0.f, sc1 = 0.f;
#pragma unroll
                    for (int h = 0; h < 8; ++h) { sc0 += w0[h] * fmaxf(acc[h], 0.f); sc1 += w1[h] * fmaxf(acc[8 + h], 0.f); }
                    k0 = f2key(sc0); k1 = f2key(sc1);
                    if (j == jmax) { const int kpos = 32 * j + r32; if (kpos > s0 + 2 * hi) k0 = 0u; if (kpos > s0 + 2 * hi + 1) k1 = 0u; }
                }
                asm volatile("" : "+v"(k0), "+v"(k1));
                ka[j] = k0; kb[j] = k1;
            }
            unsigned t0 = 0u, t1 = 0u; int n0 = 2048, n1 = 2048;
#pragma unroll 1
            for (int bit = 31; bit >= 0; --bit) {
                const unsigned c0 = t0 | (1u << bit), c1 = t1 | (1u << bit);
                int a0 = 0, a1 = 0;
#pragma unroll
                for (int j8 = 0; j8 < 64; j8 += 8) if (j8 <= jmax) {
#pragma unroll
                    for (int j = j8; j < j8 + 8; ++j) {
                        asm("v_cmp_ge_u32 vcc, %1, %2\n\tv_addc_co_u32 %0, vcc, 0, %0, vcc" : "+v"(a0) : "v"(ka[j]), "v"(c0) : "vcc");
                        asm("v_cmp_ge_u32 vcc, %1, %2\n\tv_addc_co_u32 %0, vcc, 0, %0, vcc" : "+v"(a1) : "v"(kb[j]), "v"(c1) : "vcc"); } }
                int c = a0 | (a1 << 16);
                c += __builtin_amdgcn_mov_dpp(c, DPP_XOR1, 0xF, 0xF, true); c += __builtin_amdgcn_mov_dpp(c, DPP_XOR2, 0xF, 0xF, true);
                c += __builtin_amdgcn_mov_dpp(c, DPP_ROR(4), 0xF, 0xF, true) + __builtin_amdgcn_mov_dpp(c, DPP_ROR(8), 0xF, 0xF, true) + __builtin_amdgcn_mov_dpp(c, DPP_ROR(12), 0xF, 0xF, true);
                c += __shfl_xor(c, 16);
                const int tot0 = c & 0xffff, tot1 = c >> 16;
                if (tot0 >= 256) { t0 = c0; n0 = tot0; }
                if (tot1 >= 256) { t1 = c1; n1 = tot1; }
                if (__all(n0 == 256 && n1 == 256)) break;
            }
            unsigned* mt = (unsigned*)(F.lds + F.wave * 2048);
#pragma unroll
            for (int j = 0; j < 64; ++j) { const unsigned long long g0 = __ballot(ka[j] >= t0), g1 = __ballot(kb[j] >= t1);
                if (lane == 0) *(v4u*)(mt + 4 * j) = (v4u){(unsigned)g0, (unsigned)g1, (unsigned)(g0 >> 32), (unsigned)(g1 >> 32)};
                __builtin_amdgcn_sched_barrier(0); }
            LDS_WAIT(); asm volatile("" ::: "memory");
            unsigned mA = mt[4 * lane], mB = mt[4 * lane + 1], mC = mt[4 * lane + 2], mD = mt[4 * lane + 3];
            LDS_WAIT(); asm volatile("" ::: "memory");
            if (!__all(n0 == 256 && n1 == 256)) {
#pragma unroll
                for (int j = 0; j < 64; ++j) { const unsigned long long g0 = __ballot(ka[j] > t0), g1 = __ballot(kb[j] > t1);
                    if (lane == 0) *(v4u*)(mt + 4 * j) = (v4u){(unsigned)g0, (unsigned)g1, (unsigned)(g0 >> 32), (unsigned)(g1 >> 32)};
                    __builtin_amdgcn_sched_barrier(0); }
                LDS_WAIT(); asm volatile("" ::: "memory");
                const unsigned gA = mt[4 * lane], gB = mt[4 * lane + 1], gC = mt[4 * lane + 2], gD = mt[4 * lane + 3];
                LDS_WAIT(); asm volatile("" ::: "memory");
                mA = idx_fixup(mA, gA, lane); mB = idx_fixup(mB, gB, lane); mC = idx_fixup(mC, gC, lane); mD = idx_fixup(mD, gD, lane);
            }
            mrow[lane] = mA & causal_word(lane, s0); mrow[64 + lane] = mB & causal_word(lane, s0 + 1);
            mrow[128 + lane] = mC & causal_word(lane, s0 + 2); mrow[192 + lane] = mD & causal_word(lane, s0 + 3);
        }
    }
}

__device__ __forceinline__ void phase_attn_simple(Ctx& F) {
    int* list = (int*)F.lds; int* nselp = list + 256; float* qf = (float*)(F.lds + 2048); float* pbuf = (float*)(F.lds + 8192);
    const int lane = F.lane, h = F.wave;
    for (int t = F.bid; t < T; t += F.G) {
        const int b = t >> 11;
        if (h == 0) { unsigned w = F.MASK[(size_t)t * 64 + lane]; const int pc = __popc(w), incl = wave_incl_scan(pc, lane); int o = incl - pc;
            while (w) { const int bp = __ffs((int)w) - 1; list[o++] = 32 * lane + bp; w &= w - 1u; }
            if (lane == 63) *nselp = incl; }
        { const unsigned qq = *(const unsigned*)(F.Q + (size_t)t * 1024 + h * 128 + 2 * lane); qf[h * 128 + 2 * lane] = bflo(qq) * ATTN_SCALE; qf[h * 128 + 2 * lane + 1] = bfhi(qq) * ATTN_SCALE; }
        __syncthreads();
        const int nsel = *nselp;
        const bf16* Kb = F.K + (size_t)b * SEQ * 256 + (h >> 2) * 128; const bf16* Vb = F.V + (size_t)b * SEQ * 256 + (h >> 2) * 128;
        float sc[4]; float mx = -__builtin_inff();
#pragma unroll 1
        for (int r = 0; r < 4; ++r) { const int idx = lane + 64 * r; sc[r] = -__builtin_inff();
            if (idx < nsel) { const v4u* kr = (const v4u*)(Kb + (size_t)list[idx] * 256); float d = 0.f;
#pragma unroll
                for (int c = 0; c < 16; ++c) { const v4u w = kr[c]; const float* q = qf + h * 128 + 8 * c;
                    d += q[0] * bflo(w.x) + q[1] * bfhi(w.x) + q[2] * bflo(w.y) + q[3] * bfhi(w.y) + q[4] * bflo(w.z) + q[5] * bfhi(w.z) + q[6] * bflo(w.w) + q[7] * bfhi(w.w); }
                sc[r] = d; }
            mx = fmaxf(mx, sc[r]); }
        mx = wave_max(mx);
        float ls = 0.f;
#pragma unroll
        for (int r = 0; r < 4; ++r) { const int idx = lane + 64 * r; const float p = (idx < nsel) ? __expf(sc[r] - mx) : 0.f; pbuf[h * 256 + idx] = p; ls += p; }
        ls = wave_sum(ls);
        __syncthreads();
        float a0 = 0.f, a1 = 0.f;
        for (int i = 0; i < nsel; ++i) { const float p = pbuf[h * 256 + i]; const unsigned vv = *(const unsigned*)(Vb + (size_t)list[i] * 256 + 2 * lane); a0 += p * bflo(vv); a1 += p * bfhi(vv); }
        const float inv = 1.f / ls; const size_t o = (size_t)t * 1024 + h * 128 + 2 * lane;
        const unsigned ya = *(const unsigned*)(F.P1 + o), sg = *(const unsigned*)(F.SGB + o);
        *(unsigned*)(F.XN + o) = pk2(bflo(ya) + bflo(sg) * a0 * inv, bfhi(ya) + bfhi(sg) * a1 * inv);
        __syncthreads();
    }
}

namespace att {
typedef short bf16x8 __attribute__((ext_vector_type(8)));
typedef short s16x4 __attribute__((ext_vector_type(4)));
typedef float f32x16 __attribute__((ext_vector_type(16)));
typedef unsigned u32x4 __attribute__((ext_vector_type(4)));
typedef unsigned u32x2 __attribute__((ext_vector_type(2)));
constexpr int DH = 128, QS = 1024, KVS = 256;
constexpr float SCALE = 0.08838834764831845f, THR = 8.f;
constexpr int NW = 8, QBLK = 32, KVBLK = 64, QB = NW * QBLK;
constexpr int SHM_V = KVBLK * DH * 2, SHM_K = KVBLK * DH * 2;
constexpr int OST_OFF = 2 * SHM_V + 2 * SHM_K + NW * 64 * 4, OST_PITCH = 272, OST_WAVE = 32 * OST_PITCH;
constexpr int LDS_BYTES = OST_OFF + NW * OST_WAVE;
#define KSWZ(row, colB) ((row) * 256 + ((colB) ^ (((row) & 7) << 4)))
#define SBAR() __builtin_amdgcn_sched_barrier(0)
__device__ __forceinline__ int v_st(int k, int c) { const int kk = (k & ~0xC) | ((k & 4) << 1) | ((k & 8) >> 1); return ((kk >> 3) * 4 + (c >> 5)) * 512 + ((kk & 7) * 32 + (c & 31)) * 2; }
__device__ __forceinline__ int v_rd_base(int lane) { return ((lane & 3) << 3) | (((lane >> 2) & 3) << 6) | (((lane >> 4) & 1) << 5) | (((lane >> 5) & 1) << 8); }
constexpr int v_rd_off(int d0, int ks, int half) { return d0 * 512 + ks * 4096 + half * 2048; }
__device__ __forceinline__ int crow(int r, int hi) { return (r & 3) + 8 * (r >> 2) + 4 * hi; }
__device__ __forceinline__ unsigned cvtpk(float lo, float hi) { unsigned r; asm volatile("v_cvt_pk_bf16_f32 %0, %1, %2" : "=v"(r) : "v"(lo), "v"(hi)); return r; }
__device__ __forceinline__ bf16x8 load8(const unsigned short* p) { return *reinterpret_cast<const bf16x8*>(p); }
__device__ __forceinline__ void partialSM(f32x16& p0, f32x16& p1, float& m_reg, float& mn, float& alpha) {
    float pmax = p0[0];
#pragma unroll
    for (int r = 1; r < 16; ++r) pmax = fmaxf(pmax, p0[r]);
#pragma unroll
    for (int r = 0; r < 16; ++r) pmax = fmaxf(pmax, p1[r]);
    { auto rr = __builtin_amdgcn_permlane32_swap(__float_as_uint(pmax), __float_as_uint(pmax), false, false);
      pmax = fmaxf(__uint_as_float(rr[0]), __uint_as_float(rr[1])); }
    constexpr float C2 = 1.4426950408889634f * SCALE;
    if (__builtin_expect(__all((pmax - m_reg) * SCALE <= THR), 1)) { mn = m_reg; alpha = 1.f; }
    else { mn = fmaxf(m_reg, pmax); alpha = __builtin_amdgcn_exp2f((m_reg - mn) * C2); m_reg = mn; }
    const float mnL = -mn * C2;
#pragma unroll
    for (int r = 0; r < 16; ++r) p0[r] = fmaf(p0[r], C2, mnL);
#pragma unroll
    for (int r = 0; r < 16; ++r) p1[r] = fmaf(p1[r], C2, mnL);
#pragma unroll
    for (int r = 0; r < 16; ++r) p0[r] = __builtin_amdgcn_exp2f(p0[r]);
}
__device__ __forceinline__ void finishSM(f32x16& p0, f32x16& p1, u32x2 mw, float alpha, float& l_reg, bf16x8& pa0, bf16x8& pa1, bf16x8& pa2, bf16x8& pa3) {
#pragma unroll
    for (int r = 0; r < 16; ++r) p1[r] = __builtin_amdgcn_exp2f(p1[r]);
#pragma unroll
    for (int r = 0; r < 16; ++r) { const int c = (r & 3) + 8 * (r >> 2);
        float t0, t1;
        asm("v_bfe_i32 %0, %1, %2, 1\n\tv_and_b32 %0, %3, %0" : "=&v"(t0) : "v"(mw.x), "n"(c), "v"(p0[r]));
        asm("v_bfe_i32 %0, %1, %2, 1\n\tv_and_b32 %0, %3, %0" : "=&v"(t1) : "v"(mw.y), "n"(c), "v"(p1[r]));
        p0[r] = t0; p1[r] = t1; }
    float ps = 0;
#pragma unroll
    for (int r = 0; r < 16; ++r) ps += p0[r];
#pragma unroll
    for (int r = 0; r < 16; ++r) ps += p1[r];
    { auto rr = __builtin_amdgcn_permlane32_swap(__float_as_uint(ps), __float_as_uint(ps), false, false);
      ps = __uint_as_float(rr[0]) + __uint_as_float(rr[1]); }
    l_reg = l_reg * alpha + ps;
#define PK4(P, B_, OUT) do { unsigned a0 = cvtpk(P[B_+0], P[B_+1]), a1 = cvtpk(P[B_+2], P[B_+3]);                          \
        unsigned b0 = cvtpk(P[B_+4], P[B_+5]), b1 = cvtpk(P[B_+6], P[B_+7]);                                             \
        auto r0 = __builtin_amdgcn_permlane32_swap(a0, b0, false, false); auto r1 = __builtin_amdgcn_permlane32_swap(a1, b1, false, false); \
        u32x4 w = {r0[0], r1[0], r0[1], r1[1]}; OUT = *reinterpret_cast<bf16x8*>(&w); } while (0)
    PK4(p0, 0, pa0); PK4(p0, 8, pa1); PK4(p1, 0, pa2); PK4(p1, 8, pa3);
#undef PK4
}
template <int KB>
__device__ __forceinline__ void qkt(f32x16& p0, f32x16& p1, const char* K_lds, int r32, int hi, const bf16x8* qr) {
    p0 = f32x16{}; p1 = f32x16{};
    const char* kb[4];
#pragma unroll
    for (int dd = 0; dd < 4; ++dd) kb[dd] = K_lds + KB * SHM_K + KSWZ(r32, (dd * 16 + hi * 8) * 2);
#pragma unroll
    for (int d0 = 0; d0 < 8; ++d0) { const char* a = kb[d0 & 3] + (d0 >> 2) * 128;
        bf16x8 b0 = *reinterpret_cast<const bf16x8*>(a);
        bf16x8 b1 = *reinterpret_cast<const bf16x8*>(a + 32 * 256);
        p0 = __builtin_amdgcn_mfma_f32_32x32x16_bf16(b0, qr[d0], p0, 0, 0, 0);
        p1 = __builtin_amdgcn_mfma_f32_32x32x16_bf16(b1, qr[d0], p1, 0, 0, 0); }
}
template <int VB>
__device__ __forceinline__ void pv_tile(f32x16* o, int vb0, bf16x8 pa0, bf16x8 pa1, bf16x8 pa2, bf16x8 pa3) {
#define TRRD(dst, off) asm volatile("ds_read_b64_tr_b16 %0, %1 offset:%2" : "=&v"(dst) : "v"(vb0), "i"(off) : "memory")
#define PV_D0(d0) do { s16x4 l0, l1, l2, l3, h0, h1, h2, h3; constexpr int b_ = VB * SHM_V + v_rd_off(d0, 0, 0); \
        TRRD(l0, b_); TRRD(h0, b_ + 2048); TRRD(l1, b_ + 4096); TRRD(h1, b_ + 6144); TRRD(l2, b_ + 8192); TRRD(h2, b_ + 10240); TRRD(l3, b_ + 12288); TRRD(h3, b_ + 14336); \
        asm volatile("s_waitcnt lgkmcnt(0)" ::: "memory"); SBAR();   \
        o[d0] = __builtin_amdgcn_mfma_f32_32x32x16_bf16(pa0, (bf16x8){l0[0], l0[1], l0[2], l0[3], h0[0], h0[1], h0[2], h0[3]}, o[d0], 0, 0, 0);   \
        o[d0] = __builtin_amdgcn_mfma_f32_32x32x16_bf16(pa1, (bf16x8){l1[0], l1[1], l1[2], l1[3], h1[0], h1[1], h1[2], h1[3]}, o[d0], 0, 0, 0);   \
        o[d0] = __builtin_amdgcn_mfma_f32_32x32x16_bf16(pa2, (bf16x8){l2[0], l2[1], l2[2], l2[3], h2[0], h2[1], h2[2], h2[3]}, o[d0], 0, 0, 0);   \
        o[d0] = __builtin_amdgcn_mfma_f32_32x32x16_bf16(pa3, (bf16x8){l3[0], l3[1], l3[2], l3[3], h3[0], h3[1], h3[2], h3[3]}, o[d0], 0, 0, 0); } while (0)
    PV_D0(0); PV_D0(1); PV_D0(2); PV_D0(3);
#undef PV_D0
#undef TRRD
}
struct BlockRef { const unsigned short* Q; const unsigned short* K; const unsigned short* V; const unsigned* M; const unsigned short* YA; const unsigned short* SG; unsigned short* OUT; int P0; const float* QG; };
struct Seam { bf16x8 qr[8]; bf16x8 st_v0, st_v1, st_k0, st_k1; };
#define ROWKV(p, k0, rr) ((p) + (size_t)((k0) + (rr)) * KVS + sc)
#define VMW() asm volatile("s_waitcnt vmcnt(0)" ::: "memory")
#define VMWN(n) asm volatile("s_waitcnt vmcnt(%0)" :: "i"(n) : "memory")
#define SLOAD_H(Kp, Vp, k0) do { S.st_v0 = load8(ROWKV(Vp, k0, sr)); S.st_v1 = load8(ROWKV(Vp, k0, 32 + sr)); S.st_k0 = load8(ROWKV(Kp, k0, sr)); S.st_k1 = load8(ROWKV(Kp, k0, 32 + sr)); } while (0)
#define SWRITE_HK(bf) do { *(bf16x8*)(K_lds + (bf) * SHM_K + kws) = S.st_k0; *(bf16x8*)(K_lds + (bf) * SHM_K + kws + 32 * 256) = S.st_k1; } while (0)
#define SWRITE_HV(bf) do { *(bf16x8*)(V_lds + (bf) * SHM_V + vst0) = S.st_v0; *(bf16x8*)(V_lds + (bf) * SHM_V + vst1) = S.st_v1; } while (0)
#define SWRITE_H(bf) do { SWRITE_HV(bf); SWRITE_HK(bf); } while (0)
__device__ __forceinline__ void qnorm(bf16x8 (&qr)[8], const float* qg, float pos, int hi) {
    float ss = 0.f;
#pragma unroll
    for (int d0 = 0; d0 < 8; ++d0) { const u32x4 w = *reinterpret_cast<const u32x4*>(&qr[d0]);
#pragma unroll
        for (int k = 0; k < 4; ++k) { const float lo = __uint_as_float(w[k] << 16), hf = __uint_as_float(w[k] & 0xffff0000u); ss += lo * lo + hf * hf; } }
    { auto rr = __builtin_amdgcn_permlane32_swap(__float_as_uint(ss), __float_as_uint(ss), false, false); ss = __uint_as_float(rr[0]) + __uint_as_float(rr[1]); }
    const float rstd = rsqrtf(ss * (1.f / 128.f) + EPS);
    float x1[8], x2[8];
#pragma unroll
    for (int d0 = 0; d0 < 8; ++d0) { const u32x4 w = *reinterpret_cast<const u32x4*>(&qr[d0]); const f32x4 g0 = *(const f32x4*)(qg + d0 * 16 + hi * 8), g1 = *(const f32x4*)(qg + d0 * 16 + hi * 8 + 4);
        float v[8];
#pragma unroll
        for (int k = 0; k < 4; ++k) { v[2 * k] = __uint_as_float(w[k] << 16); v[2 * k + 1] = __uint_as_float(w[k] & 0xffff0000u); }
#pragma unroll
        for (int j = 0; j < 4; ++j) { v[j] = v[j] * rstd * g0[j]; v[4 + j] = v[4 + j] * rstd * g1[j]; }
        if (d0 == 0) {
#pragma unroll
            for (int j = 0; j < 8; ++j) x1[j] = v[j];
        } else if (d0 == 1) {
#pragma unroll
            for (int j = 0; j < 8; ++j) { x2[j] = v[j]; float c, sn; rope_cs(pos, hi * 8 + j, 1.f / 16.f, c, sn); const float a = x1[j] * c - x2[j] * sn, b = x2[j] * c + x1[j] * sn; x1[j] = a; v[j] = b; }
            u32x4 o0; o0[0] = cvtpk(x1[0], x1[1]); o0[1] = cvtpk(x1[2], x1[3]); o0[2] = cvtpk(x1[4], x1[5]); o0[3] = cvtpk(x1[6], x1[7]); qr[0] = *reinterpret_cast<bf16x8*>(&o0);
        }
        if (d0 >= 1) { u32x4 o; o[0] = cvtpk(v[0], v[1]); o[1] = cvtpk(v[2], v[3]); o[2] = cvtpk(v[4], v[5]); o[3] = cvtpk(v[6], v[7]); qr[d0] = *reinterpret_cast<bf16x8*>(&o); } }
}
__device__ __forceinline__ void prime(const BlockRef& cur, char* lds, Seam& S) {
    const int tid = threadIdx.x, wid = __builtin_amdgcn_readfirstlane(tid >> 6), lane = tid & 63, r32 = lane & 31, hi = lane >> 5;
    const int sr = tid >> 4, sc = (tid & 15) * 8, kws = KSWZ(sr, sc * 2); char* K_lds = lds + 2 * SHM_V;
#pragma unroll
    for (int d0 = 0; d0 < 8; ++d0) S.qr[d0] = load8(cur.Q + (size_t)(wid * QBLK + r32) * QS + d0 * 16 + hi * 8);
    SLOAD_H(cur.K, cur.V, 0); VMW(); SWRITE_HK(0);
    __syncthreads();
}
__device__ __forceinline__ void block(const BlockRef& cur, const BlockRef& nxt, char* lds, Seam& S) {
    const int tid = threadIdx.x, wid = __builtin_amdgcn_readfirstlane(tid >> 6), lane = tid & 63, r32 = lane & 31, hi = lane >> 5;
    const int NT = (cur.P0 + QB) / KVBLK;
    char* V_lds = lds; char* K_lds = lds + 2 * SHM_V;
    float* ws = (float*)(lds + 2 * SHM_V + 2 * SHM_K) + wid * 64; float* li_l = ws, * al_l = ws + 32;
    { int hiq = hi; asm volatile("" : "+v"(hiq));
      qnorm(S.qr, cur.QG, (float)(cur.P0 + wid * QBLK + r32), hiq); }
    float m_reg = -1e30f, l_reg = 0; f32x16 o[4] = {};
    const int sr = tid >> 4, sc = (tid & 15) * 8, vst0 = v_st(sr, sc), vst1 = v_st(32 + sr, sc), kws = KSWZ(sr, sc * 2);
    const int vb0 = (int)(uintptr_t)V_lds + v_rd_base(lane);
    const unsigned short* Kh = cur.K; const unsigned short* Vh = cur.V;
    char* mlds = lds + OST_OFF + wid * OST_WAVE;
    u32x4 mrow_[8];
#pragma unroll
    for (int i = 0; i < 8; ++i) mrow_[i] = *(const u32x4*)(cur.M + (size_t)(wid * QBLK) * 64 + (size_t)(i * 64 + lane) * 4);
#define RESC(a) do { if (__any((a) < 1.f)) { if (hi == 0) al_l[r32] = (a); asm volatile("s_waitcnt lgkmcnt(0)" ::: "memory");              \
                     for (int d_ = 0; d_ < 4; ++d_) for (int r = 0; r < 16; ++r) o[d_][r] *= al_l[crow(r, hi)]; } } while (0)
#define KBASE(t) ((t) * KVBLK)
#define MLOAD(t) ({ u32x2 w_ = *(const u32x2*)(mlds + (lane & 31) * 272 + (t) * 8); w_.x >>= 4 * (lane >> 5); w_.y >>= 4 * (lane >> 5); w_; })
#define SEAM_K0() do { VMWN(8); SWRITE_HK(0); SBAR(); } while (0)
    f32x16 pA0, pA1, pB0, pB1; float mnA, mnB, alA, alB; bf16x8 pa0, pa1, pa2, pa3; u32x2 mw;
    SWRITE_HV(0); SBAR();
    if (NT > 1) { SLOAD_H(Kh, Vh, KBASE(1)); }
    SBAR(); qkt<0>(pA0, pA1, K_lds, r32, hi, S.qr);
    partialSM(pA0, pA1, m_reg, mnA, alA);
    if (NT > 1) { VMW(); SWRITE_H(1); }
#pragma unroll
    for (int i = 0; i < 8; ++i) *(u32x4*)(mlds + (i * 4 + (lane >> 4)) * 272 + (lane & 15) * 16) = mrow_[i];
    __syncthreads();
#define HALF_STEP(PX0, PX1, mnX, alX, PY0, PY1, alY, t, KB, VB, SB) do {                                              \
        mw = MLOAD((t) - 1);                                                                                                  \
        SBAR(); qkt<KB>(PX0, PX1, K_lds, r32, hi, S.qr);                                                                     \
        finishSM(PY0, PY1, mw, alY, l_reg, pa0, pa1, pa2, pa3); SBAR();                                                       \
        if ((t) + 1 < NT) { SLOAD_H(Kh, Vh, KBASE((t) + 1)); SBAR(); }                                                        \
        pv_tile<VB>(o, vb0, pa0, pa1, pa2, pa3); partialSM(PX0, PX1, m_reg, mnX, alX);                                        \
        __syncthreads();                                                                                                      \
        if ((t) + 1 < NT) { VMW(); SWRITE_H(SB); }                                                                            \
        RESC(alX); __syncthreads(); } while (0)
    for (int t = 1; t + 1 < NT; t += 2) {
        HALF_STEP(pB0, pB1, mnB, alB, pA0, pA1, alA, t, 1, 0, 0);
        HALF_STEP(pA0, pA1, mnA, alA, pB0, pB1, alB, t + 1, 0, 1, 1);
    }
    mw = MLOAD(NT - 2);
    SBAR(); qkt<1>(pB0, pB1, K_lds, r32, hi, S.qr); SBAR();
    SLOAD_H(nxt.K, nxt.V, 0); SBAR();
#pragma unroll
    for (int d0 = 0; d0 < 8; ++d0) S.qr[d0] = load8(nxt.Q + (size_t)(wid * QBLK + r32) * QS + d0 * 16 + hi * 8);
    SBAR();
    finishSM(pA0, pA1, mw, alA, l_reg, pa0, pa1, pa2, pa3); SBAR();
    mw = MLOAD(NT - 1);
    pv_tile<0>(o, vb0, pa0, pa1, pa2, pa3);
    partialSM(pB0, pB1, m_reg, mnB, alB); __syncthreads(); RESC(alB);
    finishSM(pB0, pB1, mw, alB, l_reg, pa0, pa1, pa2, pa3); SBAR(); pv_tile<1>(o, vb0, pa0, pa1, pa2, pa3);
    SBAR(); SEAM_K0();
    if (hi == 0) li_l[r32] = l_reg; asm volatile("s_waitcnt lgkmcnt(0)" ::: "memory");
    { int sbo = OST_OFF + wid * OST_WAVE + 4 * hi * OST_PITCH + r32 * 2; asm volatile("" : "+v"(sbo));
      char* sb = lds + sbo; const float* lih = li_l + 4 * hi;
#pragma unroll
      for (int r = 0; r < 16; ++r) { constexpr int dummy = 0; const int ro = (r & 3) + 8 * (r >> 2); const float rl = __builtin_amdgcn_rcpf(lih[ro]);
#pragma unroll
          for (int d0 = 0; d0 < 4; ++d0) { const unsigned pk = cvtpk(o[d0][r] * rl, 0.f); *(unsigned short*)(sb + ro * OST_PITCH + d0 * 64) = (unsigned short)pk; } }
      asm volatile("s_waitcnt lgkmcnt(0)" ::: "memory");
      int rdo = OST_OFF + wid * OST_WAVE + (lane >> 4) * OST_PITCH + (lane & 15) * 16; asm volatile("" : "+v"(rdo));
      unsigned goff = (unsigned)((wid * QBLK + (lane >> 4)) * QS + (lane & 15) * 8) * 2u; asm volatile("" : "+v"(goff));
      u32x4 yav[8], sgv[8];
#pragma unroll
      for (int i = 0; i < 8; ++i) { yav[i] = *(const u32x4*)((const char*)cur.YA + goff + i * 4 * QS * 2); sgv[i] = *(const u32x4*)((const char*)cur.SG + goff + i * 4 * QS * 2); }
      SBAR();
#pragma unroll
      for (int i = 0; i < 8; ++i) {
          const u32x4 ov = *(const u32x4*)(lds + rdo + i * 4 * OST_PITCH);
          const u32x4 ya = yav[i], sg = sgv[i]; u32x4 res;
#define MG(k) res.k = cvtpk(__uint_as_float(ya.k << 16) + __uint_as_float(sg.k << 16) * __uint_as_float(ov.k << 16), __uint_as_float(ya.k & 0xffff0000u) + __uint_as_float(sg.k & 0xffff0000u) * __uint_as_float(ov.k & 0xffff0000u))
          MG(x); MG(y); MG(z); MG(w);
#undef MG
          *(u32x4*)((char*)cur.OUT + goff + i * 4 * QS * 2) = res; } }
    __syncthreads();
#undef RESC
#undef KBASE
#undef MLOAD
#undef SEAM_K0
#undef HALF_STEP
}
#undef ROWKV
#undef VMW
#undef VMWN
#undef SLOAD_H
#undef SWRITE_HK
#undef SWRITE_HV
#undef SWRITE_H
#undef KSWZ
#undef SBAR
}
__device__ __forceinline__ att::BlockRef attn_ref(const Ctx& F, int bh, int qb) {
    const int b = bh >> 3, h = bh & 7; const size_t tok0 = (size_t)b * SEQ + (size_t)qb * 256;
    att::BlockRef r;
    r.Q = F.Q + tok0 * 1024 + h * 128; r.K = F.K + (size_t)b * SEQ * 256 + (h >> 2) * 128; r.V = F.V + (size_t)b * SEQ * 256 + (h >> 2) * 128;
    r.M = F.MASK + tok0 * 64; r.YA = F.P1 + tok0 * 1024 + h * 128; r.SG = F.SGB + tok0 * 1024 + h * 128; r.OUT = F.XN + tok0 * 1024 + h * 128; r.P0 = qb * 256; r.QG = F.qg;
    return r;
}
__device__ __forceinline__ void attn_decode(int l, int& bh, int& q0, int& q1) { const int xcd = l & 7, k = l >> 3, gi = k >> 4, r = k & 15, g = gi * 8 + xcd; bh = (g >> 1) * 8 + (g & 1) * 4 + (r >> 2); q0 = r & 3; q1 = 7 - q0; }
__device__ __forceinline__ void phase_attn(Ctx& F) {
    constexpr int NITEMS = 256;
    att::Seam S;
    int L = F.bid; if (L >= NITEMS) return;
    int bh, q0, q1; attn_decode(L, bh, q0, q1); int pass = 0;
    att::BlockRef cur = attn_ref(F, bh, q0);
    att::prime(cur, (char*)F.lds, S);
    for (;;) {
        const bool more_pass = pass == 0, more_item = L + F.G < NITEMS, last = !more_pass && !more_item;
        int bhn = bh, q0n = q0, q1n = q1, passn = pass + 1, Ln = L;
        if (!more_pass) { passn = 0; Ln = more_item ? L + F.G : L; attn_decode(Ln, bhn, q0n, q1n); }
        const att::BlockRef nxt = last ? cur : attn_ref(F, bhn, passn ? q1n : q0n);
        att::block(cur, nxt, (char*)F.lds, S);
        if (last) break;
        cur = nxt; bh = bhn; q0 = q0n; q1 = q1n; pass = passn; L = Ln;
    }
}

template <int NV, int MODE> __device__ __forceinline__ void top16(float (&v)[NV], int lane, float& outv, int& outi) {
    outv = 0.f; outi = 0;
    for (int r = 0; r < 16; ++r) {
        float m = v[0];
#pragma unroll
        for (int k = 1; k < NV; ++k) m = fmaxf(m, v[k]);
        const float M = wave_max(m);
        int ci = 0x7fffffff;
#pragma unroll
        for (int k = NV - 1; k >= 0; --k) if (v[k] == M) ci = MODE ? NV * lane + k : lane + 64 * k;
        const int I = wave_mini(ci);
#pragma unroll
        for (int k = 0; k < NV; ++k) if ((MODE ? NV * lane + k : lane + 64 * k) == I) v[k] = -__builtin_inff();
        if (lane == r) { outv = M; outi = I; }
    }
}
__device__ __forceinline__ void phase_route_simple(Ctx& F) {
    float* qf = (float*)F.lds; const int lane = F.lane, h = F.wave;
    for (int t = F.bid; t < T; t += F.G) {
        { const v2u qq = *(const v2u*)(F.PQ + (size_t)t * 2048 + h * 256 + 4 * lane); float* q = qf + h * 256 + 4 * lane; q[0] = bflo(qq.x); q[1] = bfhi(qq.x); q[2] = bflo(qq.y); q[3] = bfhi(qq.y); }
        __syncthreads();
        float s1[2], s2[2];
#pragma unroll 1
        for (int hf = 0; hf < 2; ++hf) { const bf16* kb = (hf ? F.K2 : F.K1) + (size_t)h * 128 * 128;
#pragma unroll 1
            for (int r = 0; r < 2; ++r) { const v4u* kr = (const v4u*)(kb + (size_t)(lane + 64 * r) * 128); float d = 0.f;
#pragma unroll
                for (int c = 0; c < 16; ++c) { const v4u w = kr[c]; const float* q = qf + h * 256 + hf * 128 + 8 * c;
                    d += q[0] * bflo(w.x) + q[1] * bfhi(w.x) + q[2] * bflo(w.y) + q[3] * bfhi(w.y) + q[4] * bflo(w.z) + q[5] * bfhi(w.z) + q[6] * bflo(w.w) + q[7] * bfhi(w.w); }
                if (hf) s2[r] = d; else s1[r] = d; } }
        float v1, v2; int i1, i2;
        top16<2, 0>(s1, lane, v1, i1); top16<2, 0>(s2, lane, v2, i2);
        float cand[4]; const float a = __shfl(v1, lane >> 2);
#pragma unroll
        for (int k = 0; k < 4; ++k) cand[k] = a + __shfl(v2, (lane & 3) * 4 + k);
        float ts; int pos; top16<4, 1>(cand, lane, ts, pos);
        const int e1 = __shfl(i1, (pos >> 4) & 15), e2 = __shfl(i2, pos & 15);
        const float m0 = __shfl(ts, 0); const float ex = (lane < 16) ? __expf(ts - m0) : 0.f; const float sum = wave_sum(ex);
        if (lane < 16) { F.EIDX[(size_t)t * 128 + h * 16 + lane] = e1 * 128 + e2; F.GATE[(size_t)t * 128 + h * 16 + lane] = ex / sum; }
        __syncthreads();
    }
}

namespace rt {
typedef short bf16x8 __attribute__((ext_vector_type(8)));
typedef float f32x16 __attribute__((ext_vector_type(16)));
__device__ __forceinline__ unsigned skey(float f) { const unsigned u = __float_as_uint(f); return u ^ ((unsigned)((int)u >> 31) | 0x80000000u); }
__device__ __forceinline__ float unkey(unsigned k) { return __uint_as_float((k & 0x80000000u) ? (k ^ 0x80000000u) : ~k); }
__device__ __forceinline__ void ce(unsigned& a, unsigned& b) { unsigned mx, mn; asm("v_max_f32 %0, %2, %3\n\tv_min_f32 %1, %2, %3" : "=&v"(mx), "=&v"(mn) : "v"(a), "v"(b)); a = mx; b = mn; }
__device__ __forceinline__ unsigned fmaxk(unsigned a, unsigned b) { unsigned r; asm("v_max_f32 %0, %1, %2" : "=v"(r) : "v"(a), "v"(b)); return r; }
template <int N> __device__ __forceinline__ void sort_desc(unsigned* a) {
#pragma unroll
    for (int k = 2; k <= N; k <<= 1)
#pragma unroll
        for (int j = k >> 1; j > 0; j >>= 1)
#pragma unroll
            for (int i = 0; i < N; ++i) { const int l = i ^ j; if (l > i) { if ((i & k) == 0) ce(a[i], a[l]); else ce(a[l], a[i]); } }
}
__device__ __forceinline__ void merge_bitonic16(unsigned* a) {
#pragma unroll
    for (int j = 8; j > 0; j >>= 1)
#pragma unroll
        for (int i = 0; i < 16; ++i) { const int l = i ^ j; if (l > i) ce(a[i], a[l]); }
}
template <bool SORT> __device__ __forceinline__ void top16_merge(unsigned* a, const unsigned* b) {
#pragma unroll
    for (int i = 0; i < 16; ++i) a[i] = fmaxk(a[i], b[15 - i]);
    if (SORT) merge_bitonic16(a);
}
template <bool SORT> __device__ __forceinline__ void pair_merge(unsigned* a) {
    unsigned lo[16], hi[16];
#pragma unroll
    for (int i = 0; i < 16; ++i) { auto rr = __builtin_amdgcn_permlane32_swap(a[i], a[i], false, false); lo[i] = rr[0]; hi[i] = rr[1]; }
    top16_merge<SORT>(lo, hi);
#pragma unroll
    for (int i = 0; i < 16; ++i) a[i] = lo[i];
}
}
__device__ __forceinline__ void phase_route(Ctx& F) {
    const int lane = F.lane, r32 = lane & 31, hi = lane >> 5;
    float* lv = (float*)(F.lds + F.wave * 8192);
    int* li = (int*)(F.lds + F.wave * 8192 + 4096);
    constexpr int KOFF = 65536, KPITCH = 272, KHALF = 128 * KPITCH;
    const bool staged = (F.G & 7) == 0;
    if (staged) { const int head = F.bid & 7;
        for (int c = F.tid; c < 2 * 128 * 16; c += NTHR) { const int hf = c >> 11, row = (c >> 4) & 127, ch = c & 15;
            *(v4u*)(F.lds + KOFF + hf * KHALF + row * KPITCH + ch * 16) = *(const v4u*)((hf ? F.K2 : F.K1) + (size_t)head * 128 * 128 + row * 128 + ch * 8); }
        __syncthreads(); }
    for (int tau = F.bid * NWAVES + F.wave; tau < 4096; tau += F.G * NWAVES) {
        const int head = (tau >> 3) & 7, tg = (tau & 7) | ((tau >> 6) << 3);
        const size_t token = (size_t)tg * 32 + r32;
        const bf16* qb = F.PQ + ((size_t)tg * 8 + head) * (16 * 512) + (32 * hi + r32) * 8;
        rt::bf16x8 bqa[16];
#pragma unroll
        for (int s = 0; s < 16; ++s) bqa[s] = *(const rt::bf16x8*)(qb + 512 * s);
#pragma unroll 1
        for (int half = 0; half < 2; ++half) {
            const bf16* kb = (half ? F.K2 : F.K1) + (size_t)head * 128 * 128 + (size_t)r32 * 128 + 8 * hi;
            const unsigned char* kl = F.lds + KOFF + half * KHALF + r32 * KPITCH + 16 * hi;
            rt::f32x16 acc[4] = {};
#pragma unroll
            for (int s = 0; s < 8; ++s) { const rt::bf16x8 bq = half ? bqa[8 + s] : bqa[s];
#pragma unroll
                for (int tl = 0; tl < 4; ++tl) { const rt::bf16x8 ak = staged ? *(const rt::bf16x8*)(kl + tl * 32 * KPITCH + 32 * s) : *(const rt::bf16x8*)(kb + (size_t)tl * 32 * 128 + 16 * s);
                    acc[tl] = __builtin_amdgcn_mfma_f32_32x32x16_bf16(ak, bq, acc[tl], 0, 0, 0); } }
            unsigned key[64];
#pragma unroll
            for (int tl = 0; tl < 4; ++tl)
#pragma unroll
                for (int r = 0; r < 16; ++r) { const int idx0 = tl * 32 + (r & 3) + 8 * (r >> 2);
                    key[tl * 16 + r] = (__float_as_uint(acc[tl][r]) & ~127u) | (unsigned)(127 - idx0 - 4 * hi); }
            rt::sort_desc<16>(key); rt::sort_desc<16>(key + 16); rt::sort_desc<16>(key + 32); rt::sort_desc<16>(key + 48);
            rt::top16_merge<true>(key, key + 16); rt::top16_merge<true>(key + 32, key + 48); rt::top16_merge<true>(key, key + 32);
            rt::pair_merge<true>(key);
            if (hi == half) {
#pragma unroll
                for (int i = 0; i < 16; ++i) { lv[(r32 * 2 + half) * 16 + i] = __uint_as_float(key[i] & ~127u); li[(r32 * 2 + half) * 16 + i] = 127 - (int)(key[i] & 127u); } }
        }
        LDS_WAIT(); asm volatile("" ::: "memory");
        float A[16], B[16];
        { const float* pa = lv + (r32 * 2 + hi) * 16; const float* pb = lv + (r32 * 2 + (hi ^ 1)) * 16;
#pragma unroll
          for (int i = 0; i < 16; ++i) { A[i] = pa[i]; B[i] = pb[i]; } }
        unsigned ck[32]; int nc = 0;
#pragma unroll
        for (int i = 0; i < 4; ++i)
#pragma unroll
            for (int j = i; j < 16; ++j) if ((i + 1) * (j + 1) <= 16) {
                const unsigned code = hi ? (unsigned)(255 - (j * 16 + i)) : (unsigned)(255 - (i * 16 + j));
                unsigned k = (__float_as_uint(A[i] + B[j]) & ~255u) | code; if (i == j && hi) k = 0xff800000u; ck[nc++] = k; }
#pragma unroll
        for (int i = nc; i < 32; ++i) ck[i] = 0xff800000u;
        rt::sort_desc<16>(ck); rt::sort_desc<16>(ck + 16); rt::top16_merge<true>(ck, ck + 16);
        rt::pair_merge<false>(ck);
        float sv[16]; int ev[16]; float mx = -__builtin_inff();
#pragma unroll
        for (int i = 0; i < 16; ++i) { const int code = 255 - (int)(ck[i] & 255u), r1 = code >> 4, r2 = code & 15;
            sv[i] = lv[(r32 * 2) * 16 + r1] + lv[(r32 * 2 + 1) * 16 + r2]; ev[i] = li[(r32 * 2) * 16 + r1] * 128 + li[(r32 * 2 + 1) * 16 + r2]; mx = fmaxf(mx, sv[i]); }
        float sum = 0.f;
#pragma unroll
        for (int i = 0; i < 16; ++i) { sv[i] = __expf(sv[i] - mx); sum += sv[i]; }
        const float inv = 1.f / sum; const size_t ob = token * 128 + head * 16;
        if (hi == 0) {
#pragma unroll
            for (int i = 0; i < 4; ++i) *(int4*)(F.EIDX + ob + 4 * i) = make_int4(ev[4 * i], ev[4 * i + 1], ev[4 * i + 2], ev[4 * i + 3]);
        } else {
#pragma unroll
            for (int i = 0; i < 4; ++i) *(f32x4*)(F.GATE + ob + 4 * i) = (f32x4){sv[4 * i] * inv, sv[4 * i + 1] * inv, sv[4 * i + 2] * inv, sv[4 * i + 3] * inv};
        }
        LDS_WAIT(); asm volatile("" ::: "memory");
    }
}

__device__ __forceinline__ float gelu_exact(float v) {
    const float av = fabsf(v), t = __builtin_amdgcn_rcpf(av * 0.2316418882f + 1.0f);
    float q = t * 0.5307027145f + (-0.7265760135f); q = q * t + 0.7107068705f; q = q * t + (-0.142248368f); q = q * t + 0.127414796f; q = q * t;
    const float e = __builtin_amdgcn_exp2f((v * v) * (-0.72134752044f)), m = v * (q * e);
    return v < 0.f ? m : v - m;
}
typedef float f32x2v __attribute__((ext_vector_type(2)));
#define DEC16(W_, f) do { f32x2v t_; t_ = __builtin_amdgcn_cvt_pk_f32_fp8((int)(W_).x, false); f[0] = t_.x; f[1] = t_.y; t_ = __builtin_amdgcn_cvt_pk_f32_fp8((int)(W_).x, true); f[2] = t_.x; f[3] = t_.y; \
    t_ = __builtin_amdgcn_cvt_pk_f32_fp8((int)(W_).y, false); f[4] = t_.x; f[5] = t_.y; t_ = __builtin_amdgcn_cvt_pk_f32_fp8((int)(W_).y, true); f[6] = t_.x; f[7] = t_.y; \
    t_ = __builtin_amdgcn_cvt_pk_f32_fp8((int)(W_).z, false); f[8] = t_.x; f[9] = t_.y; t_ = __builtin_amdgcn_cvt_pk_f32_fp8((int)(W_).z, true); f[10] = t_.x; f[11] = t_.y; \
    t_ = __builtin_amdgcn_cvt_pk_f32_fp8((int)(W_).w, false); f[12] = t_.x; f[13] = t_.y; t_ = __builtin_amdgcn_cvt_pk_f32_fp8((int)(W_).w, true); f[14] = t_.x; f[15] = t_.y; } while (0)
__device__ __forceinline__ void ald16(v4u& d, unsigned off, const void* base) { asm volatile("global_load_dwordx4 %0, %1, %2" : "=&v"(d) : "v"(off), "s"(base) : "memory"); }
__device__ __forceinline__ void ald2(unsigned& d, unsigned off, const void* base) { asm volatile("global_load_ushort %0, %1, %2" : "=&v"(d) : "v"(off), "s"(base) : "memory"); }
__device__ __forceinline__ void ald8(v2u& d, unsigned off, const void* base) { asm volatile("global_load_dwordx2 %0, %1, %2" : "=&v"(d) : "v"(off), "s"(base) : "memory"); }
__device__ __forceinline__ void ald4(unsigned& d, unsigned off, const void* base) { asm volatile("global_load_dword %0, %1, %2" : "=&v"(d) : "v"(off), "s"(base) : "memory"); }
#define AWAIT(N) asm volatile("s_waitcnt vmcnt(" #N ")" ::: "memory")
__device__ __forceinline__ unsigned amov(unsigned s) { unsigned d; asm volatile("v_mov_b32 %0, %1" : "=v"(d) : "v"(s)); return d; }
__device__ __forceinline__ v4u amov4(const v4u& s) { v4u d; asm volatile("v_mov_b32 %0, %4\n\tv_mov_b32 %1, %5\n\tv_mov_b32 %2, %6\n\tv_mov_b32 %3, %7" : "=&v"(d.x), "=&v"(d.y), "=&v"(d.z), "=&v"(d.w) : "v"(s.x), "v"(s.y), "v"(s.z), "v"(s.w)); return d; }
__device__ __forceinline__ void adec16(const v4u& w, float (&f)[16]) {
    f32x2v a, b, c, d, e, g, h, i;
    asm volatile("v_cvt_pk_f32_fp8_e32 %0, %8\n\tv_cvt_pk_f32_fp8_sdwa %1, %8 src0_sel:WORD_1\n\tv_cvt_pk_f32_fp8_e32 %2, %9\n\tv_cvt_pk_f32_fp8_sdwa %3, %9 src0_sel:WORD_1\n\t"
                 "v_cvt_pk_f32_fp8_e32 %4, %10\n\tv_cvt_pk_f32_fp8_sdwa %5, %10 src0_sel:WORD_1\n\tv_cvt_pk_f32_fp8_e32 %6, %11\n\tv_cvt_pk_f32_fp8_sdwa %7, %11 src0_sel:WORD_1"
                 : "=&v"(a), "=&v"(b), "=&v"(c), "=&v"(d), "=&v"(e), "=&v"(g), "=&v"(h), "=&v"(i) : "v"(w.x), "v"(w.y), "v"(w.z), "v"(w.w));
    f[0] = a.x; f[1] = a.y; f[2] = b.x; f[3] = b.y; f[4] = c.x; f[5] = c.y; f[6] = d.x; f[7] = d.y; f[8] = e.x; f[9] = e.y; f[10] = g.x; f[11] = g.y; f[12] = h.x; f[13] = h.y; f[14] = i.x; f[15] = i.y;
}
__device__ __forceinline__ void adec16p(const v4u& w, f32x2v (&f)[8]) {
    asm volatile("v_cvt_pk_f32_fp8_e32 %0, %8\n\tv_cvt_pk_f32_fp8_sdwa %1, %8 src0_sel:WORD_1\n\tv_cvt_pk_f32_fp8_e32 %2, %9\n\tv_cvt_pk_f32_fp8_sdwa %3, %9 src0_sel:WORD_1\n\t"
                 "v_cvt_pk_f32_fp8_e32 %4, %10\n\tv_cvt_pk_f32_fp8_sdwa %5, %10 src0_sel:WORD_1\n\tv_cvt_pk_f32_fp8_e32 %6, %11\n\tv_cvt_pk_f32_fp8_sdwa %7, %11 src0_sel:WORD_1"
                 : "=&v"(f[0]), "=&v"(f[1]), "=&v"(f[2]), "=&v"(f[3]), "=&v"(f[4]), "=&v"(f[5]), "=&v"(f[6]), "=&v"(f[7]) : "v"(w.x), "v"(w.y), "v"(w.z), "v"(w.w));
}
#define GROWS(TBL, EV, XW) do { _Pragma("unroll") for (int i = 0; i < 8; ++i) { const unsigned e_ = (unsigned)__shfl((int)(EV), 8 * i + rg); ald16(XW[i], e_ * 128u + toff, TBL); } } while (0)
__device__ __forceinline__ void phase_gather_dots(Ctx& F) {
    typedef int v8i __attribute__((ext_vector_type(8)));
    const int lane = F.lane, c4 = F.cls & 3, par = F.cls >> 2, cw = F.crank * NWAVES + F.wave, ncw = F.cnb * NWAVES;
    const int jj = lane & 15, g = lane >> 4, sub = lane & 7, rg = lane >> 3;
    const unsigned hoff = (unsigned)(256 * c4 + 16 * g) * 2u, toff = (unsigned)c4 * (16384u * 128u) + 16u * (unsigned)sub;
    const void* U4 = F.UB; const void* EI = F.EIDX; const void* HN = HB_OF(F); const void* RS = RSTD_OF(F);
    const unsigned wbase = (unsigned)(size_t)(LAS unsigned char*)F.lds + (unsigned)F.wave * 16384u;
    const unsigned wofs0 = wbase + (unsigned)rg * 128u + 16u * (unsigned)(sub ^ (rg >> 1)), wofs1 = wbase + (unsigned)rg * 128u + 16u * (unsigned)(sub ^ (4 + (rg >> 1)));
    LAS unsigned char* rp0 = (LAS unsigned char*)F.lds + F.wave * 16384 + jj * 128 + 16 * (g ^ (jj >> 1));
    LAS unsigned char* rp1 = (LAS unsigned char*)F.lds + F.wave * 16384 + jj * 128 + 16 * ((4 + g) ^ (jj >> 1));
    if (cw >= T / 2) return;
    int u = cw;
    struct Raw { unsigned e0, e1, rs; v4u h0, h1, h2, h3, h4, h5, h6, h7; };
#define G1_OPS(uu, Q) do { const unsigned tt_ = 2u * (unsigned)(uu) + (unsigned)par, eo_ = (tt_ * 128u + (unsigned)lane) * 4u, ho_ = tt_ * 2048u + hoff; \
        ald4(Q.e0, eo_, EI); ald4(Q.e1, eo_ + 256u, EI); ald4(Q.rs, tt_ * 4u, RS); ald16(Q.h0, ho_, HN); ald16(Q.h1, ho_ + 16u, HN); ald16(Q.h2, ho_ + 128u, HN); ald16(Q.h3, ho_ + 144u, HN); \
        ald16(Q.h4, ho_ + 256u, HN); ald16(Q.h5, ho_ + 272u, HN); ald16(Q.h6, ho_ + 384u, HN); ald16(Q.h7, ho_ + 400u, HN); } while (0)
#define G1_F8(W, R_) ({ int p_ = 0; p_ = __builtin_amdgcn_cvt_pk_fp8_f32(bflo(W.x) * R_, bfhi(W.x) * R_, p_, false); p_ = __builtin_amdgcn_cvt_pk_fp8_f32(bflo(W.y) * R_, bfhi(W.y) * R_, p_, true); p_; })
#define G1_F8B(W, R_) ({ int p_ = 0; p_ = __builtin_amdgcn_cvt_pk_fp8_f32(bflo(W.z) * R_, bfhi(W.z) * R_, p_, false); p_ = __builtin_amdgcn_cvt_pk_fp8_f32(bflo(W.w) * R_, bfhi(W.w) * R_, p_, true); p_; })
#define G1_L2(HQ, H8, B_) do { const v4u w_ = amov4(HQ); H8[B_] = G1_F8(w_, rs_); H8[B_ + 1] = G1_F8B(w_, rs_); } while (0)
#define G1_LAND(Q, E0, E1, H8) do { E0 = amov(Q.e0); E1 = amov(Q.e1); const float rs_ = __uint_as_float(amov(Q.rs)); \
        G1_L2(Q.h0, H8, 0); G1_L2(Q.h1, H8, 2); G1_L2(Q.h2, H8, 4); G1_L2(Q.h3, H8, 6); G1_L2(Q.h4, H8, 8); G1_L2(Q.h5, H8, 10); G1_L2(Q.h6, H8, 12); G1_L2(Q.h7, H8, 14); } while (0)
#define G1_ROWS(EV, XW) do { _Pragma("unroll") for (int i = 0; i < 8; ++i) { const unsigned e_ = (unsigned)__shfl((int)(EV), 8 * i + rg); ald16(XW[i], e_ * 128u + toff, U4); } } while (0)
#define G1_STAGE(XW, HF) do { _Pragma("unroll") for (int i = 0; i < 8; ++i) asm volatile("ds_write_b128 %0, %1 offset:%2" :: "v"((i & 1) ? wofs1 : wofs0), "v"(XW[i]), "i"((HF) * 8192 + i * 1024) : "memory"); } while (0)
#define G1_MMA(HF, H8, D_) do { const v8i ha0_ = {H8[0], H8[1], H8[2], H8[3], H8[4], H8[5], H8[6], H8[7]}, ha1_ = {H8[8], H8[9], H8[10], H8[11], H8[12], H8[13], H8[14], H8[15]}; \
        _Pragma("unroll") for (int m = 0; m < 4; ++m) { const v4u b0_ = *(const LAS v4u*)(rp0 + (HF) * 8192 + m * 2048), b1_ = *(const LAS v4u*)(rp1 + (HF) * 8192 + m * 2048); \
            const v8i ub0_ = {(int)b0_.x, (int)b0_.y, (int)b0_.z, (int)b0_.w, 0, 0, 0, 0}, ub1_ = {(int)b1_.x, (int)b1_.y, (int)b1_.z, (int)b1_.w, 0, 0, 0, 0}; \
            f32x4 c_ = __builtin_amdgcn_mfma_scale_f32_16x16x128_f8f6f4(ha0_, ub0_, (f32x4){0.f, 0.f, 0.f, 0.f}, 0, 4, 0, 0x7F7F7F7F, 0, 0x7F7F7F7F); \
            c_ = __builtin_amdgcn_mfma_scale_f32_16x16x128_f8f6f4(ha1_, ub1_, c_, 0, 4, 0, 0x7F7F7F7F, 0, 0x7F7F7F7F); D_[m] = c_[0]; } } while (0)
    Raw raw; v4u xa[8], xb[8];
    unsigned ea, eb; int h8[16];
    const float mk0 = (g == 0) ? 1.f / U4_SCALE : 0.f, mk1 = (g == 1) ? 1.f / U4_SCALE : 0.f, mk2 = (g == 2) ? 1.f / U4_SCALE : 0.f, mk3 = (g == 3) ? 1.f / U4_SCALE : 0.f;
    G1_OPS(u, raw);
    AWAIT(0);
    G1_LAND(raw, ea, eb, h8);
    G1_ROWS(ea, xa);
    { const int u1 = (u + ncw < T / 2) ? u + ncw : u; G1_OPS(u1, raw); }
    for (;;) {
        const int un = u + ncw; const bool more = un < T / 2;
        float d[4];
        G1_ROWS(eb, xb);
        AWAIT(19);
        G1_STAGE(xa, 0);
        __builtin_amdgcn_sched_barrier(0);
        G1_MMA(0, h8, d);
        float s0 = d[0] * mk0 + d[2] * mk1, s1 = d[1] * mk0 + d[3] * mk1;
        asm volatile("" : "+v"(s0), "+v"(s1));
        __builtin_amdgcn_sched_barrier(0);
        AWAIT(8);
        unsigned nea, neb; int nh8[16];
        G1_LAND(raw, nea, neb, nh8);
        G1_ROWS(nea, xa);
        { const int u2 = (un + ncw < T / 2) ? un + ncw : u; G1_OPS(u2, raw); }
        AWAIT(19);
        G1_STAGE(xb, 1);
        __builtin_amdgcn_sched_barrier(0);
        G1_MMA(1, h8, d);
        s0 += d[0] * mk2 + d[2] * mk3; s1 += d[1] * mk2 + d[3] * mk3;
        { bf16* pd_ = (bf16*)F.PD + ((size_t)(2 * u + par) * 128 + 32 * g + jj) * 4 + c4; pd_[0] = (bf16)f2bf(s0); pd_[64] = (bf16)f2bf(s1); }
        __builtin_amdgcn_sched_barrier(0);
        if (!more) break;
        u = un; eb = neb;
#pragma unroll
        for (int q = 0; q < 16; ++q) h8[q] = nh8[q];
    }
    AWAIT(0);
#undef G1_OPS
#undef G1_F8
#undef G1_F8B
#undef G1_L2
#undef G1_LAND
#undef G1_ROWS
#undef G1_STAGE
#undef G1_MMA
}
__device__ __forceinline__ void phase_gather_axpy(Ctx& F) {
    typedef int v8i __attribute__((ext_vector_type(8)));
    const int lane = F.lane, c4 = F.cls & 3, par = F.cls >> 2, cw = F.crank * NWAVES + F.wave, ncw = F.cnb * NWAVES;
    const int sub = lane & 7, rg = lane >> 3, jj = lane & 15, g = lane >> 4;
    const unsigned toff = (unsigned)c4 * (16384u * 128u) + 16u * (unsigned)sub;
    const void* V4 = F.VB; const void* EI = F.EIDX; const void* GT = F.GATE; const void* PDp = F.PD; const void* OUTp = F.out; const void* H1p = HB_OF(F);
    const unsigned wbase = (unsigned)(size_t)(LAS unsigned char*)F.lds + (unsigned)F.wave * 16384u;
    const unsigned wofs0 = wbase + (unsigned)rg * 128u + 16u * (unsigned)(sub ^ (rg >> 1)), wofs1 = wbase + (unsigned)rg * 128u + 16u * (unsigned)(sub ^ (4 + (rg >> 1)));
    const unsigned wtab = (unsigned)(size_t)(LAS unsigned char*)F.lds + 131072u + (unsigned)F.wave * 128u;
    unsigned rc[8];
#pragma unroll
    for (int c = 0; c < 8; ++c) rc[c] = wbase + (unsigned)(32 * g + jj) * 128u + 16u * (unsigned)(c ^ (jj >> 1));
    const unsigned ocol4 = (unsigned)(256 * c4 + 4 * lane);
    const unsigned xofs = (unsigned)(size_t)(LAS unsigned char*)F.lds + 132096u + (unsigned)F.wave * 1024u;
    const float mk0 = (g == 0) ? 1.f : 0.f, mk1 = (g == 1) ? 1.f : 0.f, mk2 = (g == 2) ? 1.f : 0.f, mk3 = (g == 3) ? 1.f : 0.f;
    if (cw >= T / 2) return;
    int u = cw;
    struct Ops { unsigned e0, e1, g0, g1; v2u p0, p1, o; };
#define G2_OPS(uu, Q) do { const unsigned tt_ = 2u * (unsigned)(uu) + (unsigned)par, eo_ = (tt_ * 128u + (unsigned)lane) * 4u, po_ = (tt_ * 128u + (unsigned)lane) * 8u, oo_ = (tt_ * 1024u + ocol4) * 2u; \
        ald4(Q.e0, eo_, EI); ald4(Q.e1, eo_ + 256u, EI); ald4(Q.g0, eo_, GT); ald4(Q.g1, eo_ + 256u, GT); ald8(Q.p0, po_, PDp); ald8(Q.p1, po_ + 512u, PDp); \
        ald8(Q.o, oo_, H1p); } while (0)
#define G2_LAND(Q, E0, E1, WA, WB, O0, O1, O2, O3) do { E0 = amov(Q.e0); E1 = amov(Q.e1); const unsigned g0_ = amov(Q.g0), g1_ = amov(Q.g1); v2u a_, b_; a_.x = amov(Q.p0.x); a_.y = amov(Q.p0.y); b_.x = amov(Q.p1.x); b_.y = amov(Q.p1.y); \
        { const unsigned ox_ = amov(Q.o.x), oy_ = amov(Q.o.y); O0 = __uint_as_float(ox_ << 16); O1 = __uint_as_float(ox_ & 0xffff0000u); O2 = __uint_as_float(oy_ << 16); O3 = __uint_as_float(oy_ & 0xffff0000u); } WA = G2_W(g0_, a_); WB = G2_W(g1_, b_); } while (0)
#define G2_W(G, P) (__uint_as_float(G) * gelu_exact((bflo(P.x) + bfhi(P.x)) + (bflo(P.y) + bfhi(P.y))) * W8_SCALE)
#define G2_STAGE(XW, HF) do { _Pragma("unroll") for (int i = 0; i < 8; ++i) asm volatile("ds_write_b128 %0, %1 offset:%2" :: "v"((i & 1) ? wofs1 : wofs0), "v"(XW[i]), "i"((HF) * 8192 + i * 1024) : "memory"); } while (0)
#define G2_TR(dst, addr, off) asm volatile("ds_read_b64_tr_b4 %0, %1 offset:%2" : "=&v"(dst) : "v"(addr), "i"(off) : "memory")
    constexpr float W8_SCALE = 64.f;
    Ops raw; v4u xa[8], xb[8];
    unsigned ea, eb; float wa, wb, o0, o1, o2, o3;
    G2_OPS(u, raw);
    AWAIT(0);
    G2_LAND(raw, ea, eb, wa, wb, o0, o1, o2, o3);
    GROWS(V4, ea, xa); GROWS(V4, eb, xb);
    { const int u1 = (u + ncw < T / 2) ? u + ncw : u; G2_OPS(u1, raw); }
    for (;;) {
        const int un = u + ncw; const bool more = un < T / 2;
        AWAIT(15);
        G2_STAGE(xa, 0);
        AWAIT(7);
        G2_STAGE(xb, 1);
        { const unsigned w8 = (unsigned)__builtin_amdgcn_cvt_pk_fp8_f32(wa, wb, 0, false);
          asm volatile("ds_write_b8 %0, %1\n\tds_write_b8_d16_hi %0, %2 offset:64" :: "v"(wtab + (unsigned)lane), "v"(w8), "v"(w8 << 8) : "memory"); }
        LDS_WAIT();
        AWAIT(0);
        unsigned nea, neb; float nwa, nwb, no0, no1, no2, no3;
        G2_LAND(raw, nea, neb, nwa, nwb, no0, no1, no2, no3);
        GROWS(V4, nea, xa); GROWS(V4, neb, xb);
        { const int u2 = (un + ncw < T / 2) ? un + ncw : u; G2_OPS(u2, raw); }
        const v4u wlo = *(const LAS v4u*)((LAS unsigned char*)F.lds + 131072 + F.wave * 128 + 16 * g), whi = *(const LAS v4u*)((LAS unsigned char*)F.lds + 131072 + F.wave * 128 + 64 + 16 * g);
        const v8i wa8 = {(int)wlo.x, (int)wlo.y, (int)wlo.z, (int)wlo.w, (int)whi.x, (int)whi.y, (int)whi.z, (int)whi.w};
        float r0 = 0.f, r1 = 0.f, r2 = 0.f, r3 = 0.f;
#pragma unroll
        for (int gq = 0; gq < 4; ++gq) {
            v2u bl[4], bh[4];
#pragma unroll
            for (int j = 0; j < 4; ++j) { const int m = 4 * gq + j; G2_TR(bl[j], rc[m >> 1], 8 * (m & 1)); G2_TR(bh[j], rc[m >> 1], 8 * (m & 1) + 2048); }
            asm volatile("s_waitcnt lgkmcnt(0)" ::: "memory"); __builtin_amdgcn_sched_barrier(0);
            float d[4];
#pragma unroll
            for (int j = 0; j < 4; ++j) { const v8i vb = {(int)bl[j].x, (int)bl[j].y, (int)bh[j].x, (int)bh[j].y, 0, 0, 0, 0};
                const f32x4 c_ = __builtin_amdgcn_mfma_scale_f32_16x16x128_f8f6f4(wa8, vb, (f32x4){0.f, 0.f, 0.f, 0.f}, 0, 4, 0, 0x7F7F7F7F, 0, 0x7F7F7F7F); d[j] = c_[0]; }
            const float mk = (gq == 0) ? mk0 : (gq == 1) ? mk1 : (gq == 2) ? mk2 : mk3;
            r0 += d[0] * mk; r1 += d[1] * mk; r2 += d[2] * mk; r3 += d[3] * mk;
            asm volatile("" : "+v"(r0), "+v"(r1), "+v"(r2), "+v"(r3));
            __builtin_amdgcn_sched_barrier(0);
        }
        { constexpr float SC = 1.f / (V4_SCALE * W8_SCALE); const unsigned oo_ = ((2u * (unsigned)u + (unsigned)par) * 1024u + ocol4) * 4u;
          LAS float* xw_ = (LAS float*)(size_t)0 + ((xofs >> 2) + 64 * g + jj); xw_[0] = r0; xw_[16] = r1; xw_[32] = r2; xw_[48] = r3;
          const f32x4 rr = *(const LAS f32x4*)((LAS float*)(size_t)0 + ((xofs >> 2) + 4 * lane));
          v4u st; st.x = __float_as_uint(o0 + rr[0] * SC); st.y = __float_as_uint(o1 + rr[1] * SC); st.z = __float_as_uint(o2 + rr[2] * SC); st.w = __float_as_uint(o3 + rr[3] * SC);
          asm volatile("global_store_dwordx4 %0, %1, %2\n\ts_nop 3" :: "v"(oo_), "v"(st), "s"(OUTp) : "memory"); }
        if (!more) break;
        u = un; wa = nwa; wb = nwb; o0 = no0; o1 = no1; o2 = no2; o3 = no3;
    }
    AWAIT(0);
#undef G2_OPS
#undef G2_LAND
#undef G2_W
#undef G2_STAGE
#undef G2_TR
}
#undef GROWS

#define XB_TMO      128
#define XB_XCNT(j)  (256  + 64 * (j))
#define XB_XSUB(j)  (1280 + 64 * (j))
#define XB_XGEN(j)  (2304 + 64 * (j))
#define XB_TOP      3328
#define XB_TOPGEN   3392
#define XCD_BAR_WORDS 3456
#define XB_SPIN_CAP (1u << 18)

__device__ __forceinline__ unsigned xb_ld(unsigned* p)              { return __hip_atomic_load(p, __ATOMIC_RELAXED, __HIP_MEMORY_SCOPE_AGENT); }
__device__ __forceinline__ unsigned xb_add(unsigned* p, unsigned v) { return __hip_atomic_fetch_add(p, v, __ATOMIC_RELAXED, __HIP_MEMORY_SCOPE_AGENT); }
__device__ __forceinline__ unsigned xb_xcc_id() { return (unsigned)__builtin_amdgcn_s_getreg((3 << 11) | 20) & 0xFu; }
#define XB_SPIN(cond, bar) do { unsigned _sp = 0; while (cond) { __builtin_amdgcn_s_sleep(1); \
    if ((++_sp & 255u) == 0u) { if (xb_ld(&(bar)[XB_TMO])) break; if (_sp > XB_SPIN_CAP) { atomicAdd(&(bar)[XB_TMO], 1u); break; } } } } while (0)

struct XcdBarrier {
    unsigned* bar; unsigned x;
    volatile LAS unsigned* st;
};

__device__ __forceinline__ XcdBarrier xcd_barrier_post(unsigned* bar, volatile LAS unsigned* st) {
    XcdBarrier b; b.bar = bar; b.x = xb_xcc_id(); b.st = st;
    if (threadIdx.x == 0) (void)xb_add(&bar[XB_XCNT(b.x)], 1u);
    return b;
}
__device__ __forceinline__ void xcd_barrier_complete(unsigned* bar, unsigned x, unsigned& nloc, unsigned& nx) {
    const unsigned G = gridDim.x * gridDim.y * gridDim.z;
    unsigned sum, cnt, mine, sp = 0u;
    for (;;) {
        sum = 0u; cnt = 0u; mine = 0u;
#pragma unroll
        for (unsigned j = 0; j < 16; ++j) { const unsigned c = xb_ld(&bar[XB_XCNT(j)]); sum += c; cnt += (c > 0u) ? 1u : 0u; mine = (j == x) ? c : mine; }
        if (sum == G) break;
        __builtin_amdgcn_s_sleep(1);
        if ((++sp & 255u) == 0u) { if (xb_ld(&bar[XB_TMO])) break; if (sp > XB_SPIN_CAP) { atomicAdd(&bar[XB_TMO], 1u); break; } }
    }
    nloc = mine > 0u ? mine : 1u; nx = cnt > 0u ? cnt : 1u;
}

__device__ __forceinline__ void xcd_barrier(const XcdBarrier& b) {
    asm volatile("s_waitcnt vmcnt(0)" ::: "memory");
    __syncthreads();
    if (threadIdx.x == 0) {
        unsigned* bar = b.bar;
        __builtin_amdgcn_s_waitcnt(0);
        unsigned nloc = b.st[0], nx = b.st[1];
        if (nloc == 0u) { xcd_barrier_complete(bar, b.x, nloc, nx); b.st[0] = nloc; b.st[1] = nx; }
        const unsigned old = xb_add(&bar[XB_XSUB(b.x)], 1u);
        const unsigned gen = old / nloc;
        if (old + 1u == (gen + 1u) * nloc) {
            __builtin_amdgcn_fence(__ATOMIC_RELEASE, "agent");
            asm volatile("s_waitcnt vmcnt(0)" ::: "memory");
            const unsigned og = xb_add(&bar[XB_TOP], 1u);
            const unsigned tg = og / nx;
            if (og + 1u == (tg + 1u) * nx) xb_add(&bar[XB_TOPGEN], 1u);
            else XB_SPIN(xb_ld(&bar[XB_TOPGEN]) == tg, bar);
            __builtin_amdgcn_fence(__ATOMIC_ACQUIRE, "agent");
            xb_add(&bar[XB_XGEN(b.x)], 1u);
            asm volatile("s_waitcnt vmcnt(0)" ::: "memory");
        } else {
            XB_SPIN(xb_ld(&bar[XB_XGEN(b.x)]) == gen, bar);
            __builtin_amdgcn_fence(__ATOMIC_ACQUIRE, "agent");
            asm volatile("s_waitcnt vmcnt(0)" ::: "memory");
        }
    }
    __syncthreads();
}

constexpr int NPHASE = 11;
__global__ void __launch_bounds__(NTHR, 2) mk_fwd(Args args) {
    extern __shared__ __attribute__((aligned(16))) unsigned char lds[];
    Ctx F;
    F.lds = lds; F.tid = threadIdx.x; F.lane = F.tid & 63; F.wave = __builtin_amdgcn_readfirstlane(F.tid >> 6); F.G = gridDim.x; F.bid = blockIdx.x;
    F.x = args.in[0]; F.g1 = args.in[1]; F.w_in = args.in[2]; F.conv_w = args.in[3]; F.qg = args.in[4]; F.kg = args.in[5]; F.w_o = args.in[6]; F.g2 = args.in[7];
    F.pwq = args.in[8]; F.pk1 = args.in[9]; F.pk2 = args.in[10]; F.pu = args.in[11]; F.pv = args.in[12]; F.out = args.out;
    unsigned char* ws = args.ws;
    F.WIN = (bf16*)(ws + WS_WIN); F.WO = (bf16*)(ws + WS_WO); F.WQ = (bf16*)(ws + WS_WQ); F.K1 = (bf16*)(ws + WS_K1); F.K2 = (bf16*)(ws + WS_K2);
    F.UB = (bf16*)(ws + WS_UB); F.VB = (bf16*)(ws + WS_VB); F.XN = (bf16*)(ws + WS_XN); F.P1 = (bf16*)(ws + WS_P1); F.U = (bf16*)(ws + WS_U);
    F.Q = (bf16*)(ws + WS_Q); F.K = (bf16*)(ws + WS_K); F.V = (bf16*)(ws + WS_V); F.QI = (bf16*)(ws + WS_QI); F.KI = (bf16*)(ws + WS_KI);
    F.SGB = (bf16*)args.out; F.PQ = (bf16*)(ws + WS_PQ); F.WI = (float*)(ws + WS_WI); F.GATE = (float*)(ws + WS_GATE); F.MASK = (unsigned*)(ws + WS_MASK); F.EIDX = (int*)(ws + WS_EIDX); F.PD = (float*)(ws + WS_PQ);
    volatile LAS unsigned* MISC = (volatile LAS unsigned*)((LAS unsigned char*)lds + MISC_OFF);
    if (F.tid < 64) MISC[F.tid] = 0u;
    __syncthreads();
    XcdBarrier xbar = xcd_barrier_post((unsigned*)(ws + WS_CTL) + CW_BAR, MISC + 8);
    if (F.tid == 0) MISC[16] = xb_add((unsigned*)(ws + WS_CTL) + CW_RANK + 64 * xbar.x, 1u);
    F.cls = F.bid & 7; F.crank = F.bid >> 3; F.cnb = (F.G - F.cls + 7) >> 3;
    const int lo = args.ph_lo, hi = args.ph_hi;
    F.late_jobs = (lo == 0 && hi == NPHASE);
#define IN(k) (lo <= (k) && (k) < hi)
#define SEAM(k) do { if (IN(k) && IN((k) + 1)) { if (hi > NPHASE) cg::this_grid().sync();   else xcd_barrier(xbar); } } while (0)
    PG8_LAS unsigned char* lds3 = (PG8_LAS unsigned char*)lds;
    if (IN(0)) { phase_prologue(F); } SEAM(0);
    if (IN(1)) { pg8::Gemm g{F.XN, F.WIN, T, NPROJ, D}; pg8::StaticOrder S; S.init(T, NPROJ, F.G, F.bid);
        pg8::EpiProj E{F.U, F.P1, F.Q, F.K, F.V, F.QI, F.SGB};
        pg8::gemm_phase<pg8::EpiProj, pg8::StaticOrder, true, true>(lds3, g, S, E);
        phase_ki(F); } SEAM(1);
    if (IN(2) && IN(3)) { const int gw_ = F.bid * NWAVES + F.wave, NGW_ = F.G * NWAVES; const size_t gt_ = (size_t)F.bid * NTHR + F.tid, NGT_ = (size_t)F.G * NTHR;
        float* scr_ = (float*)(F.lds + 16384 + F.wave * 8704);
        if (F.wave < 4) { phase_post(F); if (F.late_jobs) { late_weights_job(F, scr_, gw_, NGW_, gt_, NGT_); tables_job(F, gt_, NGT_); } phase_indexer(F); }
        else { phase_indexer(F); phase_post(F); if (F.late_jobs) { late_weights_job(F, scr_, gw_, NGW_, gt_, NGT_); tables_job(F, gt_, NGT_); } } }
    else { if (IN(2)) phase_post(F); if (IN(3)) phase_indexer(F); }
    SEAM(3);
    if (IN(4)) { phase_attn(F); } SEAM(4);
    if (IN(5)) { pg8::Gemm g{F.XN, F.WO, T, D, D}; pg8::StaticOrder S; S.init(T, D, F.G, F.bid);
        pg8::EpiResNorm E{F.x, HB_OF(F), SSQ_OF(F), D};
        pg8::gemm_phase<pg8::EpiResNorm, pg8::StaticOrder, true, true>(lds3, g, S, E); } SEAM(5);
    if (IN(7)) { pg8::Gemm g{HB_OF(F), F.WQ, T, 2048, D}; pg8::StaticOrder S; S.init(T, 2048, F.G, F.bid);
        pg8::Unit u0, u1, u2; const bool h0 = S.next(0, u0), h1 = S.next(1, u1), h2 = S.next(2, u2); const bool use_tab = h0 && !h2;
        PG8_LAS float* rtab = (PG8_LAS float*)(lds3 + 140288);
        if (use_tab) { const int slot = F.tid >> 8, rr = F.tid & 255; const int upm = slot ? u1.pm : u0.pm, upn = slot ? u1.pn : u0.pn;
            if (slot == 0 || h1) { const int row = upm * 256 + rr; const f32x4* sp = (const f32x4*)(SSQ_OF(F) + (size_t)row * 16); const f32x4 s4 = (sp[0] + sp[1]) + (sp[2] + sp[3]);
                const float r = __builtin_amdgcn_rsqf(((s4[0] + s4[1]) + (s4[2] + s4[3])) * (1.f / 1024.f) + 1e-6f); rtab[slot * 256 + rr] = r; if (upn == 0) RSTD_OF(F)[row] = r; }
            __syncthreads(); }
        pg8::EpiBf16Scale E{F.PQ, 2048, SSQ_OF(F), RSTD_OF(F), rtab, u0.pm, u0.pn, use_tab};
        pg8::gemm_phase<pg8::EpiBf16Scale, pg8::StaticOrder, true, true>(lds3, g, S, E); } SEAM(7);
    if (IN(8)) { phase_route(F); } SEAM(8);
    if (IN(9) || IN(10)) {
        unsigned* bw = (unsigned*)(ws + WS_CTL) + CW_BAR; bool ok = (lo == 0);
        for (int j = 0; j < 16; ++j) { const unsigned c = xb_ld(&bw[XB_XCNT(j)]); ok = ok && ((j < 8) ? (c > 0u) : (c == 0u)); }
        if (ok) { F.cls = (int)xbar.x; F.crank = (int)MISC[16]; F.cnb = (int)xb_ld(&bw[XB_XCNT(xbar.x)]); }
    }
    if (IN(9)) { phase_gather_dots(F); } SEAM(9);
    if (IN(10)) { phase_gather_axpy(F); }
#undef IN
#undef SEAM
}

#ifndef MK_ONE_LAUNCH
#define MK_ONE_LAUNCH 1
#endif
extern "C" void kernel_launch(void* const* d_in, const int* in_sizes, int n_in, void* d_out, int out_size, void* d_ws, size_t ws_size, hipStream_t stream) {
    static int grid = 0;
    if (grid == 0) {
        if (n_in != 13 || in_sizes[0] != T * D || out_size != T * D || ws_size < WS_END) { fprintf(stderr, "kernel_launch: unexpected shapes (n_in %d, in0 %d, out %d, ws %zu); nothing launched\n", n_in, n_in > 0 ? in_sizes[0] : -1, out_size, ws_size); grid = -1; return; }
        int dev = 0, cus = 0, per_cu = 0;
        if (hipGetDevice(&dev) != hipSuccess || hipDeviceGetAttribute(&cus, hipDeviceAttributeMultiprocessorCount, dev) != hipSuccess) { fprintf(stderr, "kernel_launch: device query failed\n"); grid = -1; return; }
        if (hipFuncSetAttribute((const void*)mk_fwd, hipFuncAttributeMaxDynamicSharedMemorySize, LDS_BYTES) != hipSuccess) { fprintf(stderr, "kernel_launch: hipFuncSetAttribute failed\n"); grid = -1; return; }
        if (hipOccupancyMaxActiveBlocksPerMultiprocessor(&per_cu, (const void*)mk_fwd, NTHR, LDS_BYTES) != hipSuccess || per_cu < 1) { fprintf(stderr, "kernel_launch: occupancy query says %d blocks per CU\n", per_cu); per_cu = 1; }
        (void)hipGetLastError();
        grid = cus * (per_cu < 1 ? 1 : 1);
    }
    if (grid < 0) return;
    if (hipMemsetAsync((char*)d_ws + WS_CTL, 0, CTL_ZERO_BYTES, stream) != hipSuccess) { fprintf(stderr, "kernel_launch: memset of control words failed\n"); return; }
    Args a{};
    for (int i = 0; i < 13; ++i) a.in[i] = (const float*)d_in[i];
    a.out = (float*)d_out; a.ws = (unsigned char*)d_ws;
#if MK_ONE_LAUNCH
    a.ph_lo = 0; a.ph_hi = NPHASE;
    void* kargs[] = {&a};
    hipError_t e = hipLaunchCooperativeKernel((const void*)mk_fwd, dim3(grid), dim3(NTHR), kargs, LDS_BYTES, stream);
    if (e != hipSuccess) fprintf(stderr, "kernel_launch: cooperative launch failed: %s (grid %d)\n", hipGetErrorString(e), grid);
#else
    for (int p = 0; p < NPHASE; ++p) { a.ph_lo = p; a.ph_hi = p + 1; hipLaunchKernelGGL(mk_fwd, dim3(grid), dim3(NTHR), LDS_BYTES, stream, a); }
#endif
}
```

```cpp
#include <hip/hip_runtime.h>
#include <hip/hip_cooperative_groups.h>
#include <cstdio>
#include <cstdint>
namespace cg = cooperative_groups;

namespace pg8 {
#define PG8_LAS __attribute__((address_space(3)))
typedef unsigned short bf16_t;
typedef short bf16x8 __attribute__((ext_vector_type(8)));
typedef float f32x4 __attribute__((ext_vector_type(4)));
typedef unsigned u32x4 __attribute__((ext_vector_type(4)));
constexpr int BM = 256, BK = 64, HALF = 128, HTB = HALF * BK * 2  , STAGE_BYTES = 8 * HTB, NXCD = 8, WGM = 8;

__host__ __device__ __forceinline__ int lds_byte(int r, int c) { const int st = (r >> 4) * 2 + (c >> 5), rr = r & 15, cc = c & 31, ob = rr * 64 + cc * 2; return st * 1024 + (ob ^ (((ob >> 9) & 1) << 5)); }
__host__ __device__ __forceinline__ void stage_rc(int b, int& R, int& C) { const int st = b / 1024, sb = b % 1024, swz = sb ^ (((sb >> 9) & 1) << 5); R = (st >> 1) * 16 + swz / 64; C = (st & 1) * 32 + (swz % 64) / 2; }
__host__ __device__ __forceinline__ int perm32(int rho) { const int n = rho >> 4, i = rho & 15; return 8 * (i >> 2) + 4 * n + (i & 3); }

struct Unit { int pm, pn; };
struct Gemm { const bf16_t* A; const bf16_t* Bt; int M, N, K; };

struct StaticOrder {
    int nM, nN, nwg, G, c;
    __host__ __device__ void init(int M, int N, int G_, int c_) { nM = M / BM; nN = N / BM; nwg = nM * nN; G = G_; c = c_; }
    __host__ __device__ __forceinline__ bool next(int i, Unit& u) const {
        const long L = (long)i * G + c; if (L >= nwg) return false;
        int wgid = (int)L; { const int q = nwg / NXCD, r = nwg % NXCD, xcd = wgid % NXCD, off = wgid / NXCD; wgid = (xcd < r ? xcd * (q + 1) : r * (q + 1) + (xcd - r) * q) + off; }
        const int nig = WGM * nN, gid = wgid / nig, fm = gid * WGM, gsz = (nM - fm) < WGM ? (nM - fm) : WGM;
        u.pm = fm + ((wgid % nig) % gsz); u.pn = (wgid % nig) / gsz; return true;
    }
    __device__ __forceinline__ void a_ready(const Unit&) const {}
    __device__ __forceinline__ void done(const Unit&) const {}
};

__device__ __forceinline__ unsigned cvt_pk_bf16(float lo, float hi) { unsigned r; asm volatile("v_cvt_pk_bf16_f32 %0, %1, %2" : "=v"(r) : "v"(lo), "v"(hi)); return r; }
typedef float f32x2 __attribute__((ext_vector_type(2)));
__device__ __forceinline__ float sigm(float x) { return __builtin_amdgcn_rcpf(1.0f + __expf(-x)); }
__device__ __forceinline__ void st8(bf16_t* p, const f32x4& v0, const f32x4& v1) {
    u32x4 w; w.x = cvt_pk_bf16(v0[0], v0[1]); w.y = cvt_pk_bf16(v0[2], v0[3]); w.z = cvt_pk_bf16(v1[0], v1[1]); w.w = cvt_pk_bf16(v1[2], v1[3]); *(u32x4*)p = w; }
__device__ __forceinline__ f32x4 sigm4(const f32x4& v) { return (f32x4){sigm(v[0]), sigm(v[1]), sigm(v[2]), sigm(v[3])}; }
struct EpiProj {
    static constexpr bool PERM = true, AFTER_DRAIN = false;
    bf16_t *U, *P1, *Q, *K, *V, *QI, *SGB;
    __device__ __forceinline__ void operator()(const f32x4 (&acc)[2][2][4][2], const Unit& u, int wr, int wc, int fr, int fq) const {
        const int row0 = u.pm * BM + wr * 64 + fr, pn = u.pn, cw = wc * 32 + 8 * fq;
        if (pn < 16) {
            bf16_t* base = (pn < 8 ? U : P1) + (size_t)(pn & 7) * 128 + cw;
#pragma unroll
            for (int ai = 0; ai < 2; ++ai)
#pragma unroll
                for (int m = 0; m < 4; ++m) {
                    f32x4 a0 = acc[ai][0][m][0], a1 = acc[ai][0][m][1], b0 = acc[ai][1][m][0], b1 = acc[ai][1][m][1];
                    if (pn >= 8) { b0 = sigm4(b0); b1 = sigm4(b1); }
                    st8(base + (size_t)(row0 + ai * HALF + m * 16) * 1024, a0 * b0, a1 * b1); }
        } else if (pn < 22 || (pn >= 24 && pn < 28)) {
            bf16_t* base; int ld; bool sg = false;
            if (pn < 20) { base = Q + (pn - 16) * 256; ld = 1024; }
            else if (pn == 20) { base = K; ld = 256; }
            else if (pn == 21) { base = V; ld = 256; }
            else { base = SGB + (pn - 24) * 256; ld = 1024; sg = true; }
#pragma unroll
            for (int ai = 0; ai < 2; ++ai)
#pragma unroll
                for (int m = 0; m < 4; ++m) { bf16_t* rowp = base + (size_t)(row0 + ai * HALF + m * 16) * ld + cw;
#pragma unroll
                    for (int bj = 0; bj < 2; ++bj) { f32x4 v0 = acc[ai][bj][m][0], v1 = acc[ai][bj][m][1];
                        if (sg) { v0 = sigm4(v0); v1 = sigm4(v1); }
                        st8(rowp + bj * HALF, v0, v1); } }
        } else {
            const bool isx1 = (fq == 0), roped = (((32 * wc + 8 * fq) & 63) < 16);
#pragma unroll
            for (int ai = 0; ai < 2; ++ai)
#pragma unroll
                for (int m = 0; m < 4; ++m) { const int row = row0 + ai * HALF + m * 16; const float pos = (float)(row & 2047);
                    float cs[8], sn[8];
#pragma unroll
                    for (int i = 0; i < 8; ++i) { const float inv = exp2f(-(float)i * (18.931568569324174f / 8.f)), ang = pos * inv; float rev = ang * 0.15915494309189535f; rev -= floorf(rev);
                        sn[i] = __builtin_amdgcn_sinf(rev); cs[i] = __builtin_amdgcn_cosf(rev); }
#pragma unroll
                    for (int bj = 0; bj < 2; ++bj) {
                        f32x4 v0 = acc[ai][bj][m][0], v1 = acc[ai][bj][m][1]; f32x4 o0, o1;
#pragma unroll
                        for (int i = 0; i < 4; ++i) { o0[i] = __shfl_xor(v0[i], 16); o1[i] = __shfl_xor(v1[i], 16); }
                        if (roped) {
#pragma unroll
                            for (int i = 0; i < 4; ++i) { v0[i] = isx1 ? v0[i] * cs[i] - o0[i] * sn[i] : v0[i] * cs[i] + o0[i] * sn[i]; v1[i] = isx1 ? v1[i] * cs[4 + i] - o1[i] * sn[4 + i] : v1[i] * cs[4 + i] + o1[i] * sn[4 + i]; } }
                        st8(QI + (size_t)row * 512 + (pn - 22) * 256 + bj * HALF + cw, v0, v1); } }
        }
    }
};
struct EpiBf16 {
    static constexpr bool PERM = true, AFTER_DRAIN = false;
    bf16_t* O; int ldc;
    __device__ __forceinline__ void operator()(const f32x4 (&acc)[2][2][4][2], const Unit& u, int wr, int wc, int fr, int fq) const {
        const int row0 = u.pm * BM + wr * 64 + fr, col0 = u.pn * BM + wc * 32 + 8 * fq;
#pragma unroll
        for (int ai = 0; ai < 2; ++ai)
#pragma unroll
            for (int m = 0; m < 4; ++m) { bf16_t* rowp = O + (size_t)(row0 + ai * HALF + m * 16) * ldc + col0;
#pragma unroll
                for (int bj = 0; bj < 2; ++bj) st8(rowp + bj * HALF, acc[ai][bj][m][0], acc[ai][bj][m][1]); }
    }
};
struct EpiResF32 {
    static constexpr bool PERM = false, AFTER_DRAIN = false;
    const float* base; float* out; int ldc;
    __device__ __forceinline__ void operator()(const f32x4 (&acc)[2][2][4][2], const Unit& u, int wr, int wc, int fr, int fq) const {
        const int row0 = u.pm * BM + wr * 64 + fr, col0 = u.pn * BM + wc * 32 + 4 * fq;
#pragma unroll
        for (int ai = 0; ai < 2; ++ai)
#pragma unroll
            for (int m = 0; m < 4; ++m) { const size_t off = (size_t)(row0 + ai * HALF + m * 16) * ldc + col0;
#pragma unroll
                for (int bj = 0; bj < 2; ++bj)
#pragma unroll
                    for (int n = 0; n < 2; ++n) { const size_t o = off + bj * HALF + n * 16; *(f32x4*)(out + o) = *(const f32x4*)(base + o) + acc[ai][bj][m][n]; } }
    }
};

__device__ __forceinline__ void epi_ld16(u32x4& d, unsigned off, const void* base) { asm volatile("global_load_dwordx4 %0, %1, %2" : "=&v"(d) : "v"(off), "s"(base) : "memory"); }
__device__ __forceinline__ u32x4 epi_mov4(const u32x4& s) { u32x4 d; asm volatile("v_mov_b32 %0, %4\n\tv_mov_b32 %1, %5\n\tv_mov_b32 %2, %6\n\tv_mov_b32 %3, %7" : "=&v"(d.x), "=&v"(d.y), "=&v"(d.z), "=&v"(d.w) : "v"(s.x), "v"(s.y), "v"(s.z), "v"(s.w)); return d; }
struct EpiResNorm {
    static constexpr bool PERM = true, AFTER_DRAIN = false;
    const float* base; bf16_t* HB; float* SSQ; int ldc;
    __device__ __forceinline__ void operator()(const f32x4 (&acc)[2][2][4][2], const Unit& u, int wr, int wc, int fr, int fq) const {
        const int row0 = u.pm * BM + wr * 64 + fr, col0 = u.pn * BM + wc * 32 + 8 * fq;
        const void* xb = base;
        u32x4 bufA[8], bufB[8];
#define EPI_ISSUE(BUF, G) do { _Pragma("unroll") for (int q_ = 0; q_ < 2; ++q_) { const int rg_ = 2 * (G) + q_, row_ = row0 + (rg_ >> 2) * HALF + (rg_ & 3) * 16; \
            _Pragma("unroll") for (int bj = 0; bj < 2; ++bj) _Pragma("unroll") for (int n = 0; n < 2; ++n) epi_ld16(BUF[q_ * 4 + bj * 2 + n], (unsigned)(row_ * ldc + col0 + bj * HALF + n * 4) * 4u, xb); } } while (0)
#define EPI_PROC(BUF, G) do { _Pragma("unroll") for (int q_ = 0; q_ < 2; ++q_) { const int rg_ = 2 * (G) + q_, ai = rg_ >> 2, m = rg_ & 3, row = row0 + ai * HALF + m * 16; const size_t off = (size_t)row * ldc + col0; float ss = 0.f; \
            _Pragma("unroll") for (int bj = 0; bj < 2; ++bj) { const u32x4 xa_ = epi_mov4(BUF[q_ * 4 + bj * 2]), xb_ = epi_mov4(BUF[q_ * 4 + bj * 2 + 1]); \
                const f32x4 v0 = __builtin_bit_cast(f32x4, xa_) + acc[ai][bj][m][0], v1 = __builtin_bit_cast(f32x4, xb_) + acc[ai][bj][m][1]; \
                ss += ((v0[0] * v0[0] + v0[1] * v0[1]) + (v0[2] * v0[2] + v0[3] * v0[3])) + ((v1[0] * v1[0] + v1[1] * v1[1]) + (v1[2] * v1[2] + v1[3] * v1[3])); \
                st8(HB + off + bj * HALF, v0, v1); } \
            ss += __shfl_xor(ss, 16); ss += __shfl_xor(ss, 32); \
            if (fq == 0) SSQ[(size_t)row * 16 + u.pn * 4 + wc] = ss; } } while (0)
#define EPI_WAIT(N) asm volatile("s_waitcnt vmcnt(" #N ")" ::: "memory")
        EPI_ISSUE(bufA, 0); EPI_ISSUE(bufB, 1);
        EPI_WAIT(8); EPI_PROC(bufA, 0); EPI_ISSUE(bufA, 2);
        EPI_WAIT(8); EPI_PROC(bufB, 1); EPI_ISSUE(bufB, 3);
        EPI_WAIT(8); EPI_PROC(bufA, 2);
        EPI_WAIT(0); EPI_PROC(bufB, 3);
#undef EPI_ISSUE
#undef EPI_PROC
#undef EPI_WAIT
    }
};
struct EpiBf16Scale {
    static constexpr bool PERM = true, AFTER_DRAIN = false;
    bf16_t* O; int ldc; const float* SSQ; float* RSTD; const PG8_LAS float* tab; int pm0, pn0; bool use_tab;
    __device__ __forceinline__ void operator()(const f32x4 (&acc)[2][2][4][2], const Unit& u, int wr, int wc, int fr, int fq) const {
        const int row0 = u.pm * BM + wr * 64 + fr, col0 = u.pn * BM + wc * 32 + 8 * fq;
        const PG8_LAS float* tb = tab + ((u.pm == pm0 && u.pn == pn0) ? 0 : 256) + wr * 64 + fr;
#pragma unroll
        for (int ai = 0; ai < 2; ++ai)
#pragma unroll
            for (int m = 0; m < 4; ++m) { const int row = row0 + ai * HALF + m * 16; float r;
                if (use_tab) r = tb[ai * HALF + m * 16];
                else { const f32x4* sp = (const f32x4*)(SSQ + (size_t)row * 16); const f32x4 s4 = (sp[0] + sp[1]) + (sp[2] + sp[3]); r = __builtin_amdgcn_rsqf(((s4[0] + s4[1]) + (s4[2] + s4[3])) * (1.f / 1024.f) + 1e-6f);
                    if (u.pn == 0 && wc == 0 && fq == 0) RSTD[row] = r; }
#pragma unroll
                for (int bj = 0; bj < 2; ++bj) { const int dim = wc * 32 + 8 * fq + bj * HALF;
                    st8(O + (((((size_t)(row >> 5) * 8 + u.pn) * 16 + (dim >> 4)) * 64 + ((dim >> 3) & 1) * 32 + (row & 31)) * 8), acc[ai][bj][m][0] * r, acc[ai][bj][m][1] * r); } }
    }
};

template <class Epi, class Sched, bool ALIGN_EPI = false, bool SP2 = false>
__device__ __forceinline__ void gemm_phase(PG8_LAS unsigned char* lds, const Gemm g, const Sched& S, const Epi& E) {
    const int tid = threadIdx.x, wid = __builtin_amdgcn_readfirstlane(tid >> 6), lane = tid & 63, wr = wid >> 2, wc = wid & 3, fr = lane & 15, fq = lane >> 4;
    const int K = g.K, nt = K / BK;
    unsigned voffA[2], voffB[2];
#pragma unroll
    for (int i = 0; i < 2; ++i) { int R, C; stage_rc(tid * 16 + i * 8192, R, C); const int Rb = Epi::PERM ? ((R & ~31) + perm32(R & 31)) : R;
        voffA[i] = (unsigned)(R * K + C) * 2u; voffB[i] = (unsigned)(Rb * K + C) * 2u; }
    const size_t kstep = (size_t)(BK * 2);
    const size_t hstep = (size_t)HALF * K * 2;
    const size_t tstep = 2 * hstep;
    const unsigned ldsw = (unsigned)wid * 1024u;
    const int aoff = lds_byte(wr * 64 + fr, fq * 8), boff = lds_byte(wc * 32 + fr, fq * 8);
#define PG8_SA(b, h) (((b) * 2 + (h)) * HTB)
#define PG8_SB(b, h) ((4 + (b) * 2 + (h)) * HTB)
#define PG8_STAGE(bufoff, gbase, voff) do { _Pragma("unroll") for (int _i = 0; _i < 2; ++_i) \
        __builtin_amdgcn_global_load_lds((const unsigned*)((const char*)(gbase) + (voff)[_i]), (PG8_LAS unsigned*)(lds + (bufoff) + ldsw + _i * 8192), 16, 0, 0); } while (0)
#define PG8_LDA(dst, b, h) do { _Pragma("unroll") for (int m = 0; m < 4; ++m) _Pragma("unroll") for (int k = 0; k < 2; ++k) dst[m][k] = *(const PG8_LAS bf16x8*)(lds + PG8_SA(b, h) + aoff + m * 2048 + k * 1024); } while (0)
#define PG8_LDB(dst, b, h) do { _Pragma("unroll") for (int n = 0; n < 2; ++n) _Pragma("unroll") for (int k = 0; k < 2; ++k) dst[n][k] = *(const PG8_LAS bf16x8*)(lds + PG8_SB(b, h) + boff + n * 2048 + k * 1024); } while (0)
#define PG8_MMA(ai, bj, At, Bt) do { __builtin_amdgcn_s_setprio(1); _Pragma("unroll") for (int m = 0; m < 4; ++m) _Pragma("unroll") for (int n = 0; n < 2; ++n) _Pragma("unroll") for (int k = 0; k < 2; ++k) \
        acc[ai][bj][m][n] = __builtin_amdgcn_mfma_f32_16x16x32_bf16(Bt[n][k], At[m][k], acc[ai][bj][m][n], 0, 0, 0); __builtin_amdgcn_s_setprio(0); } while (0)
#define PG8_WAIT_V(n) asm volatile("s_waitcnt vmcnt(" #n ")" ::: "memory")
#define PG8_WAIT_L(n) asm volatile("s_waitcnt lgkmcnt(" #n ")" ::: "memory")
#define PG8_BAR __builtin_amdgcn_s_barrier()
#define PG8_SCHED __builtin_amdgcn_sched_barrier(0)
    Unit cur, nxt; int ui = 0;
    if (!S.next(0, cur)) return;
    f32x4 acc[2][2][4][2];
#pragma unroll
    for (int a = 0; a < 2; ++a)
#pragma unroll
        for (int b = 0; b < 2; ++b)
#pragma unroll
            for (int m = 0; m < 4; ++m)
#pragma unroll
                for (int n = 0; n < 2; ++n) acc[a][b][m][n] = (f32x4){0.f, 0.f, 0.f, 0.f};
    bf16x8 At[4][2], B0[2][2], B1[2][2];
    const char* cA = (const char*)g.A + (size_t)cur.pm * tstep; const char* cB = (const char*)g.Bt + (size_t)cur.pn * tstep;
    S.a_ready(cur);
    if constexpr (SP2) {
        PG8_STAGE(PG8_SB(0, 0), cB, voffB); PG8_STAGE(PG8_SB(0, 1), cB + hstep, voffB); PG8_STAGE(PG8_SA(0, 0), cA, voffA); PG8_STAGE(PG8_SA(0, 1), cA + hstep, voffA);
        if (wr == 1) PG8_BAR;
        PG8_WAIT_V(2); PG8_BAR;
        PG8_STAGE(PG8_SB(1, 0), cB + kstep, voffB); PG8_STAGE(PG8_SA(1, 0), cA + kstep, voffA); PG8_STAGE(PG8_SB(1, 1), cB + hstep + kstep, voffB);
        PG8_WAIT_V(6); PG8_BAR;
    } else {
        PG8_STAGE(PG8_SB(0, 0), cB, voffB); PG8_STAGE(PG8_SA(0, 0), cA, voffA); PG8_STAGE(PG8_SB(0, 1), cB + hstep, voffB); PG8_STAGE(PG8_SA(0, 1), cA + hstep, voffA);
        if (wr == 1) PG8_BAR;
        PG8_WAIT_V(4); PG8_BAR;
        PG8_STAGE(PG8_SB(1, 0), cB + kstep, voffB); PG8_STAGE(PG8_SA(1, 0), cA + kstep, voffA); PG8_STAGE(PG8_SB(1, 1), cB + hstep + kstep, voffB);
        PG8_WAIT_V(6); PG8_BAR;
    }
    for (;;) {
        const bool has_next = S.next(ui + 1, nxt);
        const char* nA = has_next ? (const char*)g.A + (size_t)nxt.pm * tstep : cA; const char* nB = has_next ? (const char*)g.Bt + (size_t)nxt.pn * tstep : cB;
        for (int t = 0; t < nt; t += 2) {
            const bool last = (t == nt - 2);
            const char* a1 = cA + (size_t)(t + 1) * kstep;
            const char* a2 = last ? nA : cA + (size_t)(t + 2) * kstep; const char* b2 = last ? nB : cB + (size_t)(t + 2) * kstep;
            const char* a3 = a2 + kstep; const char* b3 = b2 + kstep;
            if (last && has_next) S.a_ready(nxt);
            if constexpr (SP2) {
            PG8_LDB(B0, 0, 0); PG8_LDB(B1, 0, 1); PG8_SCHED; PG8_LDA(At, 0, 0); PG8_STAGE(PG8_SA(1, 1), a1 + hstep, voffA);
            PG8_WAIT_V(8); PG8_WAIT_L(0); PG8_BAR; PG8_MMA(0, 0, At, B0); PG8_MMA(0, 1, At, B1); PG8_BAR; PG8_SCHED;
            PG8_LDA(At, 0, 1); PG8_STAGE(PG8_SB(0, 0), b2, voffB); PG8_STAGE(PG8_SB(0, 1), b2 + hstep, voffB); PG8_STAGE(PG8_SA(0, 0), a2, voffA);
            PG8_WAIT_V(8); PG8_WAIT_L(0); PG8_BAR; PG8_MMA(1, 0, At, B0); PG8_MMA(1, 1, At, B1); PG8_BAR; PG8_SCHED;
            PG8_LDB(B0, 1, 0); PG8_LDB(B1, 1, 1); PG8_SCHED; PG8_LDA(At, 1, 0); PG8_STAGE(PG8_SA(0, 1), a2 + hstep, voffA);
            PG8_WAIT_V(8); PG8_WAIT_L(0); PG8_BAR; PG8_MMA(0, 0, At, B0); PG8_MMA(0, 1, At, B1); PG8_BAR; PG8_SCHED;
            PG8_LDA(At, 1, 1); PG8_STAGE(PG8_SB(1, 0), b3, voffB); PG8_STAGE(PG8_SB(1, 1), b3 + hstep, voffB); PG8_STAGE(PG8_SA(1, 0), a3, voffA);
            PG8_WAIT_V(8); PG8_WAIT_L(0); PG8_BAR; PG8_MMA(1, 0, At, B0); PG8_MMA(1, 1, At, B1); PG8_BAR; PG8_SCHED;
            } else {
            PG8_LDB(B0, 0, 0); PG8_SCHED; PG8_LDA(At, 0, 0); PG8_STAGE(PG8_SA(1, 1), a1 + hstep, voffA);
            PG8_WAIT_L(8); PG8_BAR; PG8_WAIT_L(0); PG8_MMA(0, 0, At, B0); PG8_BAR; PG8_SCHED;
            PG8_LDB(B1, 0, 1); PG8_STAGE(PG8_SB(0, 0), b2, voffB);
            PG8_BAR; PG8_WAIT_L(0); PG8_MMA(0, 1, At, B1); PG8_BAR;
            PG8_LDA(At, 0, 1); PG8_STAGE(PG8_SA(0, 0), a2, voffA);
            PG8_BAR; PG8_WAIT_L(0); PG8_MMA(1, 0, At, B0); PG8_BAR; PG8_SCHED;
            PG8_STAGE(PG8_SB(0, 1), b2 + hstep, voffB);
            PG8_WAIT_V(6); PG8_BAR; PG8_MMA(1, 1, At, B1); PG8_BAR;
            PG8_LDB(B0, 1, 0); PG8_SCHED; PG8_LDA(At, 1, 0); PG8_STAGE(PG8_SA(0, 1), a2 + hstep, voffA);
            PG8_WAIT_L(8); PG8_BAR; PG8_WAIT_L(0); PG8_MMA(0, 0, At, B0); PG8_BAR; PG8_SCHED;
            PG8_LDB(B1, 1, 1); PG8_STAGE(PG8_SB(1, 0), b3, voffB);
            PG8_BAR; PG8_WAIT_L(0); PG8_MMA(0, 1, At, B1); PG8_BAR;
            PG8_LDA(At, 1, 1); PG8_STAGE(PG8_SA(1, 0), a3, voffA);
            PG8_BAR; PG8_WAIT_L(0); PG8_MMA(1, 0, At, B0); PG8_BAR; PG8_SCHED;
            PG8_STAGE(PG8_SB(1, 1), b3 + hstep, voffB);
            PG8_WAIT_V(6); PG8_BAR; PG8_MMA(1, 1, At, B1); PG8_BAR;
            }
        }
        if constexpr (ALIGN_EPI) { if (wr == 0) PG8_BAR; }
        if constexpr (!Epi::AFTER_DRAIN) { E(acc, cur, wr, wc, fr, fq); S.done(cur); }
        if (!has_next) break;
#pragma unroll
        for (int a = 0; a < 2; ++a)
#pragma unroll
            for (int b = 0; b < 2; ++b)
#pragma unroll
                for (int m = 0; m < 4; ++m)
#pragma unroll
                    for (int n = 0; n < 2; ++n) acc[a][b][m][n] = (f32x4){0.f, 0.f, 0.f, 0.f};
        cur = nxt; cA = nA; cB = nB; ++ui;
        if constexpr (ALIGN_EPI) { if (wr == 1) PG8_BAR; }
    }
    PG8_WAIT_V(0);
    if constexpr (!ALIGN_EPI) { if (wr == 0) PG8_BAR; }
    PG8_BAR;
    if constexpr (Epi::AFTER_DRAIN) { E.fused(acc, cur, wr, wc, fr, fq, lds, wid, lane); S.done(cur); }
#undef PG8_SA
#undef PG8_SB
#undef PG8_STAGE
#undef PG8_LDA
#undef PG8_LDB
#undef PG8_MMA
#undef PG8_WAIT_V
#undef PG8_WAIT_L
#undef PG8_BAR
#undef PG8_SCHED
}
}
constexpr int T = 16384, D = 1024, SEQ = 2048, NBATCH = 8;
constexpr int NPROJ = 7168;
constexpr int NPROJ_T = 7264;
constexpr float EPS = 1e-6f;
constexpr float ATTN_SCALE = 0.08838834764831845f, IDX_SCALE = 0.125f, IDX_W_SCALE = 0.35355339059327373f;
constexpr float LOG2_THETA = 18.931568569324174f;
constexpr int NWAVES = 8, NTHR = 512;

constexpr size_t MiB = 1u << 20;
constexpr size_t WS_CTL = 0, CTL_ZERO_BYTES = 64 * 1024;
constexpr size_t WS_WIN = 1 * MiB;
constexpr size_t WS_WO = 16 * MiB;
constexpr size_t WS_WQ = 18 * MiB;
constexpr size_t WS_K1 = 22 * MiB, WS_K2 = WS_K1 + 256 * 1024;
constexpr size_t WS_UB = 24 * MiB, WS_VB = 56 * MiB;
constexpr size_t WS_XN = 88 * MiB;
constexpr size_t WS_P1 = 120 * MiB;
constexpr size_t WS_U = 152 * MiB;
constexpr size_t WS_Q = 184 * MiB;
constexpr size_t WS_K = 216 * MiB, WS_V = 224 * MiB;
constexpr size_t WS_QI = 232 * MiB;
constexpr size_t WS_KI = 248 * MiB;
constexpr size_t WS_WI = 250 * MiB;
constexpr size_t WS_MASK = 251 * MiB;
constexpr size_t WS_END = 256 * MiB;
constexpr size_t WS_PQ = 120 * MiB;
constexpr size_t WS_EIDX = 184 * MiB, WS_GATE = 192 * MiB;

constexpr int LDS_BYTES = 147456;
constexpr int MISC_OFF = 147456 - 256;
constexpr int CW_RANK = 8192;
constexpr int CW_BAR = 1024;

#define LAS __attribute__((address_space(3)))
typedef unsigned short bf16;
typedef unsigned v4u __attribute__((ext_vector_type(4)));
typedef unsigned v2u __attribute__((ext_vector_type(2)));
typedef float f32x4 __attribute__((ext_vector_type(4)));
typedef __bf16 bf16x2_t __attribute__((ext_vector_type(2)));

__device__ __forceinline__ unsigned f2bf(float f) { unsigned u = __builtin_bit_cast(unsigned, f); return (u + 0x7fffu + ((u >> 16) & 1u)) >> 16; }
__device__ __forceinline__ unsigned pk2(float lo, float hi) { return f2bf(lo) | (f2bf(hi) << 16); }
__device__ __forceinline__ float bflo(unsigned w) { return __builtin_bit_cast(float, w << 16); }
__device__ __forceinline__ float bfhi(unsigned w) { return __builtin_bit_cast(float, w & 0xffff0000u); }
__device__ __forceinline__ float bf1(bf16 h) { return __builtin_bit_cast(float, (unsigned)h << 16); }
__device__ __forceinline__ float dot2bf(unsigned a, unsigned b, float acc) { return __builtin_amdgcn_fdot2_f32_bf16(__builtin_bit_cast(bf16x2_t, a), __builtin_bit_cast(bf16x2_t, b), acc, false); }
#define DPP_XOR1 0xB1
#define DPP_XOR2 0x4E
#define DPP_ROR(n) (0x120 + (n))
__device__ __forceinline__ float wave_sum(float v) {
#pragma unroll
    for (int o = 1; o < 64; o <<= 1) v += __shfl_xor(v, o);
    return v; }
__device__ __forceinline__ float wave_max(float v) {
#pragma unroll
    for (int o = 1; o < 64; o <<= 1) v = fmaxf(v, __shfl_xor(v, o));
    return v; }
__device__ __forceinline__ int wave_sumi(int v) {
#pragma unroll
    for (int o = 1; o < 64; o <<= 1) v += __shfl_xor(v, o);
    return v; }
__device__ __forceinline__ int wave_mini(int v) {
#pragma unroll
    for (int o = 1; o < 64; o <<= 1) v = min(v, __shfl_xor(v, o));
    return v; }
__device__ __forceinline__ int wave_incl_scan(int v, int lane) {
#pragma unroll
    for (int o = 1; o < 64; o <<= 1) { const int x = __shfl_up(v, o); if (lane >= o) v += x; }
    return v; }
#define LDS_WAIT() asm volatile("s_waitcnt lgkmcnt(0)" ::: "memory")

struct Args { const float* in[13]; float* out; unsigned char* ws; int ph_lo, ph_hi; };

struct Ctx {
    unsigned char* lds; int tid, lane, wave, G, bid;
    const float *x, *g1, *w_in, *conv_w, *qg, *kg, *w_o, *g2, *pwq, *pk1, *pk2, *pu, *pv; float* out;
    bf16 *WIN, *WO, *WQ, *K1, *K2, *UB, *VB, *XN, *P1, *U, *Q, *K, *V, *QI, *KI, *SGB, *PQ;
    float *WI, *GATE, *PD; unsigned* MASK; int* EIDX;
    bool late_jobs;
    int cls, crank, cnb;
};

#define HB_OF(F) ((bf16*)((unsigned char*)(F).Q + 16 * MiB))
#define SSQ_OF(F) ((float*)((unsigned char*)(F).MASK + 4 * MiB))
#define RSTD_OF(F) ((float*)((unsigned char*)(F).K1 + 512 * 1024))
__device__ __forceinline__ int win_src_col(int n) {
    if (n < 2048) { const int ch = ((n >> 8) << 7) + (n & 127); return ((n >> 7) & 1) ? 2048 + ch : 1024 + ch; }
    if (n < 4096) { const int m = n - 2048, ch = ((m >> 8) << 7) + (m & 127); return ((m >> 7) & 1) ? 5192 + ch : ch; }
    if (n < 5120) return 3072 + (n - 4096);
    if (n < 5376) return 4096 + (n - 5120);
    if (n < 5632) return 4352 + (n - 5376);
    if (n < 6144) return 4608 + (n - 5632);
    if (n < 7168) return 6216 + (n - 6144);
    if (n < 7232) return 5120 + (n - 7168);
    if (n < 7240) return 5184 + (n - 7232);
    return -1;
}

template <bool MAPPED, bool GAIN = false>
__device__ __forceinline__ void transpose_item(const float* W, int K, int N, bf16* WT, float* scr, int item, int nblk, int lane, const float* gain = nullptr) {
    const int kb = item / nblk, nb = item % nblk, k0 = 64 * kb, n0 = 32 * nb;
    int src = n0 + (lane & 31); if (MAPPED) src = win_src_col(src);
    float tv[32];
#pragma unroll
    for (int i = 0; i < 32; ++i) { const int kk = 2 * i + (lane >> 5); tv[i] = (src >= 0) ? W[(size_t)(k0 + kk) * N + src] : 0.f; }
#pragma unroll
    for (int i = 0; i < 32; ++i) { const int kk = 2 * i + (lane >> 5); scr[kk * 33 + (lane & 31)] = tv[i]; }
    LDS_WAIT(); asm volatile("" ::: "memory");
    const int c = lane & 7;
    f32x4 ga = {1.f, 1.f, 1.f, 1.f}, gb = ga; if (GAIN) { ga = *(const f32x4*)(gain + k0 + 8 * c); gb = *(const f32x4*)(gain + k0 + 8 * c + 4); }
#pragma unroll
    for (int j = 0; j < 4; ++j) { const int n = (lane >> 3) + 8 * j; const float* s = scr + (8 * c) * 33 + n;
        v4u o; o.x = pk2(s[0 * 33] * ga[0], s[1 * 33] * ga[1]); o.y = pk2(s[2 * 33] * ga[2], s[3 * 33] * ga[3]); o.z = pk2(s[4 * 33] * gb[0], s[5 * 33] * gb[1]); o.w = pk2(s[6 * 33] * gb[2], s[7 * 33] * gb[3]);
        size_t wo = (size_t)(n0 + n) * K + k0 + 8 * c;
        if (MAPPED && n0 >= NPROJ) { const int nr = n0 + n - NPROJ, kc = (k0 >> 3) + c;
            wo = (size_t)NPROJ * K + ((((size_t)(nr >> 4) * 32 + (kc >> 2)) * 64 + (kc & 3) * 16 + (nr & 15)) * 8); }
        *(v4u*)(WT + wo) = o; }
    LDS_WAIT(); asm volatile("" ::: "memory");
}
__device__ __forceinline__ void cvt8(const float* src, bf16* dst, size_t i) {
    const f32x4 a = *(const f32x4*)(src + i), b = *(const f32x4*)(src + i + 4);
    v4u o; o.x = pk2(a[0], a[1]); o.y = pk2(a[2], a[3]); o.z = pk2(b[0], b[1]); o.w = pk2(b[2], b[3]); *(v4u*)(dst + i) = o;
}
constexpr float U8_SCALE = 64.f, V8_SCALE = 8.f;
__device__ __forceinline__ size_t tbl8_off(size_t c16) { const size_t e = c16 >> 6, q = c16 & 63; return (q >> 3) * (size_t)(16384 * 128) + e * 128 + (q & 7) * 16; }
__device__ __forceinline__ unsigned pk4_fp8(const f32x4& a, float s) { int p = 0; p = __builtin_amdgcn_cvt_pk_fp8_f32(a[0] * s, a[1] * s, p, false); p = __builtin_amdgcn_cvt_pk_fp8_f32(a[2] * s, a[3] * s, p, true); return (unsigned)p; }
__device__ __forceinline__ void cvt16_fp8(const float* src, unsigned char* dst, size_t i, float s) {
    const f32x4 a = *(const f32x4*)(src + i), b = *(const f32x4*)(src + i + 4), c = *(const f32x4*)(src + i + 8), d = *(const f32x4*)(src + i + 12);
    v4u o; o.x = pk4_fp8(a, s); o.y = pk4_fp8(b, s); o.z = pk4_fp8(c, s); o.w = pk4_fp8(d, s); *(v4u*)(dst + i) = o;
}
__device__ __forceinline__ void rms_row2_to_bf16(const float* xrow0, const float* xrow1, const float* g, bf16* orow0, bf16* orow1, int lane) {
    const f32x4* xa = (const f32x4*)xrow0 + lane; const f32x4* xb = (const f32x4*)xrow1 + lane; f32x4 va[4], vb[4]; float sa = 0.f, sb = 0.f;
#pragma unroll
    for (int j = 0; j < 4; ++j) { va[j] = xa[64 * j]; vb[j] = xb[64 * j]; }
#pragma unroll
    for (int j = 0; j < 4; ++j) { sa += (va[j].x * va[j].x + va[j].y * va[j].y) + (va[j].z * va[j].z + va[j].w * va[j].w); sb += (vb[j].x * vb[j].x + vb[j].y * vb[j].y) + (vb[j].z * vb[j].z + vb[j].w * vb[j].w); }
#pragma unroll
    for (int o = 1; o < 64; o <<= 1) { sa += __shfl_xor(sa, o); sb += __shfl_xor(sb, o); }
    const float ra = rsqrtf(sa * (1.f / 1024.f) + EPS), rb = rsqrtf(sb * (1.f / 1024.f) + EPS);
    v2u* oa = (v2u*)orow0 + lane; v2u* ob = (v2u*)orow1 + lane;
#pragma unroll
    for (int j = 0; j < 4; ++j) { const f32x4 gv = ((const f32x4*)g)[lane + 64 * j]; v2u w;
        w.x = pk2(va[j].x * ra * gv.x, va[j].y * ra * gv.y); w.y = pk2(va[j].z * ra * gv.z, va[j].w * ra * gv.w); oa[64 * j] = w;
        w.x = pk2(vb[j].x * rb * gv.x, vb[j].y * rb * gv.y); w.y = pk2(vb[j].z * rb * gv.z, vb[j].w * rb * gv.w); ob[64 * j] = w; }
}
__device__ __forceinline__ void rms_rows(const float* X, const float* g, bf16* O, int gw, int NGW, int lane) {
    f32x4 gq[4];
#pragma unroll
    for (int q = 0; q < 4; ++q) gq[q] = ((const f32x4*)g)[lane + 64 * q];
    for (int m0 = gw; m0 < T; m0 += 4 * NGW) {
        int mr[4]; f32x4 v[4][4]; float ss[4];
#pragma unroll
        for (int j = 0; j < 4; ++j) { mr[j] = (m0 + j * NGW < T) ? m0 + j * NGW : m0; const f32x4* xr = (const f32x4*)(X + (size_t)mr[j] * D) + lane;
#pragma unroll
            for (int q = 0; q < 4; ++q) v[j][q] = xr[64 * q]; }
#pragma unroll
        for (int j = 0; j < 4; ++j) { float s = 0.f;
#pragma unroll
            for (int q = 0; q < 4; ++q) s += (v[j][q].x * v[j][q].x + v[j][q].y * v[j][q].y) + (v[j][q].z * v[j][q].z + v[j][q].w * v[j][q].w);
            ss[j] = s; }
#pragma unroll
        for (int o = 1; o < 64; o <<= 1) {
#pragma unroll
            for (int j = 0; j < 4; ++j) ss[j] += __shfl_xor(ss[j], o); }
#pragma unroll
        for (int j = 0; j < 4; ++j) { const float r = rsqrtf(ss[j] * (1.f / 1024.f) + EPS); v2u* op = (v2u*)(O + (size_t)mr[j] * D) + lane;
#pragma unroll
            for (int q = 0; q < 4; ++q) { const f32x4 gv = gq[q]; v2u w;
                w.x = pk2(v[j][q].x * r * gv.x, v[j][q].y * r * gv.y); w.y = pk2(v[j][q].z * r * gv.z, v[j][q].w * r * gv.w); op[64 * q] = w; } }
    }
}
__device__ __forceinline__ void rms_row_to_bf16(const float* xrow, const float* g, bf16* orow, int lane) {
    const f32x4* xr = (const f32x4*)xrow + lane; f32x4 v[4]; float s = 0.f;
#pragma unroll
    for (int j = 0; j < 4; ++j) { v[j] = xr[64 * j]; s += (v[j].x * v[j].x + v[j].y * v[j].y) + (v[j].z * v[j].z + v[j].w * v[j].w); }
    const float rstd = rsqrtf(wave_sum(s) * (1.f / 1024.f) + EPS);
    v2u* o8 = (v2u*)orow + lane;
#pragma unroll
    for (int j = 0; j < 4; ++j) { const f32x4 gv = ((const f32x4*)g)[lane + 64 * j]; v2u w; w.x = pk2(v[j].x * rstd * gv.x, v[j].y * rstd * gv.y); w.y = pk2(v[j].z * rstd * gv.z, v[j].w * rstd * gv.w); o8[64 * j] = w; }
}
constexpr float U4_SCALE = 64.f, V4_SCALE = 5.656854249f;
__device__ __forceinline__ size_t tbl4_off(size_t c32) { const size_t e = c32 >> 5, q = c32 & 31; return (q >> 3) * (size_t)(16384 * 128) + e * 128 + (q & 7) * 16; }
__device__ __forceinline__ unsigned pk8_fp4(const f32x4& a, const f32x4& b, float s) { unsigned p = 0;
    p = __builtin_amdgcn_cvt_scalef32_pk_fp4_f32(p, a[0] * s, a[1] * s, 1.0f, 0); p = __builtin_amdgcn_cvt_scalef32_pk_fp4_f32(p, a[2] * s, a[3] * s, 1.0f, 1);
    p = __builtin_amdgcn_cvt_scalef32_pk_fp4_f32(p, b[0] * s, b[1] * s, 1.0f, 2); p = __builtin_amdgcn_cvt_scalef32_pk_fp4_f32(p, b[2] * s, b[3] * s, 1.0f, 3); return p; }
__device__ __forceinline__ void tables_job(Ctx& F, size_t gt, size_t NGT) {
    const int lane = (int)(gt & 63); const size_t wv = gt >> 6, NWV = NGT >> 6;
    constexpr size_t NIT = (size_t)16384 * 4;
    f32x4 gc[4];
#pragma unroll
    for (int c = 0; c < 4; ++c) gc[c] = *(const f32x4*)(F.g2 + c * 256 + lane * 4);
    for (size_t i0 = wv; i0 < NIT; i0 += 8 * NWV) {
        size_t it[8]; f32x4 a[8], b[8];
#pragma unroll
        for (int j = 0; j < 8; ++j) { it[j] = (i0 + j * NWV < NIT) ? i0 + j * NWV : i0; const size_t src = it[j] * 256 + lane * 4;
            a[j] = *(const f32x4*)(F.pu + src); b[j] = *(const f32x4*)(F.pv + src); }
#pragma unroll
        for (int j = 0; j < 8; ++j) { const size_t e = it[j] >> 2, c = it[j] & 3; const size_t dst = c * (size_t)(16384 * 128) + e * 128 + lane * 2;
            const f32x4 gq = (c == 0) ? gc[0] : (c == 1) ? gc[1] : (c == 2) ? gc[2] : gc[3]; const f32x4 au = a[j] * gq;
            unsigned pu4 = 0, pv4 = 0;
            pu4 = __builtin_amdgcn_cvt_scalef32_pk_fp4_f32(pu4, au[0] * U4_SCALE, au[1] * U4_SCALE, 1.0f, 0); pu4 = __builtin_amdgcn_cvt_scalef32_pk_fp4_f32(pu4, au[2] * U4_SCALE, au[3] * U4_SCALE, 1.0f, 1);
            pv4 = __builtin_amdgcn_cvt_scalef32_pk_fp4_f32(pv4, b[j][0] * V4_SCALE, b[j][1] * V4_SCALE, 1.0f, 0); pv4 = __builtin_amdgcn_cvt_scalef32_pk_fp4_f32(pv4, b[j][2] * V4_SCALE, b[j][3] * V4_SCALE, 1.0f, 1);
            *(unsigned short*)((unsigned char*)F.UB + dst) = (unsigned short)pu4; *(unsigned short*)((unsigned char*)F.VB + dst) = (unsigned short)pv4; }
    }
}
__device__ __forceinline__ void late_weights_job(Ctx& F, float* scr, int gw, int NGW, size_t gt, size_t NGT) {
    constexpr int I_O = 16 * 32, I_Q = 16 * 64;
    for (int it = gw; it < I_O + I_Q; it += NGW) {
        if (it < I_O) transpose_item<false>(F.w_o, 1024, 1024, F.WO, scr, it, 32, F.lane);
        else transpose_item<false, true>(F.pwq, 1024, 2048, F.WQ, scr, it - I_O, 64, F.lane, F.g2); }
    for (size_t i = gt; i < (size_t)(8 * 128 * 128) / 8; i += NGT) { cvt8(F.pk1, F.K1, i * 8); cvt8(F.pk2, F.K2, i * 8); }
}
__device__ __forceinline__ void phase_prologue(Ctx& F) {
    float* scr = (float*)(F.lds + F.wave * 16384);
    const int gw = F.bid * NWAVES + F.wave, NGW = F.G * NWAVES;
    constexpr int I_IN = 16 * (NPROJ_T / 32);
    const size_t gt = (size_t)F.bid * NTHR + F.tid, NGT = (size_t)F.G * NTHR;
    for (int st = 0; st < 2; ++st) { const int which = (st + F.wave) & 1;
    if (which == 0) {
    for (int it = gw; it < I_IN; it += NGW) transpose_item<true>(F.w_in, 1024, 7240, F.WIN, scr, it, NPROJ_T / 32, F.lane);
    } else {
    rms_rows(F.x, F.g1, F.XN, gw, NGW, F.lane);
    } }
    if (!F.late_jobs) { late_weights_job(F, scr, gw, NGW, gt, NGT); tables_job(F, gt, NGT); }
}

__device__ __forceinline__ void rope_cs(float pos, int i, float inv_half, float& c, float& s) {
    const float inv = exp2f(-(float)i * inv_half * LOG2_THETA), ang = pos * inv;
    float rev = ang * 0.15915494309189535f; rev -= floorf(rev);
    s = __builtin_amdgcn_sinf(rev); c = __builtin_amdgcn_cosf(rev);
}
__device__ __forceinline__ void phase_ki(Ctx& F) {
    typedef short bf16x8 __attribute__((ext_vector_type(8)));
    int lane = F.lane; asm volatile("" : "+v"(lane));
    const int w = F.wave, fr = lane & 15, fq = lane >> 4;
    LAS f32x4* red = (LAS f32x4*)F.lds;
    for (int tb = F.bid; tb < T / 64; tb += F.G) {
        const char* Ab = (const char*)F.XN + ((size_t)(tb * 64 + fr) * 1024 + w * 128 + fq * 8) * 2;
        const char* Bb = (const char*)F.WIN + ((size_t)NPROJ * 1024 + ((size_t)(4 * w) * 64 + lane) * 8) * 2;
        bf16x8 a[4][4], b[5][4];
#pragma unroll
        for (int kk = 0; kk < 4; ++kk) {
#pragma unroll
            for (int m = 0; m < 4; ++m) a[m][kk] = *(const bf16x8*)(Ab + m * (16 * 2048) + kk * 64);
#pragma unroll
            for (int n = 0; n < 5; ++n) b[n][kk] = *(const bf16x8*)(Bb + (n * 32 + kk) * 1024); }
        __builtin_amdgcn_sched_barrier(0);
        f32x4 acc[4][5];
#pragma unroll
        for (int m = 0; m < 4; ++m)
#pragma unroll
            for (int n = 0; n < 5; ++n) acc[m][n] = (f32x4){0.f, 0.f, 0.f, 0.f};
#pragma unroll
        for (int kk = 0; kk < 4; ++kk)
#pragma unroll
            for (int m = 0; m < 4; ++m)
#pragma unroll
                for (int n = 0; n < 5; ++n) acc[m][n] = __builtin_amdgcn_mfma_f32_16x16x32_bf16(b[n][kk], a[m][kk], acc[m][n], 0, 0, 0);
        LAS f32x4* mine = red + (w & 3) * (20 * 64) + lane;
        if (w >= 4) {
#pragma unroll
            for (int m = 0; m < 4; ++m)
#pragma unroll
                for (int n = 0; n < 5; ++n) mine[(m * 5 + n) * 64] = acc[m][n]; }
        __syncthreads();
        if (w < 4) {
#pragma unroll
            for (int m = 0; m < 4; ++m)
#pragma unroll
                for (int n = 0; n < 5; ++n) mine[(m * 5 + n) * 64] = acc[m][n] + mine[(m * 5 + n) * 64]; }
        __syncthreads();
        const int mf = w & 3, token = tb * 64 + mf * 16 + fr, nf0 = (w < 4) ? 0 : 3, nfn = (w < 4) ? 3 : 2;
        for (int q = 0; q < nfn; ++q) { const int nf = nf0 + q; LAS f32x4* rp = red + (mf * 5 + nf) * 64 + lane;
            f32x4 v = (rp[0] + rp[20 * 64]) + (rp[40 * 64] + rp[60 * 64]);
            if (nf == 0) { const float pos = (float)(token & 2047);
#pragma unroll
                for (int r = 0; r < 4; ++r) { const float o = __shfl_xor(v[r], 32); float c, s; rope_cs(pos, 4 * (fq & 1) + r, 1.f / 8.f, c, s); v[r] = (fq < 2) ? v[r] * c - o * s : v[r] * c + o * s; } }
            if (nf < 4) { v2u o; o.x = pk2(v[0], v[1]); o.y = pk2(v[2], v[3]);
                *(v2u*)(F.KI + ((((size_t)(token >> 5) * 4 + nf) * 64 + ((fq >> 1) & 1) * 32 + (token & 31)) * 8 + (fq & 1) * 4)) = o; }
            else if (fq < 2) *(f32x4*)(F.WI + (size_t)token * 8 + fq * 4) = v * IDX_W_SCALE; }
        __syncthreads();
    }
}

__device__ __forceinline__ void phase_post(Ctx& F) {
    const int gw = F.bid * NWAVES + F.wave, NGW = F.G * NWAVES, lane = F.lane;
    const int gt = F.bid * NTHR + F.tid, NGT = F.G * NTHR;
    for (int st = 0; st < 2; ++st) { const int which = (st + F.wave) & 1;
    if (which == 0) {
    { constexpr int NWI = T * 2 / 8; const int sub = lane & 7;
      for (int wi0 = gw; wi0 < NWI; wi0 += 4 * NGW) {
        bf16* p[4]; const float* g[4]; v4u a[4], b[4]; float pos[4];
#pragma unroll
        for (int j = 0; j < 4; ++j) { const int wi = (wi0 + j * NGW < NWI) ? wi0 + j * NGW : wi0; const int unit = wi * 8 + (lane >> 3), t = unit >> 1, hh = unit & 1;
            p[j] = F.K + (size_t)t * 256 + hh * 128 + sub * 16;
            g[j] = F.kg + sub * 16; pos[j] = (float)(t & (SEQ - 1));
            a[j] = *(const v4u*)p[j]; b[j] = *(const v4u*)(p[j] + 8); }
#pragma unroll
        for (int j = 0; j < 4; ++j) {
            float v[16];
            v[0] = bflo(a[j].x); v[1] = bfhi(a[j].x); v[2] = bflo(a[j].y); v[3] = bfhi(a[j].y); v[4] = bflo(a[j].z); v[5] = bfhi(a[j].z); v[6] = bflo(a[j].w); v[7] = bfhi(a[j].w);
            v[8] = bflo(b[j].x); v[9] = bfhi(b[j].x); v[10] = bflo(b[j].y); v[11] = bfhi(b[j].y); v[12] = bflo(b[j].z); v[13] = bfhi(b[j].z); v[14] = bflo(b[j].w); v[15] = bfhi(b[j].w);
            float ss = 0.f;
#pragma unroll
            for (int i = 0; i < 16; ++i) ss += v[i] * v[i];
            ss += __int_as_float(__builtin_amdgcn_mov_dpp(__float_as_int(ss), DPP_XOR1, 0xF, 0xF, true)); ss += __int_as_float(__builtin_amdgcn_mov_dpp(__float_as_int(ss), DPP_XOR2, 0xF, 0xF, true)); ss += __shfl_xor(ss, 4);
            const float rstd = rsqrtf(ss * (1.f / 128.f) + EPS);
#pragma unroll
            for (int i = 0; i < 16; ++i) v[i] = v[i] * rstd * g[j][i];
#pragma unroll
            for (int i = 0; i < 16; ++i) { const float o = __int_as_float(__builtin_amdgcn_mov_dpp(__float_as_int(v[i]), DPP_XOR1, 0xF, 0xF, true)); float c, s; rope_cs(pos[j], i, 1.f / 16.f, c, s);
                if (sub == 0) v[i] = v[i] * c - o * s; else if (sub == 1) v[i] = v[i] * c + o * s; }
            v4u oa, ob;
            oa.x = pk2(v[0], v[1]); oa.y = pk2(v[2], v[3]); oa.z = pk2(v[4], v[5]); oa.w = pk2(v[6], v[7]);
            ob.x = pk2(v[8], v[9]); ob.y = pk2(v[10], v[11]); ob.z = pk2(v[12], v[13]); ob.w = pk2(v[14], v[15]);
            if (j == 0 || wi0 + j * NGW < NWI) { *(v4u*)p[j] = oa; *(v4u*)(p[j] + 8) = ob; }
        }
      } }
    } else {
    for (int id0 = gt; id0 < T * 128; id0 += 4 * NGT) {
        v4u p1[4], u0[4], u1[4], u2[4]; f32x4 w[4][6]; size_t o[4];
#pragma unroll
        for (int j = 0; j < 4; ++j) { int id = id0 + j * NGT; if (id >= T * 128) id = id0; const int t = id >> 7, c8 = (id & 127) * 8, s = t & (SEQ - 1); o[j] = (size_t)t * 1024 + c8;
            p1[j] = *(const v4u*)(F.P1 + o[j]); u0[j] = *(const v4u*)(F.U + o[j]);
            u1[j] = (s >= 1) ? *(const v4u*)(F.U + o[j] - 1024) : (v4u){0u, 0u, 0u, 0u};
            u2[j] = (s >= 2) ? *(const v4u*)(F.U + o[j] - 2048) : (v4u){0u, 0u, 0u, 0u};
#pragma unroll
            for (int r = 0; r < 3; ++r) { w[j][2 * r] = *(const f32x4*)(F.conv_w + r * 1024 + c8); w[j][2 * r + 1] = *(const f32x4*)(F.conv_w + r * 1024 + c8 + 4); } }
#pragma unroll
        for (int j = 0; j < 4; ++j) { v4u r;
#define CV(pw, a0, a1, a2, i0, i1, W0, W1, W2) pk2(bflo(pw) * (W0[i0] * bflo(a2) + W1[i0] * bflo(a1) + W2[i0] * bflo(a0)), bfhi(pw) * (W0[i1] * bfhi(a2) + W1[i1] * bfhi(a1) + W2[i1] * bfhi(a0)))
            r.x = CV(p1[j].x, u0[j].x, u1[j].x, u2[j].x, 0, 1, w[j][0], w[j][2], w[j][4]); r.y = CV(p1[j].y, u0[j].y, u1[j].y, u2[j].y, 2, 3, w[j][0], w[j][2], w[j][4]);
            r.z = CV(p1[j].z, u0[j].z, u1[j].z, u2[j].z, 0, 1, w[j][1], w[j][3], w[j][5]); r.w = CV(p1[j].w, u0[j].w, u1[j].w, u2[j].w, 2, 3, w[j][1], w[j][3], w[j][5]);
#undef CV
            if (j == 0 || id0 + j * NGT < T * 128) *(v4u*)(F.P1 + o[j]) = r; }
    }
    } }
}

__device__ __forceinline__ unsigned f2key(float f) { const unsigned u = __builtin_bit_cast(unsigned, f); return (u >> 31) ? ~u : (u | 0x80000000u); }
__device__ __forceinline__ unsigned causal_word(int j, int s) { const int lo = 32 * j; return (lo + 31 <= s) ? 0xffffffffu : (lo > s ? 0u : ((1u << (s - lo + 1)) - 1u)); }
__device__ __forceinline__ void phase_indexer_simple(Ctx& F) {
    float* qf = (float*)F.lds; float* wsc = qf + 512; int* cnts = (int*)(wsc + 8); unsigned* gew = (unsigned*)(cnts + 16); unsigned* gtw = gew + 64;
    const int tid = F.tid, lane = F.lane, wave = F.wave;
    for (int t = F.bid; t < T; t += F.G) {
        const int s = t & (SEQ - 1), b = t >> 11;
        unsigned* mrow = F.MASK + (size_t)t * 64;
        if (s < 256) { if (tid < 64) mrow[tid] = causal_word(tid, s); continue; }
        qf[tid] = bf1(F.QI[(size_t)t * 512 + tid]); if (tid < 8) wsc[tid] = F.WI[(size_t)t * 8 + tid] * IDX_SCALE;
        __syncthreads();
        unsigned key[4];
#pragma unroll 1
        for (int j = 0; j < 4; ++j) {
            const int sk = tid + 512 * j; key[j] = 0u;
            if (sk <= s) {
                const v4u* kr = (const v4u*)(F.KI + ((size_t)b * SEQ + sk) * 64);
                float kf[64];
#pragma unroll
                for (int c = 0; c < 8; ++c) { const v4u w = kr[c]; kf[8 * c] = bflo(w.x); kf[8 * c + 1] = bfhi(w.x); kf[8 * c + 2] = bflo(w.y); kf[8 * c + 3] = bfhi(w.y); kf[8 * c + 4] = bflo(w.z); kf[8 * c + 5] = bfhi(w.z); kf[8 * c + 6] = bflo(w.w); kf[8 * c + 7] = bfhi(w.w); }
                float sc = 0.f;
#pragma unroll
                for (int h = 0; h < 8; ++h) { float d = 0.f;
#pragma unroll
                    for (int e = 0; e < 64; ++e) d += qf[h * 64 + e] * kf[e];
                    sc += wsc[h] * fmaxf(d, 0.f); }
                key[j] = f2key(sc);
            }
        }
        unsigned thr = 0u;
        for (int bit = 31; bit >= 0; --bit) {
            const unsigned cand = thr | (1u << bit);
            int c = (key[0] >= cand) + (key[1] >= cand) + (key[2] >= cand) + (key[3] >= cand);
            c = wave_sumi(c);
            if (lane == 0) cnts[(bit & 1) * 8 + wave] = c;
            __syncthreads();
            int tot = 0;
#pragma unroll
            for (int w = 0; w < 8; ++w) tot += cnts[(bit & 1) * 8 + w];
            if (tot >= 256) thr = cand;
        }
#pragma unroll
        for (int j = 0; j < 4; ++j) { const unsigned long long ge = __ballot(key[j] >= thr), gt = __ballot(key[j] > thr);
            if (lane == 0) { const int w = 16 * j + 2 * wave; gew[w] = (unsigned)ge; gew[w + 1] = (unsigned)(ge >> 32); gtw[w] = (unsigned)gt; gtw[w + 1] = (unsigned)(gt >> 32); } }
        __syncthreads();
        if (wave == 0) {
            const unsigned ge = gew[lane], gt = gtw[lane], eq = ge & ~gt;
            const int need = 256 - wave_sumi(__popc(gt)), pe = __popc(eq), excl = wave_incl_scan(pe, lane) - pe;
            const int keep = min(max(need - excl, 0), pe);
            unsigned kept = 0u, e = eq;
            for (int i = 0; i < keep; ++i) { const unsigned bb = e & (0u - e); kept |= bb; e ^= bb; }
            mrow[lane] = (gt | kept) & causal_word(lane, s);
        }
        __syncthreads();
    }
}

__device__ __forceinline__ unsigned idx_fixup(unsigned ge, unsigned gt, int lane) {
    const unsigned eq = ge & ~gt;
    const int need = 256 - wave_sumi(__popc(gt)), pe = __popc(eq), excl = wave_incl_scan(pe, lane) - pe;
    const int keep = min(max(need - excl, 0), pe);
    unsigned kept = 0u, e = eq;
    for (int i = 0; i < keep; ++i) { const unsigned bb = e & (0u - e); kept |= bb; e ^= bb; }
    return gt | kept;
}
__device__ __forceinline__ void phase_indexer(Ctx& F) {
    typedef short bf16x8 __attribute__((ext_vector_type(8)));
    typedef float f32x16 __attribute__((ext_vector_type(16)));
    for (int vw = F.bid * NWAVES + F.wave; vw < 2048; vw += F.G * NWAVES) {
        const int vb = vw >> 3, batch = vb & 7, p = (vb >> 3) * 8 + (vw & 7);
#pragma unroll 1
        for (int pass = 0; pass < 2; ++pass) {
            int lane = F.lane; asm volatile("" : "+v"(lane));
            const int r32 = lane & 31, hi = lane >> 5;
            const int gi = ((pass != 0) != (F.wave >= 4)) ? 511 - p : p, s0 = gi * 4; const size_t tok0 = (size_t)batch * SEQ + s0;
            unsigned* mrow = F.MASK + tok0 * 64;
            if (s0 + 3 < 256) {
#pragma unroll
                for (int tk = 0; tk < 4; ++tk) mrow[tk * 64 + lane] = causal_word(lane, s0 + tk);
                continue;
            }
            bf16x8 aq[4];
            { const size_t trow = tok0 + 2 * ((r32 >> 2) & 1) + (r32 >> 4); const int hrow = (r32 & 3) + 4 * ((r32 >> 3) & 1);
              const bf16* qp = F.QI + trow * 512 + hrow * 64 + 8 * hi;
#pragma unroll
              for (int s = 0; s < 4; ++s) aq[s] = *(const bf16x8*)(qp + 16 * s); }
            float w0[8], w1[8];
            { const f32x4* wp = (const f32x4*)(F.WI + (tok0 + 2 * hi) * 8); const f32x4 a = wp[0], b = wp[1], c = wp[2], d = wp[3];
              w0[0] = a[0] * IDX_SCALE; w0[1] = a[1] * IDX_SCALE; w0[2] = a[2] * IDX_SCALE; w0[3] = a[3] * IDX_SCALE; w0[4] = b[0] * IDX_SCALE; w0[5] = b[1] * IDX_SCALE; w0[6] = b[2] * IDX_SCALE; w0[7] = b[3] * IDX_SCALE;
              w1[0] = c[0] * IDX_SCALE; w1[1] = c[1] * IDX_SCALE; w1[2] = c[2] * IDX_SCALE; w1[3] = c[3] * IDX_SCALE; w1[4] = d[0] * IDX_SCALE; w1[5] = d[1] * IDX_SCALE; w1[6] = d[2] * IDX_SCALE; w1[7] = d[3] * IDX_SCALE; }
            const int jmax = (s0 + 3) >> 5;
            const bf16* kp = F.KI + (size_t)batch * SEQ * 64 + lane * 8;
            unsigned ka[64], kb[64];
            bf16x8 bq[2][4];
#pragma unroll
            for (int s = 0; s < 4; ++s) bq[0][s] = *(const bf16x8*)(kp + 512 * s);
#pragma unroll
            for (int j = 0; j < 64; ++j) {
                unsigned k0 = 0u, k1 = 0u;
                if (j <= jmax) {
                    if (j + 1 <= jmax) {
#pragma unroll
                        for (int s = 0; s < 4; ++s) bq[(j + 1) & 1][s] = *(const bf16x8*)(kp + (size_t)(j + 1) * 2048 + 512 * s); }
                    f32x16 acc = {};
#pragma unroll
                    for (int s = 0; s < 4; ++s) acc = __builtin_amdgcn_mfma_f32_32x32x16_bf16(aq[s], bq[j & 1][s], acc, 0, 0, 0);
                    float sc0 = 0.f, sc1 = 0.f;
#pragma unroll
                    for (int h = 0; h < 8; ++h) { sc0 += w0[h] * fmaxf(acc[h], 0.f); sc1 += w1[h] * fmaxf(acc[8 + h], 0.f); }
                    k0 = f2key(sc0); k1 = f2key(sc1);
                    if (j == jmax) { const int kpos = 32 * j + r32; if (kpos > s0 + 2 * hi) k0 = 0u; if (kpos > s0 + 2 * hi + 1) k1 = 0u; }
                }
                asm volatile("" : "+v"(k0), "+v"(k1));
                ka[j] = k0; kb[j] = k1;
            }
            unsigned t0 = 0u, t1 = 0u; int n0 = 2048, n1 = 2048;
#pragma unroll 1
            for (int bit = 31; bit >= 0; --bit) {
                const unsigned c0 = t0 | (1u << bit), c1 = t1 | (1u << bit);
                int a0 = 0, a1 = 0;
#pragma unroll
                for (int j8 = 0; j8 < 64; j8 += 8) if (j8 <= jmax) {
#define IDX_P(KA0, KB0, KA1, KB1) "v_cmp_ge_u32_e64 %2, %" #KA0 ", %22\n\tv_cmp_ge_u32_e64 %3, %" #KB0 ", %23\n\tv_cmp_ge_u32_e64 %4, %" #KA1 ", %22\n\tv_cmp_ge_u32_e64 %5, %" #KB1 ", %23\n\t" \
                      "v_addc_co_u32_e64 %0, %2, 0, %0, %2\n\tv_addc_co_u32_e64 %1, %3, 0, %1, %3\n\tv_addc_co_u32_e64 %0, %4, 0, %0, %4\n\tv_addc_co_u32_e64 %1, %5, 0, %1, %5\n\t"
                    { unsigned long long q0_, q1_, q2_, q3_;
                    asm(IDX_P(6, 14, 7, 15) IDX_P(8, 16, 9, 17) IDX_P(10, 18, 11, 19) IDX_P(12, 20, 13, 21)
                        : "+v"(a0), "+v"(a1), "=&s"(q0_), "=&s"(q1_), "=&s"(q2_), "=&s"(q3_)
                        : "v"(ka[j8]), "v"(ka[j8 + 1]), "v"(ka[j8 + 2]), "v"(ka[j8 + 3]), "v"(ka[j8 + 4]), "v"(ka[j8 + 5]), "v"(ka[j8 + 6]), "v"(ka[j8 + 7]),
                          "v"(kb[j8]), "v"(kb[j8 + 1]), "v"(kb[j8 + 2]), "v"(kb[j8 + 3]), "v"(kb[j8 + 4]), "v"(kb[j8 + 5]), "v"(kb[j8 + 6]), "v"(kb[j8 + 7]), "v"(c0), "v"(c1)); }
#undef IDX_P
                }
                int c = a0 | (a1 << 16);
                c += __builtin_amdgcn_mov_dpp(c, DPP_XOR1, 0xF, 0xF, true); c += __builtin_amdgcn_mov_dpp(c, DPP_XOR2, 0xF, 0xF, true);
                c += __builtin_amdgcn_mov_dpp(c, DPP_ROR(4), 0xF, 0xF, true) + __builtin_amdgcn_mov_dpp(c, DPP_ROR(8), 0xF, 0xF, true) + __builtin_amdgcn_mov_dpp(c, DPP_ROR(12), 0xF, 0xF, true);
                c += __shfl_xor(c, 16);
                const int tot0 = c & 0xffff, tot1 = c >> 16;
                if (tot0 >= 256) { t0 = c0; n0 = tot0; }
                if (tot1 >= 256) { t1 = c1; n1 = tot1; }
                if (__all(n0 == 256 && n1 == 256)) break;
            }
            unsigned* mt = (unsigned*)(F.lds + F.wave * 2048);
#pragma unroll
            for (int j = 0; j < 64; ++j) { const unsigned long long g0 = __ballot(ka[j] >= t0), g1 = __ballot(kb[j] >= t1);
                if (lane == 0) *(v4u*)(mt + 4 * j) = (v4u){(unsigned)g0, (unsigned)g1, (unsigned)(g0 >> 32), (unsigned)(g1 >> 32)};
                __builtin_amdgcn_sched_barrier(0); }
            LDS_WAIT(); asm volatile("" ::: "memory");
            unsigned mA = mt[4 * lane], mB = mt[4 * lane + 1], mC = mt[4 * lane + 2], mD = mt[4 * lane + 3];
            LDS_WAIT(); asm volatile("" ::: "memory");
            if (!__all(n0 == 256 && n1 == 256)) {
#pragma unroll
                for (int j = 0; j < 64; ++j) { const unsigned long long g0 = __ballot(ka[j] > t0), g1 = __ballot(kb[j] > t1);
                    if (lane == 0) *(v4u*)(mt + 4 * j) = (v4u){(unsigned)g0, (unsigned)g1, (unsigned)(g0 >> 32), (unsigned)(g1 >> 32)};
                    __builtin_amdgcn_sched_barrier(0); }
                LDS_WAIT(); asm volatile("" ::: "memory");
                const unsigned gA = mt[4 * lane], gB = mt[4 * lane + 1], gC = mt[4 * lane + 2], gD = mt[4 * lane + 3];
                LDS_WAIT(); asm volatile("" ::: "memory");
                mA = idx_fixup(mA, gA, lane); mB = idx_fixup(mB, gB, lane); mC = idx_fixup(mC, gC, lane); mD = idx_fixup(mD, gD, lane);
            }
            mrow[lane] = mA & causal_word(lane, s0); mrow[64 + lane] = mB & causal_word(lane, s0 + 1);
            mrow[128 + lane] = mC & causal_word(lane, s0 + 2); mrow[192 + lane] = mD & causal_word(lane, s0 + 3);
        }
    }
}

__device__ __forceinline__ void phase_attn_simple(Ctx& F) {
    int* list = (int*)F.lds; int* nselp = list + 256; float* qf = (float*)(F.lds + 2048); float* pbuf = (float*)(F.lds + 8192);
    const int lane = F.lane, h = F.wave;
    for (int t = F.bid; t < T; t += F.G) {
        const int b = t >> 11;
        if (h == 0) { unsigned w = F.MASK[(size_t)t * 64 + lane]; const int pc = __popc(w), incl = wave_incl_scan(pc, lane); int o = incl - pc;
            while (w) { const int bp = __ffs((int)w) - 1; list[o++] = 32 * lane + bp; w &= w - 1u; }
            if (lane == 63) *nselp = incl; }
        { const unsigned qq = *(const unsigned*)(F.Q + (size_t)t * 1024 + h * 128 + 2 * lane); qf[h * 128 + 2 * lane] = bflo(qq) * ATTN_SCALE; qf[h * 128 + 2 * lane + 1] = bfhi(qq) * ATTN_SCALE; }
        __syncthreads();
        const int nsel = *nselp;
        const bf16* Kb = F.K + (size_t)b * SEQ * 256 + (h >> 2) * 128; const bf16* Vb = F.V + (size_t)b * SEQ * 256 + (h >> 2) * 128;
        float sc[4]; float mx = -__builtin_inff();
#pragma unroll 1
        for (int r = 0; r < 4; ++r) { const int idx = lane + 64 * r; sc[r] = -__builtin_inff();
            if (idx < nsel) { const v4u* kr = (const v4u*)(Kb + (size_t)list[idx] * 256); float d = 0.f;
#pragma unroll
                for (int c = 0; c < 16; ++c) { const v4u w = kr[c]; const float* q = qf + h * 128 + 8 * c;
                    d += q[0] * bflo(w.x) + q[1] * bfhi(w.x) + q[2] * bflo(w.y) + q[3] * bfhi(w.y) + q[4] * bflo(w.z) + q[5] * bfhi(w.z) + q[6] * bflo(w.w) + q[7] * bfhi(w.w); }
                sc[r] = d; }
            mx = fmaxf(mx, sc[r]); }
        mx = wave_max(mx);
        float ls = 0.f;
#pragma unroll
        for (int r = 0; r < 4; ++r) { const int idx = lane + 64 * r; const float p = (idx < nsel) ? __expf(sc[r] - mx) : 0.f; pbuf[h * 256 + idx] = p; ls += p; }
        ls = wave_sum(ls);
        __syncthreads();
        float a0 = 0.f, a1 = 0.f;
        for (int i = 0; i < nsel; ++i) { const float p = pbuf[h * 256 + i]; const unsigned vv = *(const unsigned*)(Vb + (size_t)list[i] * 256 + 2 * lane); a0 += p * bflo(vv); a1 += p * bfhi(vv); }
        const float inv = 1.f / ls; const size_t o = (size_t)t * 1024 + h * 128 + 2 * lane;
        const unsigned ya = *(const unsigned*)(F.P1 + o), sg = *(const unsigned*)(F.SGB + o);
        *(unsigned*)(F.XN + o) = pk2(bflo(ya) + bflo(sg) * a0 * inv, bfhi(ya) + bfhi(sg) * a1 * inv);
        __syncthreads();
    }
}

namespace att {
typedef short bf16x8 __attribute__((ext_vector_type(8)));
typedef short s16x4 __attribute__((ext_vector_type(4)));
typedef float f32x16 __attribute__((ext_vector_type(16)));
typedef unsigned u32x4 __attribute__((ext_vector_type(4)));
typedef unsigned u32x2 __attribute__((ext_vector_type(2)));
constexpr int DH = 128, QS = 1024, KVS = 256;
constexpr float SCALE = 0.08838834764831845f, THR = 8.f;
constexpr int NW = 8, QBLK = 32, KVBLK = 64, QB = NW * QBLK;
constexpr int SHM_V = KVBLK * DH * 2, SHM_K = KVBLK * DH * 2;
constexpr int OST_OFF = 2 * SHM_V + 2 * SHM_K + NW * 64 * 4, OST_PITCH = 272, OST_WAVE = 32 * OST_PITCH;
constexpr int LDS_BYTES = OST_OFF + NW * OST_WAVE;
#define KSWZ(row, colB) ((row) * 256 + ((colB) ^ (((row) & 7) << 4)))
#define SBAR() __builtin_amdgcn_sched_barrier(0)
__device__ __forceinline__ int v_st(int k, int c) { const int kk = (k & ~0xC) | ((k & 4) << 1) | ((k & 8) >> 1); return ((kk >> 3) * 4 + (c >> 5)) * 512 + ((kk & 7) * 32 + (c & 31)) * 2; }
__device__ __forceinline__ int v_rd_base(int lane) { return ((lane & 3) << 3) | (((lane >> 2) & 3) << 6) | (((lane >> 4) & 1) << 5) | (((lane >> 5) & 1) << 8); }
constexpr int v_rd_off(int d0, int ks, int half) { return d0 * 512 + ks * 4096 + half * 2048; }
__device__ __forceinline__ int crow(int r, int hi) { return (r & 3) + 8 * (r >> 2) + 4 * hi; }
__device__ __forceinline__ unsigned cvtpk(float lo, float hi) { unsigned r; asm volatile("v_cvt_pk_bf16_f32 %0, %1, %2" : "=v"(r) : "v"(lo), "v"(hi)); return r; }
__device__ __forceinline__ bf16x8 load8(const unsigned short* p) { return *reinterpret_cast<const bf16x8*>(p); }
__device__ __forceinline__ void partialSM(f32x16& p0, f32x16& p1, float& m_reg, float& mn, float& alpha) {
    float pmax = p0[0];
#pragma unroll
    for (int r = 1; r < 16; ++r) pmax = fmaxf(pmax, p0[r]);
#pragma unroll
    for (int r = 0; r < 16; ++r) pmax = fmaxf(pmax, p1[r]);
    { auto rr = __builtin_amdgcn_permlane32_swap(__float_as_uint(pmax), __float_as_uint(pmax), false, false);
      pmax = fmaxf(__uint_as_float(rr[0]), __uint_as_float(rr[1])); }
    constexpr float C2 = 1.4426950408889634f * SCALE;
    if (__builtin_expect(__all((pmax - m_reg) * SCALE <= THR), 1)) { mn = m_reg; alpha = 1.f; }
    else { mn = fmaxf(m_reg, pmax); alpha = __builtin_amdgcn_exp2f((m_reg - mn) * C2); m_reg = mn; }
    const float mnL = -mn * C2;
#pragma unroll
    for (int r = 0; r < 16; ++r) p0[r] = fmaf(p0[r], C2, mnL);
#pragma unroll
    for (int r = 0; r < 16; ++r) p1[r] = fmaf(p1[r], C2, mnL);
#pragma unroll
    for (int r = 0; r < 16; ++r) p0[r] = __builtin_amdgcn_exp2f(p0[r]);
}
__device__ __forceinline__ void finishSM(f32x16& p0, f32x16& p1, u32x2 mw, float alpha, float& l_reg, bf16x8& pa0, bf16x8& pa1, bf16x8& pa2, bf16x8& pa3) {
#pragma unroll
    for (int r = 0; r < 16; ++r) p1[r] = __builtin_amdgcn_exp2f(p1[r]);
#pragma unroll
    for (int r = 0; r < 16; ++r) { const int c = (r & 3) + 8 * (r >> 2);
        float t0, t1;
        asm("v_bfe_i32 %0, %1, %2, 1\n\tv_and_b32 %0, %3, %0" : "=&v"(t0) : "v"(mw.x), "n"(c), "v"(p0[r]));
        asm("v_bfe_i32 %0, %1, %2, 1\n\tv_and_b32 %0, %3, %0" : "=&v"(t1) : "v"(mw.y), "n"(c), "v"(p1[r]));
        p0[r] = t0; p1[r] = t1; }
    float ps = 0;
#pragma unroll
    for (int r = 0; r < 16; ++r) ps += p0[r];
#pragma unroll
    for (int r = 0; r < 16; ++r) ps += p1[r];
    { auto rr = __builtin_amdgcn_permlane32_swap(__float_as_uint(ps), __float_as_uint(ps), false, false);
      ps = __uint_as_float(rr[0]) + __uint_as_float(rr[1]); }
    l_reg = l_reg * alpha + ps;
#define PK4(P, B_, OUT) do { unsigned a0 = cvtpk(P[B_+0], P[B_+1]), a1 = cvtpk(P[B_+2], P[B_+3]);                          \
        unsigned b0 = cvtpk(P[B_+4], P[B_+5]), b1 = cvtpk(P[B_+6], P[B_+7]);                                             \
        auto r0 = __builtin_amdgcn_permlane32_swap(a0, b0, false, false); auto r1 = __builtin_amdgcn_permlane32_swap(a1, b1, false, false); \
        u32x4 w = {r0[0], r1[0], r0[1], r1[1]}; OUT = *reinterpret_cast<bf16x8*>(&w); } while (0)
    PK4(p0, 0, pa0); PK4(p0, 8, pa1); PK4(p1, 0, pa2); PK4(p1, 8, pa3);
#undef PK4
}
template <int KB>
__device__ __forceinline__ void qkt(f32x16& p0, f32x16& p1, const char* K_lds, int r32, int hi, const bf16x8* qr) {
    p0 = f32x16{}; p1 = f32x16{};
    const char* kb[4];
#pragma unroll
    for (int dd = 0; dd < 4; ++dd) kb[dd] = K_lds + KB * SHM_K + KSWZ(r32, (dd * 16 + hi * 8) * 2);
#pragma unroll
    for (int d0 = 0; d0 < 8; ++d0) { const char* a = kb[d0 & 3] + (d0 >> 2) * 128;
        bf16x8 b0 = *reinterpret_cast<const bf16x8*>(a);
        bf16x8 b1 = *reinterpret_cast<const bf16x8*>(a + 32 * 256);
        p0 = __builtin_amdgcn_mfma_f32_32x32x16_bf16(b0, qr[d0], p0, 0, 0, 0);
        p1 = __builtin_amdgcn_mfma_f32_32x32x16_bf16(b1, qr[d0], p1, 0, 0, 0); }
}
template <int VB>
__device__ __forceinline__ void pv_tile(f32x16* o, int vb0, bf16x8 pa0, bf16x8 pa1, bf16x8 pa2, bf16x8 pa3) {
#define TRRD(dst, off) asm volatile("ds_read_b64_tr_b16 %0, %1 offset:%2" : "=&v"(dst) : "v"(vb0), "i"(off) : "memory")
#define PV_D0(d0) do { s16x4 l0, l1, l2, l3, h0, h1, h2, h3; constexpr int b_ = VB * SHM_V + v_rd_off(d0, 0, 0); \
        TRRD(l0, b_); TRRD(h0, b_ + 2048); TRRD(l1, b_ + 4096); TRRD(h1, b_ + 6144); TRRD(l2, b_ + 8192); TRRD(h2, b_ + 10240); TRRD(l3, b_ + 12288); TRRD(h3, b_ + 14336); \
        asm volatile("s_waitcnt lgkmcnt(0)" ::: "memory"); SBAR();   \
        o[d0] = __builtin_amdgcn_mfma_f32_32x32x16_bf16(pa0, (bf16x8){l0[0], l0[1], l0[2], l0[3], h0[0], h0[1], h0[2], h0[3]}, o[d0], 0, 0, 0);   \
        o[d0] = __builtin_amdgcn_mfma_f32_32x32x16_bf16(pa1, (bf16x8){l1[0], l1[1], l1[2], l1[3], h1[0], h1[1], h1[2], h1[3]}, o[d0], 0, 0, 0);   \
        o[d0] = __builtin_amdgcn_mfma_f32_32x32x16_bf16(pa2, (bf16x8){l2[0], l2[1], l2[2], l2[3], h2[0], h2[1], h2[2], h2[3]}, o[d0], 0, 0, 0);   \
        o[d0] = __builtin_amdgcn_mfma_f32_32x32x16_bf16(pa3, (bf16x8){l3[0], l3[1], l3[2], l3[3], h3[0], h3[1], h3[2], h3[3]}, o[d0], 0, 0, 0); } while (0)
    PV_D0(0); PV_D0(1); PV_D0(2); PV_D0(3);
#undef PV_D0
#undef TRRD
}
struct BlockRef { const unsigned short* Q; const unsigned short* K; const unsigned short* V; const unsigned* M; const unsigned short* YA; const unsigned short* SG; unsigned short* OUT; int P0; const float* QG; };
struct Seam { bf16x8 qr[8]; bf16x8 st_v0, st_v1, st_k0, st_k1; };
#define ROWKV(p, k0, rr) ((p) + (size_t)((k0) + (rr)) * KVS + sc)
#define VMW() asm volatile("s_waitcnt vmcnt(0)" ::: "memory")
#define VMWN(n) asm volatile("s_waitcnt vmcnt(%0)" :: "i"(n) : "memory")
#define SLOAD_H(Kp, Vp, k0) do { S.st_v0 = load8(ROWKV(Vp, k0, sr)); S.st_v1 = load8(ROWKV(Vp, k0, 32 + sr)); S.st_k0 = load8(ROWKV(Kp, k0, sr)); S.st_k1 = load8(ROWKV(Kp, k0, 32 + sr)); } while (0)
#define SWRITE_HK(bf) do { *(bf16x8*)(K_lds + (bf) * SHM_K + kws) = S.st_k0; *(bf16x8*)(K_lds + (bf) * SHM_K + kws + 32 * 256) = S.st_k1; } while (0)
#define SWRITE_HV(bf) do { *(bf16x8*)(V_lds + (bf) * SHM_V + vst0) = S.st_v0; *(bf16x8*)(V_lds + (bf) * SHM_V + vst1) = S.st_v1; } while (0)
#define SWRITE_H(bf) do { SWRITE_HV(bf); SWRITE_HK(bf); } while (0)
__device__ __forceinline__ void qnorm(bf16x8 (&qr)[8], const float* qg, float pos, int hi) {
    float ss = 0.f;
#pragma unroll
    for (int d0 = 0; d0 < 8; ++d0) { const u32x4 w = *reinterpret_cast<const u32x4*>(&qr[d0]);
#pragma unroll
        for (int k = 0; k < 4; ++k) { const float lo = __uint_as_float(w[k] << 16), hf = __uint_as_float(w[k] & 0xffff0000u); ss += lo * lo + hf * hf; } }
    { auto rr = __builtin_amdgcn_permlane32_swap(__float_as_uint(ss), __float_as_uint(ss), false, false); ss = __uint_as_float(rr[0]) + __uint_as_float(rr[1]); }
    const float rstd = rsqrtf(ss * (1.f / 128.f) + EPS);
    float x1[8], x2[8];
#pragma unroll
    for (int d0 = 0; d0 < 8; ++d0) { const u32x4 w = *reinterpret_cast<const u32x4*>(&qr[d0]); const f32x4 g0 = *(const f32x4*)(qg + d0 * 16 + hi * 8), g1 = *(const f32x4*)(qg + d0 * 16 + hi * 8 + 4);
        float v[8];
#pragma unroll
        for (int k = 0; k < 4; ++k) { v[2 * k] = __uint_as_float(w[k] << 16); v[2 * k + 1] = __uint_as_float(w[k] & 0xffff0000u); }
#pragma unroll
        for (int j = 0; j < 4; ++j) { v[j] = v[j] * rstd * g0[j]; v[4 + j] = v[4 + j] * rstd * g1[j]; }
        if (d0 == 0) {
#pragma unroll
            for (int j = 0; j < 8; ++j) x1[j] = v[j];
        } else if (d0 == 1) {
#pragma unroll
            for (int j = 0; j < 8; ++j) { x2[j] = v[j]; float c, sn; rope_cs(pos, hi * 8 + j, 1.f / 16.f, c, sn); const float a = x1[j] * c - x2[j] * sn, b = x2[j] * c + x1[j] * sn; x1[j] = a; v[j] = b; }
            u32x4 o0; o0[0] = cvtpk(x1[0], x1[1]); o0[1] = cvtpk(x1[2], x1[3]); o0[2] = cvtpk(x1[4], x1[5]); o0[3] = cvtpk(x1[6], x1[7]); qr[0] = *reinterpret_cast<bf16x8*>(&o0);
        }
        if (d0 >= 1) { u32x4 o; o[0] = cvtpk(v[0], v[1]); o[1] = cvtpk(v[2], v[3]); o[2] = cvtpk(v[4], v[5]); o[3] = cvtpk(v[6], v[7]); qr[d0] = *reinterpret_cast<bf16x8*>(&o); } }
}
__device__ __forceinline__ void prime(const BlockRef& cur, char* lds, Seam& S) {
    const int tid = threadIdx.x, wid = __builtin_amdgcn_readfirstlane(tid >> 6), lane = tid & 63, r32 = lane & 31, hi = lane >> 5;
    const int sr = tid >> 4, sc = (tid & 15) * 8, kws = KSWZ(sr, sc * 2); char* K_lds = lds + 2 * SHM_V;
#pragma unroll
    for (int d0 = 0; d0 < 8; ++d0) S.qr[d0] = load8(cur.Q + (size_t)(wid * QBLK + r32) * QS + d0 * 16 + hi * 8);
    SLOAD_H(cur.K, cur.V, 0); VMW(); SWRITE_HK(0);
    __syncthreads();
}
__device__ __forceinline__ void block(const BlockRef& cur, const BlockRef& nxt, char* lds, Seam& S) {
    const int tid = threadIdx.x, wid = __builtin_amdgcn_readfirstlane(tid >> 6), lane = tid & 63, r32 = lane & 31, hi = lane >> 5;
    const int NT = (cur.P0 + QB) / KVBLK;
    char* V_lds = lds; char* K_lds = lds + 2 * SHM_V;
    float* ws = (float*)(lds + 2 * SHM_V + 2 * SHM_K) + wid * 64; float* li_l = ws, * al_l = ws + 32;
    { int hiq = hi; asm volatile("" : "+v"(hiq));
      qnorm(S.qr, cur.QG, (float)(cur.P0 + wid * QBLK + r32), hiq); }
    float m_reg = -1e30f, l_reg = 0; f32x16 o[4] = {};
    const int sr = tid >> 4, sc = (tid & 15) * 8, vst0 = v_st(sr, sc), vst1 = v_st(32 + sr, sc), kws = KSWZ(sr, sc * 2);
    const int vb0 = (int)(uintptr_t)V_lds + v_rd_base(lane);
    const unsigned short* Kh = cur.K; const unsigned short* Vh = cur.V;
    char* mlds = lds + OST_OFF + wid * OST_WAVE;
    u32x4 mrow_[8];
#pragma unroll
    for (int i = 0; i < 8; ++i) mrow_[i] = *(const u32x4*)(cur.M + (size_t)(wid * QBLK) * 64 + (size_t)(i * 64 + lane) * 4);
#define RESC(a) do { if (__any((a) < 1.f)) { if (hi == 0) al_l[r32] = (a); asm volatile("s_waitcnt lgkmcnt(0)" ::: "memory");              \
                     for (int d_ = 0; d_ < 4; ++d_) for (int r = 0; r < 16; ++r) o[d_][r] *= al_l[crow(r, hi)]; } } while (0)
#define KBASE(t) ((t) * KVBLK)
#define MLOAD(t) ({ u32x2 w_ = *(const u32x2*)(mlds + (lane & 31) * 272 + (t) * 8); w_.x >>= 4 * (lane >> 5); w_.y >>= 4 * (lane >> 5); w_; })
#define SEAM_K0() do { VMWN(8); SWRITE_HK(0); SBAR(); } while (0)
    f32x16 pA0, pA1, pB0, pB1; float mnA, mnB, alA, alB; bf16x8 pa0, pa1, pa2, pa3; u32x2 mw;
    SWRITE_HV(0); SBAR();
    if (NT > 1) { SLOAD_H(Kh, Vh, KBASE(1)); }
    SBAR(); qkt<0>(pA0, pA1, K_lds, r32, hi, S.qr);
    partialSM(pA0, pA1, m_reg, mnA, alA);
    if (NT > 1) { VMW(); SWRITE_H(1); }
#pragma unroll
    for (int i = 0; i < 8; ++i) *(u32x4*)(mlds + (i * 4 + (lane >> 4)) * 272 + (lane & 15) * 16) = mrow_[i];
    __syncthreads();
#define HALF_STEP(PX0, PX1, mnX, alX, PY0, PY1, alY, t, KB, VB, SB) do {                                              \
        mw = MLOAD((t) - 1);                                                                                                  \
        SBAR(); qkt<KB>(PX0, PX1, K_lds, r32, hi, S.qr);                                                                     \
        finishSM(PY0, PY1, mw, alY, l_reg, pa0, pa1, pa2, pa3); SBAR();                                                       \
        if ((t) + 1 < NT) { SLOAD_H(Kh, Vh, KBASE((t) + 1)); SBAR(); }                                                        \
        pv_tile<VB>(o, vb0, pa0, pa1, pa2, pa3); partialSM(PX0, PX1, m_reg, mnX, alX);                                        \
        __syncthreads();                                                                                                      \
        if ((t) + 1 < NT) { VMW(); SWRITE_H(SB); }                                                                            \
        RESC(alX); __syncthreads(); } while (0)
    for (int t = 1; t + 1 < NT; t += 2) {
        HALF_STEP(pB0, pB1, mnB, alB, pA0, pA1, alA, t, 1, 0, 0);
        HALF_STEP(pA0, pA1, mnA, alA, pB0, pB1, alB, t + 1, 0, 1, 1);
    }
    mw = MLOAD(NT - 2);
    SBAR(); qkt<1>(pB0, pB1, K_lds, r32, hi, S.qr); SBAR();
    SLOAD_H(nxt.K, nxt.V, 0); SBAR();
#pragma unroll
    for (int d0 = 0; d0 < 8; ++d0) S.qr[d0] = load8(nxt.Q + (size_t)(wid * QBLK + r32) * QS + d0 * 16 + hi * 8);
    SBAR();
    finishSM(pA0, pA1, mw, alA, l_reg, pa0, pa1, pa2, pa3); SBAR();
    mw = MLOAD(NT - 1);
    pv_tile<0>(o, vb0, pa0, pa1, pa2, pa3);
    partialSM(pB0, pB1, m_reg, mnB, alB); __syncthreads(); RESC(alB);
    finishSM(pB0, pB1, mw, alB, l_reg, pa0, pa1, pa2, pa3); SBAR(); pv_tile<1>(o, vb0, pa0, pa1, pa2, pa3);
    SBAR(); SEAM_K0();
    if (hi == 0) li_l[r32] = l_reg; asm volatile("s_waitcnt lgkmcnt(0)" ::: "memory");
    { int sbo = OST_OFF + wid * OST_WAVE + 4 * hi * OST_PITCH + r32 * 2; asm volatile("" : "+v"(sbo));
      char* sb = lds + sbo; const float* lih = li_l + 4 * hi;
#pragma unroll
      for (int r = 0; r < 16; ++r) { constexpr int dummy = 0; const int ro = (r & 3) + 8 * (r >> 2); const float rl = __builtin_amdgcn_rcpf(lih[ro]);
#pragma unroll
          for (int d0 = 0; d0 < 4; ++d0) { const unsigned pk = cvtpk(o[d0][r] * rl, 0.f); *(unsigned short*)(sb + ro * OST_PITCH + d0 * 64) = (unsigned short)pk; } }
      asm volatile("s_waitcnt lgkmcnt(0)" ::: "memory");
      int rdo = OST_OFF + wid * OST_WAVE + (lane >> 4) * OST_PITCH + (lane & 15) * 16; asm volatile("" : "+v"(rdo));
      unsigned goff = (unsigned)((wid * QBLK + (lane >> 4)) * QS + (lane & 15) * 8) * 2u; asm volatile("" : "+v"(goff));
      u32x4 yav[8], sgv[8];
#pragma unroll
      for (int i = 0; i < 8; ++i) { yav[i] = *(const u32x4*)((const char*)cur.YA + goff + i * 4 * QS * 2); sgv[i] = *(const u32x4*)((const char*)cur.SG + goff + i * 4 * QS * 2); }
      SBAR();
#pragma unroll
      for (int i = 0; i < 8; ++i) {
          const u32x4 ov = *(const u32x4*)(lds + rdo + i * 4 * OST_PITCH);
          const u32x4 ya = yav[i], sg = sgv[i]; u32x4 res;
#define MG(k) res.k = cvtpk(__uint_as_float(ya.k << 16) + __uint_as_float(sg.k << 16) * __uint_as_float(ov.k << 16), __uint_as_float(ya.k & 0xffff0000u) + __uint_as_float(sg.k & 0xffff0000u) * __uint_as_float(ov.k & 0xffff0000u))
          MG(x); MG(y); MG(z); MG(w);
#undef MG
          *(u32x4*)((char*)cur.OUT + goff + i * 4 * QS * 2) = res; } }
    __syncthreads();
#undef RESC
#undef KBASE
#undef MLOAD
#undef SEAM_K0
#undef HALF_STEP
}
#undef ROWKV
#undef VMW
#undef VMWN
#undef SLOAD_H
#undef SWRITE_HK
#undef SWRITE_HV
#undef SWRITE_H
#undef KSWZ
#undef SBAR
}
__device__ __forceinline__ att::BlockRef attn_ref(const Ctx& F, int bh, int qb) {
    const int b = bh >> 3, h = bh & 7; const size_t tok0 = (size_t)b * SEQ + (size_t)qb * 256;
    att::BlockRef r;
    r.Q = F.Q + tok0 * 1024 + h * 128; r.K = F.K + (size_t)b * SEQ * 256 + (h >> 2) * 128; r.V = F.V + (size_t)b * SEQ * 256 + (h >> 2) * 128;
    r.M = F.MASK + tok0 * 64; r.YA = F.P1 + tok0 * 1024 + h * 128; r.SG = F.SGB + tok0 * 1024 + h * 128; r.OUT = F.XN + tok0 * 1024 + h * 128; r.P0 = qb * 256; r.QG = F.qg;
    return r;
}
__device__ __forceinline__ void attn_decode(int l, int& bh, int& q0, int& q1) { const int xcd = l & 7, k = l >> 3, gi = k >> 4, r = k & 15, g = gi * 8 + xcd; bh = (g >> 1) * 8 + (g & 1) * 4 + (r >> 2); q0 = r & 3; q1 = 7 - q0; }
__device__ __forceinline__ void phase_attn(Ctx& F) {
    constexpr int NITEMS = 256;
    att::Seam S;
    int L = F.bid; if (L >= NITEMS) return;
    int bh, q0, q1; attn_decode(L, bh, q0, q1); int pass = 0;
    att::BlockRef cur = attn_ref(F, bh, q0);
    att::prime(cur, (char*)F.lds, S);
    for (;;) {
        const bool more_pass = pass == 0, more_item = L + F.G < NITEMS, last = !more_pass && !more_item;
        int bhn = bh, q0n = q0, q1n = q1, passn = pass + 1, Ln = L;
        if (!more_pass) { passn = 0; Ln = more_item ? L + F.G : L; attn_decode(Ln, bhn, q0n, q1n); }
        const att::BlockRef nxt = last ? cur : attn_ref(F, bhn, passn ? q1n : q0n);
        att::block(cur, nxt, (char*)F.lds, S);
        if (last) break;
        cur = nxt; bh = bhn; q0 = q0n; q1 = q1n; pass = passn; L = Ln;
    }
}

template <int NV, int MODE> __device__ __forceinline__ void top16(float (&v)[NV], int lane, float& outv, int& outi) {
    outv = 0.f; outi = 0;
    for (int r = 0; r < 16; ++r) {
        float m = v[0];
#pragma unroll
        for (int k = 1; k < NV; ++k) m = fmaxf(m, v[k]);
        const float M = wave_max(m);
        int ci = 0x7fffffff;
#pragma unroll
        for (int k = NV - 1; k >= 0; --k) if (v[k] == M) ci = MODE ? NV * lane + k : lane + 64 * k;
        const int I = wave_mini(ci);
#pragma unroll
        for (int k = 0; k < NV; ++k) if ((MODE ? NV * lane + k : lane + 64 * k) == I) v[k] = -__builtin_inff();
        if (lane == r) { outv = M; outi = I; }
    }
}
__device__ __forceinline__ void phase_route_simple(Ctx& F) {
    float* qf = (float*)F.lds; const int lane = F.lane, h = F.wave;
    for (int t = F.bid; t < T; t += F.G) {
        { const v2u qq = *(const v2u*)(F.PQ + (size_t)t * 2048 + h * 256 + 4 * lane); float* q = qf + h * 256 + 4 * lane; q[0] = bflo(qq.x); q[1] = bfhi(qq.x); q[2] = bflo(qq.y); q[3] = bfhi(qq.y); }
        __syncthreads();
        float s1[2], s2[2];
#pragma unroll 1
        for (int hf = 0; hf < 2; ++hf) { const bf16* kb = (hf ? F.K2 : F.K1) + (size_t)h * 128 * 128;
#pragma unroll 1
            for (int r = 0; r < 2; ++r) { const v4u* kr = (const v4u*)(kb + (size_t)(lane + 64 * r) * 128); float d = 0.f;
#pragma unroll
                for (int c = 0; c < 16; ++c) { const v4u w = kr[c]; const float* q = qf + h * 256 + hf * 128 + 8 * c;
                    d += q[0] * bflo(w.x) + q[1] * bfhi(w.x) + q[2] * bflo(w.y) + q[3] * bfhi(w.y) + q[4] * bflo(w.z) + q[5] * bfhi(w.z) + q[6] * bflo(w.w) + q[7] * bfhi(w.w); }
                if (hf) s2[r] = d; else s1[r] = d; } }
        float v1, v2; int i1, i2;
        top16<2, 0>(s1, lane, v1, i1); top16<2, 0>(s2, lane, v2, i2);
        float cand[4]; const float a = __shfl(v1, lane >> 2);
#pragma unroll
        for (int k = 0; k < 4; ++k) cand[k] = a + __shfl(v2, (lane & 3) * 4 + k);
        float ts; int pos; top16<4, 1>(cand, lane, ts, pos);
        const int e1 = __shfl(i1, (pos >> 4) & 15), e2 = __shfl(i2, pos & 15);
        const float m0 = __shfl(ts, 0); const float ex = (lane < 16) ? __expf(ts - m0) : 0.f; const float sum = wave_sum(ex);
        if (lane < 16) { F.EIDX[(size_t)t * 128 + h * 16 + lane] = e1 * 128 + e2; F.GATE[(size_t)t * 128 + h * 16 + lane] = ex / sum; }
        __syncthreads();
    }
}

namespace rt {
typedef short bf16x8 __attribute__((ext_vector_type(8)));
typedef float f32x16 __attribute__((ext_vector_type(16)));
__device__ __forceinline__ unsigned skey(float f) { const unsigned u = __float_as_uint(f); return u ^ ((unsigned)((int)u >> 31) | 0x80000000u); }
__device__ __forceinline__ float unkey(unsigned k) { return __uint_as_float((k & 0x80000000u) ? (k ^ 0x80000000u) : ~k); }
__device__ __forceinline__ void ce(unsigned& a, unsigned& b) { unsigned mx, mn; asm("v_max_f32 %0, %2, %3\n\tv_min_f32 %1, %2, %3" : "=&v"(mx), "=&v"(mn) : "v"(a), "v"(b)); a = mx; b = mn; }
__device__ __forceinline__ unsigned fmaxk(unsigned a, unsigned b) { unsigned r; asm("v_max_f32 %0, %1, %2" : "=v"(r) : "v"(a), "v"(b)); return r; }
template <int N> __device__ __forceinline__ void sort_desc(unsigned* a) {
#pragma unroll
    for (int k = 2; k <= N; k <<= 1)
#pragma unroll
        for (int j = k >> 1; j > 0; j >>= 1)
#pragma unroll
            for (int i = 0; i < N; ++i) { const int l = i ^ j; if (l > i) { if ((i & k) == 0) ce(a[i], a[l]); else ce(a[l], a[i]); } }
}
__device__ __forceinline__ void merge_bitonic16(unsigned* a) {
#pragma unroll
    for (int j = 8; j > 0; j >>= 1)
#pragma unroll
        for (int i = 0; i < 16; ++i) { const int l = i ^ j; if (l > i) ce(a[i], a[l]); }
}
template <bool SORT> __device__ __forceinline__ void top16_merge(unsigned* a, const unsigned* b) {
#pragma unroll
    for (int i = 0; i < 16; ++i) a[i] = fmaxk(a[i], b[15 - i]);
    if (SORT) merge_bitonic16(a);
}
template <bool SORT> __device__ __forceinline__ void pair_merge(unsigned* a) {
    unsigned lo[16], hi[16];
#pragma unroll
    for (int i = 0; i < 16; ++i) { auto rr = __builtin_amdgcn_permlane32_swap(a[i], a[i], false, false); lo[i] = rr[0]; hi[i] = rr[1]; }
    top16_merge<SORT>(lo, hi);
#pragma unroll
    for (int i = 0; i < 16; ++i) a[i] = lo[i];
}
}
__device__ __forceinline__ void phase_route(Ctx& F) {
    const int lane = F.lane, r32 = lane & 31, hi = lane >> 5;
    float* lv = (float*)(F.lds + F.wave * 8192);
    int* li = (int*)(F.lds + F.wave * 8192 + 4096);
    constexpr int KOFF = 65536, KPITCH = 272, KHALF = 128 * KPITCH;
    const bool staged = (F.G & 7) == 0;
    if (staged) { const int head = F.bid & 7;
        for (int c = F.tid; c < 2 * 128 * 16; c += NTHR) { const int hf = c >> 11, row = (c >> 4) & 127, ch = c & 15;
            *(v4u*)(F.lds + KOFF + hf * KHALF + row * KPITCH + ch * 16) = *(const v4u*)((hf ? F.K2 : F.K1) + (size_t)head * 128 * 128 + row * 128 + ch * 8); }
        __syncthreads(); }
    for (int tau = F.bid * NWAVES + F.wave; tau < 4096; tau += F.G * NWAVES) {
        const int head = (tau >> 3) & 7, tg = (tau & 7) | ((tau >> 6) << 3);
        const size_t token = (size_t)tg * 32 + r32;
        const bf16* qb = F.PQ + ((size_t)tg * 8 + head) * (16 * 512) + (32 * hi + r32) * 8;
        rt::bf16x8 bqa[16];
#pragma unroll
        for (int s = 0; s < 16; ++s) bqa[s] = *(const rt::bf16x8*)(qb + 512 * s);
#pragma unroll 1
        for (int half = 0; half < 2; ++half) {
            const bf16* kb = (half ? F.K2 : F.K1) + (size_t)head * 128 * 128 + (size_t)r32 * 128 + 8 * hi;
            const unsigned char* kl = F.lds + KOFF + half * KHALF + r32 * KPITCH + 16 * hi;
            rt::f32x16 acc[4] = {};
#pragma unroll
            for (int s = 0; s < 8; ++s) { const rt::bf16x8 bq = half ? bqa[8 + s] : bqa[s];
#pragma unroll
                for (int tl = 0; tl < 4; ++tl) { const rt::bf16x8 ak = staged ? *(const rt::bf16x8*)(kl + tl * 32 * KPITCH + 32 * s) : *(const rt::bf16x8*)(kb + (size_t)tl * 32 * 128 + 16 * s);
                    acc[tl] = __builtin_amdgcn_mfma_f32_32x32x16_bf16(ak, bq, acc[tl], 0, 0, 0); } }
            unsigned key[64];
#pragma unroll
            for (int tl = 0; tl < 4; ++tl)
#pragma unroll
                for (int r = 0; r < 16; ++r) { const int idx0 = tl * 32 + (r & 3) + 8 * (r >> 2);
                    key[tl * 16 + r] = (__float_as_uint(acc[tl][r]) & ~127u) | (unsigned)(127 - idx0 - 4 * hi); }
            rt::sort_desc<16>(key); rt::sort_desc<16>(key + 16); rt::sort_desc<16>(key + 32); rt::sort_desc<16>(key + 48);
            rt::top16_merge<true>(key, key + 16); rt::top16_merge<true>(key + 32, key + 48); rt::top16_merge<true>(key, key + 32);
            rt::pair_merge<true>(key);
            if (hi == half) {
#pragma unroll
                for (int i = 0; i < 16; ++i) { lv[(r32 * 2 + half) * 16 + i] = __uint_as_float(key[i] & ~127u); li[(r32 * 2 + half) * 16 + i] = 127 - (int)(key[i] & 127u); } }
        }
        LDS_WAIT(); asm volatile("" ::: "memory");
        float A[16], B[16];
        { const float* pa = lv + (r32 * 2 + hi) * 16; const float* pb = lv + (r32 * 2 + (hi ^ 1)) * 16;
#pragma unroll
          for (int i = 0; i < 16; ++i) { A[i] = pa[i]; B[i] = pb[i]; } }
        unsigned ck[32]; int nc = 0;
#pragma unroll
        for (int i = 0; i < 4; ++i)
#pragma unroll
            for (int j = i; j < 16; ++j) if ((i + 1) * (j + 1) <= 16) {
                const unsigned code = hi ? (unsigned)(255 - (j * 16 + i)) : (unsigned)(255 - (i * 16 + j));
                unsigned k = (__float_as_uint(A[i] + B[j]) & ~255u) | code; if (i == j && hi) k = 0xff800000u; ck[nc++] = k; }
#pragma unroll
        for (int i = nc; i < 32; ++i) ck[i] = 0xff800000u;
        rt::sort_desc<16>(ck); rt::sort_desc<16>(ck + 16); rt::top16_merge<true>(ck, ck + 16);
        rt::pair_merge<false>(ck);
        float sv[16]; int ev[16]; float mx = -__builtin_inff();
#pragma unroll
        for (int i = 0; i < 16; ++i) { const int code = 255 - (int)(ck[i] & 255u), r1 = code >> 4, r2 = code & 15;
            sv[i] = lv[(r32 * 2) * 16 + r1] + lv[(r32 * 2 + 1) * 16 + r2]; ev[i] = li[(r32 * 2) * 16 + r1] * 128 + li[(r32 * 2 + 1) * 16 + r2]; mx = fmaxf(mx, sv[i]); }
        float sum = 0.f;
#pragma unroll
        for (int i = 0; i < 16; ++i) { sv[i] = __expf(sv[i] - mx); sum += sv[i]; }
        const float inv = 1.f / sum; const size_t ob = token * 128 + head * 16;
        if (hi == 0) {
#pragma unroll
            for (int i = 0; i < 4; ++i) *(int4*)(F.EIDX + ob + 4 * i) = make_int4(ev[4 * i], ev[4 * i + 1], ev[4 * i + 2], ev[4 * i + 3]);
        } else {
#pragma unroll
            for (int i = 0; i < 4; ++i) *(f32x4*)(F.GATE + ob + 4 * i) = (f32x4){sv[4 * i] * inv, sv[4 * i + 1] * inv, sv[4 * i + 2] * inv, sv[4 * i + 3] * inv};
        }
        LDS_WAIT(); asm volatile("" ::: "memory");
    }
}

__device__ __forceinline__ float gelu_exact(float v) {
    const float av = fabsf(v), t = __builtin_amdgcn_rcpf(av * 0.2316418882f + 1.0f);
    float q = t * 0.5307027145f + (-0.7265760135f); q = q * t + 0.7107068705f; q = q * t + (-0.142248368f); q = q * t + 0.127414796f; q = q * t;
    const float e = __builtin_amdgcn_exp2f((v * v) * (-0.72134752044f)), m = v * (q * e);
    return v < 0.f ? m : v - m;
}
typedef float f32x2v __attribute__((ext_vector_type(2)));
#define DEC16(W_, f) do { f32x2v t_; t_ = __builtin_amdgcn_cvt_pk_f32_fp8((int)(W_).x, false); f[0] = t_.x; f[1] = t_.y; t_ = __builtin_amdgcn_cvt_pk_f32_fp8((int)(W_).x, true); f[2] = t_.x; f[3] = t_.y; \
    t_ = __builtin_amdgcn_cvt_pk_f32_fp8((int)(W_).y, false); f[4] = t_.x; f[5] = t_.y; t_ = __builtin_amdgcn_cvt_pk_f32_fp8((int)(W_).y, true); f[6] = t_.x; f[7] = t_.y; \
    t_ = __builtin_amdgcn_cvt_pk_f32_fp8((int)(W_).z, false); f[8] = t_.x; f[9] = t_.y; t_ = __builtin_amdgcn_cvt_pk_f32_fp8((int)(W_).z, true); f[10] = t_.x; f[11] = t_.y; \
    t_ = __builtin_amdgcn_cvt_pk_f32_fp8((int)(W_).w, false); f[12] = t_.x; f[13] = t_.y; t_ = __builtin_amdgcn_cvt_pk_f32_fp8((int)(W_).w, true); f[14] = t_.x; f[15] = t_.y; } while (0)
__device__ __forceinline__ void ald16(v4u& d, unsigned off, const void* base) { asm volatile("global_load_dwordx4 %0, %1, %2" : "=&v"(d) : "v"(off), "s"(base) : "memory"); }
__device__ __forceinline__ void ald2(unsigned& d, unsigned off, const void* base) { asm volatile("global_load_ushort %0, %1, %2" : "=&v"(d) : "v"(off), "s"(base) : "memory"); }
__device__ __forceinline__ void ald8(v2u& d, unsigned off, const void* base) { asm volatile("global_load_dwordx2 %0, %1, %2" : "=&v"(d) : "v"(off), "s"(base) : "memory"); }
__device__ __forceinline__ void ald4(unsigned& d, unsigned off, const void* base) { asm volatile("global_load_dword %0, %1, %2" : "=&v"(d) : "v"(off), "s"(base) : "memory"); }
#define AWAIT(N) asm volatile("s_waitcnt vmcnt(" #N ")" ::: "memory")
__device__ __forceinline__ unsigned amov(unsigned s) { unsigned d; asm volatile("v_mov_b32 %0, %1" : "=v"(d) : "v"(s)); return d; }
__device__ __forceinline__ v4u amov4(const v4u& s) { v4u d; asm volatile("v_mov_b32 %0, %4\n\tv_mov_b32 %1, %5\n\tv_mov_b32 %2, %6\n\tv_mov_b32 %3, %7" : "=&v"(d.x), "=&v"(d.y), "=&v"(d.z), "=&v"(d.w) : "v"(s.x), "v"(s.y), "v"(s.z), "v"(s.w)); return d; }
__device__ __forceinline__ void adec16(const v4u& w, float (&f)[16]) {
    f32x2v a, b, c, d, e, g, h, i;
    asm volatile("v_cvt_pk_f32_fp8_e32 %0, %8\n\tv_cvt_pk_f32_fp8_sdwa %1, %8 src0_sel:WORD_1\n\tv_cvt_pk_f32_fp8_e32 %2, %9\n\tv_cvt_pk_f32_fp8_sdwa %3, %9 src0_sel:WORD_1\n\t"
                 "v_cvt_pk_f32_fp8_e32 %4, %10\n\tv_cvt_pk_f32_fp8_sdwa %5, %10 src0_sel:WORD_1\n\tv_cvt_pk_f32_fp8_e32 %6, %11\n\tv_cvt_pk_f32_fp8_sdwa %7, %11 src0_sel:WORD_1"
                 : "=&v"(a), "=&v"(b), "=&v"(c), "=&v"(d), "=&v"(e), "=&v"(g), "=&v"(h), "=&v"(i) : "v"(w.x), "v"(w.y), "v"(w.z), "v"(w.w));
    f[0] = a.x; f[1] = a.y; f[2] = b.x; f[3] = b.y; f[4] = c.x; f[5] = c.y; f[6] = d.x; f[7] = d.y; f[8] = e.x; f[9] = e.y; f[10] = g.x; f[11] = g.y; f[12] = h.x; f[13] = h.y; f[14] = i.x; f[15] = i.y;
}
__device__ __forceinline__ void adec16p(const v4u& w, f32x2v (&f)[8]) {
    asm volatile("v_cvt_pk_f32_fp8_e32 %0, %8\n\tv_cvt_pk_f32_fp8_sdwa %1, %8 src0_sel:WORD_1\n\tv_cvt_pk_f32_fp8_e32 %2, %9\n\tv_cvt_pk_f32_fp8_sdwa %3, %9 src0_sel:WORD_1\n\t"
                 "v_cvt_pk_f32_fp8_e32 %4, %10\n\tv_cvt_pk_f32_fp8_sdwa %5, %10 src0_sel:WORD_1\n\tv_cvt_pk_f32_fp8_e32 %6, %11\n\tv_cvt_pk_f32_fp8_sdwa %7, %11 src0_sel:WORD_1"
                 : "=&v"(f[0]), "=&v"(f[1]), "=&v"(f[2]), "=&v"(f[3]), "=&v"(f[4]), "=&v"(f[5]), "=&v"(f[6]), "=&v"(f[7]) : "v"(w.x), "v"(w.y), "v"(w.z), "v"(w.w));
}
#define GROWS(TBL, EV, XW) do { _Pragma("unroll") for (int i = 0; i < 8; ++i) { const unsigned e_ = (unsigned)__shfl((int)(EV), 8 * i + rg); ald16(XW[i], e_ * 128u + toff, TBL); } } while (0)
__device__ __forceinline__ void phase_gather_dots(Ctx& F) {
    typedef int v8i __attribute__((ext_vector_type(8)));
    const int lane = F.lane, c4 = F.cls & 3, par = F.cls >> 2, cw = F.crank * NWAVES + F.wave, ncw = F.cnb * NWAVES;
    const int jj = lane & 15, g = lane >> 4, sub = lane & 7, rg = lane >> 3;
    const unsigned hoff = (unsigned)(256 * c4 + 16 * g) * 2u, toff = (unsigned)c4 * (16384u * 128u) + 16u * (unsigned)sub;
    const void* U4 = F.UB; const void* EI = F.EIDX; const void* HN = HB_OF(F); const void* RS = RSTD_OF(F);
    const unsigned wbase = (unsigned)(size_t)(LAS unsigned char*)F.lds + (unsigned)F.wave * 16384u;
    const unsigned wofs0 = wbase + (unsigned)rg * 128u + 16u * (unsigned)(sub ^ (rg >> 1)), wofs1 = wbase + (unsigned)rg * 128u + 16u * (unsigned)(sub ^ (4 + (rg >> 1)));
    LAS unsigned char* rp0 = (LAS unsigned char*)F.lds + F.wave * 16384 + jj * 128 + 16 * (g ^ (jj >> 1));
    LAS unsigned char* rp1 = (LAS unsigned char*)F.lds + F.wave * 16384 + jj * 128 + 16 * ((4 + g) ^ (jj >> 1));
    if (cw >= T / 2) return;
    int u = cw;
    struct Raw { unsigned e0, e1, rs; v4u h0, h1, h2, h3, h4, h5, h6, h7; };
#define G1_OPS(uu, Q) do { const unsigned tt_ = 2u * (unsigned)(uu) + (unsigned)par, eo_ = (tt_ * 128u + (unsigned)lane) * 4u, ho_ = tt_ * 2048u + hoff; \
        ald4(Q.e0, eo_, EI); ald4(Q.e1, eo_ + 256u, EI); ald4(Q.rs, tt_ * 4u, RS); ald16(Q.h0, ho_, HN); ald16(Q.h1, ho_ + 16u, HN); ald16(Q.h2, ho_ + 128u, HN); ald16(Q.h3, ho_ + 144u, HN); \
        ald16(Q.h4, ho_ + 256u, HN); ald16(Q.h5, ho_ + 272u, HN); ald16(Q.h6, ho_ + 384u, HN); ald16(Q.h7, ho_ + 400u, HN); } while (0)
#define G1_F8(W, R_) ({ int p_ = 0; p_ = __builtin_amdgcn_cvt_pk_fp8_f32(bflo(W.x) * R_, bfhi(W.x) * R_, p_, false); p_ = __builtin_amdgcn_cvt_pk_fp8_f32(bflo(W.y) * R_, bfhi(W.y) * R_, p_, true); p_; })
#define G1_F8B(W, R_) ({ int p_ = 0; p_ = __builtin_amdgcn_cvt_pk_fp8_f32(bflo(W.z) * R_, bfhi(W.z) * R_, p_, false); p_ = __builtin_amdgcn_cvt_pk_fp8_f32(bflo(W.w) * R_, bfhi(W.w) * R_, p_, true); p_; })
#define G1_L2(HQ, H8, B_) do { const v4u w_ = amov4(HQ); H8[B_] = G1_F8(w_, rs_); H8[B_ + 1] = G1_F8B(w_, rs_); } while (0)
#define G1_LAND(Q, E0, E1, H8) do { E0 = amov(Q.e0); E1 = amov(Q.e1); const float rs_ = __uint_as_float(amov(Q.rs)); \
        G1_L2(Q.h0, H8, 0); G1_L2(Q.h1, H8, 2); G1_L2(Q.h2, H8, 4); G1_L2(Q.h3, H8, 6); G1_L2(Q.h4, H8, 8); G1_L2(Q.h5, H8, 10); G1_L2(Q.h6, H8, 12); G1_L2(Q.h7, H8, 14); } while (0)
#define G1_ROWS(EV, XW) do { _Pragma("unroll") for (int i = 0; i < 8; ++i) { const unsigned e_ = (unsigned)__shfl((int)(EV), 8 * i + rg); ald16(XW[i], e_ * 128u + toff, U4); } } while (0)
#define G1_STAGE(XW, HF) do { _Pragma("unroll") for (int i = 0; i < 8; ++i) asm volatile("ds_write_b128 %0, %1 offset:%2" :: "v"((i & 1) ? wofs1 : wofs0), "v"(XW[i]), "i"((HF) * 8192 + i * 1024) : "memory"); } while (0)
#define G1_MMA(HF, H8, D_) do { const v8i ha0_ = {H8[0], H8[1], H8[2], H8[3], H8[4], H8[5], H8[6], H8[7]}, ha1_ = {H8[8], H8[9], H8[10], H8[11], H8[12], H8[13], H8[14], H8[15]}; \
        _Pragma("unroll") for (int m = 0; m < 4; ++m) { const v4u b0_ = *(const LAS v4u*)(rp0 + (HF) * 8192 + m * 2048), b1_ = *(const LAS v4u*)(rp1 + (HF) * 8192 + m * 2048); \
            const v8i ub0_ = {(int)b0_.x, (int)b0_.y, (int)b0_.z, (int)b0_.w, 0, 0, 0, 0}, ub1_ = {(int)b1_.x, (int)b1_.y, (int)b1_.z, (int)b1_.w, 0, 0, 0, 0}; \
            f32x4 c_ = __builtin_amdgcn_mfma_scale_f32_16x16x128_f8f6f4(ha0_, ub0_, (f32x4){0.f, 0.f, 0.f, 0.f}, 0, 4, 0, 0x7F7F7F7F, 0, 0x7F7F7F7F); \
            c_ = __builtin_amdgcn_mfma_scale_f32_16x16x128_f8f6f4(ha1_, ub1_, c_, 0, 4, 0, 0x7F7F7F7F, 0, 0x7F7F7F7F); D_[m] = c_[0]; } } while (0)
    Raw raw; v4u xa[8], xb[8];
    unsigned ea, eb; int h8[16];
    const float mk0 = (g == 0) ? 1.f / U4_SCALE : 0.f, mk1 = (g == 1) ? 1.f / U4_SCALE : 0.f, mk2 = (g == 2) ? 1.f / U4_SCALE : 0.f, mk3 = (g == 3) ? 1.f / U4_SCALE : 0.f;
    G1_OPS(u, raw);
    AWAIT(0);
    G1_LAND(raw, ea, eb, h8);
    G1_ROWS(ea, xa);
    { const int u1 = (u + ncw < T / 2) ? u + ncw : u; G1_OPS(u1, raw); }
    for (;;) {
        const int un = u + ncw; const bool more = un < T / 2;
        float d[4];
        G1_ROWS(eb, xb);
        AWAIT(19);
        G1_STAGE(xa, 0);
        __builtin_amdgcn_sched_barrier(0);
        G1_MMA(0, h8, d);
        float s0 = d[0] * mk0 + d[2] * mk1, s1 = d[1] * mk0 + d[3] * mk1;
        asm volatile("" : "+v"(s0), "+v"(s1));
        __builtin_amdgcn_sched_barrier(0);
        AWAIT(8);
        unsigned nea, neb; int nh8[16];
        G1_LAND(raw, nea, neb, nh8);
        G1_ROWS(nea, xa);
        { const int u2 = (un + ncw < T / 2) ? un + ncw : u; G1_OPS(u2, raw); }
        AWAIT(19);
        G1_STAGE(xb, 1);
        __builtin_amdgcn_sched_barrier(0);
        G1_MMA(1, h8, d);
        s0 += d[0] * mk2 + d[2] * mk3; s1 += d[1] * mk2 + d[3] * mk3;
        { bf16* pd_ = (bf16*)F.PD + ((size_t)(2 * u + par) * 128 + 32 * g + jj) * 4 + c4; pd_[0] = (bf16)f2bf(s0); pd_[64] = (bf16)f2bf(s1); }
        __builtin_amdgcn_sched_barrier(0);
        if (!more) break;
        u = un; eb = neb;
#pragma unroll
        for (int q = 0; q < 16; ++q) h8[q] = nh8[q];
    }
    AWAIT(0);
#undef G1_OPS
#undef G1_F8
#undef G1_F8B
#undef G1_L2
#undef G1_LAND
#undef G1_ROWS
#undef G1_STAGE
#undef G1_MMA
}
__device__ __forceinline__ void phase_gather_axpy(Ctx& F) {
    typedef int v8i __attribute__((ext_vector_type(8)));
    const int lane = F.lane, c4 = F.cls & 3, par = F.cls >> 2, cw = F.crank * NWAVES + F.wave, ncw = F.cnb * NWAVES;
    const int sub = lane & 7, rg = lane >> 3, jj = lane & 15, g = lane >> 4;
    const unsigned toff = (unsigned)c4 * (16384u * 128u) + 16u * (unsigned)sub;
    const void* V4 = F.VB; const void* EI = F.EIDX; const void* GT = F.GATE; const void* PDp = F.PD; const void* OUTp = F.out; const void* H1p = HB_OF(F);
    const unsigned wbase = (unsigned)(size_t)(LAS unsigned char*)F.lds + (unsigned)F.wave * 16384u;
    const unsigned wofs0 = wbase + (unsigned)rg * 128u + 16u * (unsigned)(sub ^ (rg >> 1)), wofs1 = wbase + (unsigned)rg * 128u + 16u * (unsigned)(sub ^ (4 + (rg >> 1)));
    const unsigned wtab = (unsigned)(size_t)(LAS unsigned char*)F.lds + 131072u + (unsigned)F.wave * 128u;
    unsigned rc[8];
#pragma unroll
    for (int c = 0; c < 8; ++c) rc[c] = wbase + (unsigned)(32 * g + jj) * 128u + 16u * (unsigned)(c ^ (jj >> 1));
    const unsigned ocol4 = (unsigned)(256 * c4 + 4 * lane);
    const unsigned xofs = (unsigned)(size_t)(LAS unsigned char*)F.lds + 132096u + (unsigned)F.wave * 1024u;
    const float mk0 = (g == 0) ? 1.f : 0.f, mk1 = (g == 1) ? 1.f : 0.f, mk2 = (g == 2) ? 1.f : 0.f, mk3 = (g == 3) ? 1.f : 0.f;
    if (cw >= T / 2) return;
    int u = cw;
    struct Ops { unsigned e0, e1, g0, g1; v2u p0, p1, o; };
#define G2_OPS(uu, Q) do { const unsigned tt_ = 2u * (unsigned)(uu) + (unsigned)par, eo_ = (tt_ * 128u + (unsigned)lane) * 4u, po_ = (tt_ * 128u + (unsigned)lane) * 8u, oo_ = (tt_ * 1024u + ocol4) * 2u; \
        ald4(Q.e0, eo_, EI); ald4(Q.e1, eo_ + 256u, EI); ald4(Q.g0, eo_, GT); ald4(Q.g1, eo_ + 256u, GT); ald8(Q.p0, po_, PDp); ald8(Q.p1, po_ + 512u, PDp); \
        ald8(Q.o, oo_, H1p); } while (0)
#define G2_LAND(Q, E0, E1, WA, WB, O0, O1, O2, O3) do { E0 = amov(Q.e0); E1 = amov(Q.e1); const unsigned g0_ = amov(Q.g0), g1_ = amov(Q.g1); v2u a_, b_; a_.x = amov(Q.p0.x); a_.y = amov(Q.p0.y); b_.x = amov(Q.p1.x); b_.y = amov(Q.p1.y); \
        { const unsigned ox_ = amov(Q.o.x), oy_ = amov(Q.o.y); O0 = __uint_as_float(ox_ << 16); O1 = __uint_as_float(ox_ & 0xffff0000u); O2 = __uint_as_float(oy_ << 16); O3 = __uint_as_float(oy_ & 0xffff0000u); } WA = G2_W(g0_, a_); WB = G2_W(g1_, b_); } while (0)
#define G2_W(G, P) (__uint_as_float(G) * gelu_exact((bflo(P.x) + bfhi(P.x)) + (bflo(P.y) + bfhi(P.y))) * W8_SCALE)
#define G2_STAGE(XW, HF) do { _Pragma("unroll") for (int i = 0; i < 8; ++i) asm volatile("ds_write_b128 %0, %1 offset:%2" :: "v"((i & 1) ? wofs1 : wofs0), "v"(XW[i]), "i"((HF) * 8192 + i * 1024) : "memory"); } while (0)
#define G2_TR(dst, addr, off) asm volatile("ds_read_b64_tr_b4 %0, %1 offset:%2" : "=&v"(dst) : "v"(addr), "i"(off) : "memory")
    constexpr float W8_SCALE = 64.f;
    Ops raw; v4u xa[8], xb[8];
    unsigned ea, eb; float wa, wb, o0, o1, o2, o3;
    G2_OPS(u, raw);
    AWAIT(0);
    G2_LAND(raw, ea, eb, wa, wb, o0, o1, o2, o3);
    GROWS(V4, ea, xa); GROWS(V4, eb, xb);
    { const int u1 = (u + ncw < T / 2) ? u + ncw : u; G2_OPS(u1, raw); }
    for (;;) {
        const int un = u + ncw; const bool more = un < T / 2;
        AWAIT(15);
        G2_STAGE(xa, 0);
        AWAIT(7);
        G2_STAGE(xb, 1);
        { const unsigned w8 = (unsigned)__builtin_amdgcn_cvt_pk_fp8_f32(wa, wb, 0, false);
          asm volatile("ds_write_b8 %0, %1\n\tds_write_b8_d16_hi %0, %2 offset:64" :: "v"(wtab + (unsigned)lane), "v"(w8), "v"(w8 << 8) : "memory"); }
        LDS_WAIT();
        AWAIT(0);
        unsigned nea, neb; float nwa, nwb, no0, no1, no2, no3;
        G2_LAND(raw, nea, neb, nwa, nwb, no0, no1, no2, no3);
        GROWS(V4, nea, xa); GROWS(V4, neb, xb);
        { const int u2 = (un + ncw < T / 2) ? un + ncw : u; G2_OPS(u2, raw); }
        const v4u wlo = *(const LAS v4u*)((LAS unsigned char*)F.lds + 131072 + F.wave * 128 + 16 * g), whi = *(const LAS v4u*)((LAS unsigned char*)F.lds + 131072 + F.wave * 128 + 64 + 16 * g);
        const v8i wa8 = {(int)wlo.x, (int)wlo.y, (int)wlo.z, (int)wlo.w, (int)whi.x, (int)whi.y, (int)whi.z, (int)whi.w};
        float r0 = 0.f, r1 = 0.f, r2 = 0.f, r3 = 0.f;
#pragma unroll
        for (int gq = 0; gq < 4; ++gq) {
            v2u bl[4], bh[4];
#pragma unroll
            for (int j = 0; j < 4; ++j) { const int m = 4 * gq + j; G2_TR(bl[j], rc[m >> 1], 8 * (m & 1)); G2_TR(bh[j], rc[m >> 1], 8 * (m & 1) + 2048); }
            asm volatile("s_waitcnt lgkmcnt(0)" ::: "memory"); __builtin_amdgcn_sched_barrier(0);
            float d[4];
#pragma unroll
            for (int j = 0; j < 4; ++j) { const v8i vb = {(int)bl[j].x, (int)bl[j].y, (int)bh[j].x, (int)bh[j].y, 0, 0, 0, 0};
                const f32x4 c_ = __builtin_amdgcn_mfma_scale_f32_16x16x128_f8f6f4(wa8, vb, (f32x4){0.f, 0.f, 0.f, 0.f}, 0, 4, 0, 0x7F7F7F7F, 0, 0x7F7F7F7F); d[j] = c_[0]; }
            const float mk = (gq == 0) ? mk0 : (gq == 1) ? mk1 : (gq == 2) ? mk2 : mk3;
            r0 += d[0] * mk; r1 += d[1] * mk; r2 += d[2] * mk; r3 += d[3] * mk;
            asm volatile("" : "+v"(r0), "+v"(r1), "+v"(r2), "+v"(r3));
            __builtin_amdgcn_sched_barrier(0);
        }
        { constexpr float SC = 1.f / (V4_SCALE * W8_SCALE); const unsigned oo_ = ((2u * (unsigned)u + (unsigned)par) * 1024u + ocol4) * 4u;
          LAS float* xw_ = (LAS float*)(size_t)0 + ((xofs >> 2) + 64 * g + jj); xw_[0] = r0; xw_[16] = r1; xw_[32] = r2; xw_[48] = r3;
          const f32x4 rr = *(const LAS f32x4*)((LAS float*)(size_t)0 + ((xofs >> 2) + 4 * lane));
          v4u st; st.x = __float_as_uint(o0 + rr[0] * SC); st.y = __float_as_uint(o1 + rr[1] * SC); st.z = __float_as_uint(o2 + rr[2] * SC); st.w = __float_as_uint(o3 + rr[3] * SC);
          asm volatile("global_store_dwordx4 %0, %1, %2\n\ts_nop 3" :: "v"(oo_), "v"(st), "s"(OUTp) : "memory"); }
        if (!more) break;
        u = un; wa = nwa; wb = nwb; o0 = no0; o1 = no1; o2 = no2; o3 = no3;
    }
    AWAIT(0);
#undef G2_OPS
#undef G2_LAND
#undef G2_W
#undef G2_STAGE
#undef G2_TR
}
#undef GROWS

#define XB_TMO      128
#define XB_XCNT(j)  (256  + 64 * (j))
#define XB_XSUB(j)  (1280 + 64 * (j))
#define XB_XGEN(j)  (2304 + 64 * (j))
#define XB_TOP      3328
#define XB_TOPGEN   3392
#define XCD_BAR_WORDS 3456
#define XB_SPIN_CAP (1u << 18)

__device__ __forceinline__ unsigned xb_ld(unsigned* p)              { return __hip_atomic_load(p, __ATOMIC_RELAXED, __HIP_MEMORY_SCOPE_AGENT); }
__device__ __forceinline__ unsigned xb_add(unsigned* p, unsigned v) { return __hip_atomic_fetch_add(p, v, __ATOMIC_RELAXED, __HIP_MEMORY_SCOPE_AGENT); }
__device__ __forceinline__ unsigned xb_xcc_id() { return (unsigned)__builtin_amdgcn_s_getreg((3 << 11) | 20) & 0xFu; }
#define XB_SPIN(cond, bar) do { unsigned _sp = 0; while (cond) { __builtin_amdgcn_s_sleep(1); \
    if ((++_sp & 255u) == 0u) { if (xb_ld(&(bar)[XB_TMO])) break; if (_sp > XB_SPIN_CAP) { atomicAdd(&(bar)[XB_TMO], 1u); break; } } } } while (0)

struct XcdBarrier {
    unsigned* bar; unsigned x;
    volatile LAS unsigned* st;
};

__device__ __forceinline__ XcdBarrier xcd_barrier_post(unsigned* bar, volatile LAS unsigned* st) {
    XcdBarrier b; b.bar = bar; b.x = xb_xcc_id(); b.st = st;
    if (threadIdx.x == 0) (void)xb_add(&bar[XB_XCNT(b.x)], 1u);
    return b;
}
__device__ __forceinline__ void xcd_barrier_complete(unsigned* bar, unsigned x, unsigned& nloc, unsigned& nx) {
    const unsigned G = gridDim.x * gridDim.y * gridDim.z;
    unsigned sum, cnt, mine, sp = 0u;
    for (;;) {
        sum = 0u; cnt = 0u; mine = 0u;
#pragma unroll
        for (unsigned j = 0; j < 16; ++j) { const unsigned c = xb_ld(&bar[XB_XCNT(j)]); sum += c; cnt += (c > 0u) ? 1u : 0u; mine = (j == x) ? c : mine; }
        if (sum == G) break;
        __builtin_amdgcn_s_sleep(1);
        if ((++sp & 255u) == 0u) { if (xb_ld(&bar[XB_TMO])) break; if (sp > XB_SPIN_CAP) { atomicAdd(&bar[XB_TMO], 1u); break; } }
    }
    nloc = mine > 0u ? mine : 1u; nx = cnt > 0u ? cnt : 1u;
}

__device__ __forceinline__ void xcd_barrier(const XcdBarrier& b) {
    asm volatile("s_waitcnt vmcnt(0)" ::: "memory");
    __syncthreads();
    if (threadIdx.x == 0) {
        unsigned* bar = b.bar;
        __builtin_amdgcn_s_waitcnt(0);
        unsigned nloc = b.st[0], nx = b.st[1];
        if (nloc == 0u) { xcd_barrier_complete(bar, b.x, nloc, nx); b.st[0] = nloc; b.st[1] = nx; }
        const unsigned old = xb_add(&bar[XB_XSUB(b.x)], 1u);
        const unsigned gen = old / nloc;
        if (old + 1u == (gen + 1u) * nloc) {
            __builtin_amdgcn_fence(__ATOMIC_RELEASE, "agent");
            asm volatile("s_waitcnt vmcnt(0)" ::: "memory");
            const unsigned og = xb_add(&bar[XB_TOP], 1u);
            const unsigned tg = og / nx;
            if (og + 1u == (tg + 1u) * nx) xb_add(&bar[XB_TOPGEN], 1u);
            else XB_SPIN(xb_ld(&bar[XB_TOPGEN]) == tg, bar);
            __builtin_amdgcn_fence(__ATOMIC_ACQUIRE, "agent");
            xb_add(&bar[XB_XGEN(b.x)], 1u);
            asm volatile("s_waitcnt vmcnt(0)" ::: "memory");
        } else {
            XB_SPIN(xb_ld(&bar[XB_XGEN(b.x)]) == gen, bar);
            __builtin_amdgcn_fence(__ATOMIC_ACQUIRE, "agent");
            asm volatile("s_waitcnt vmcnt(0)" ::: "memory");
        }
    }
    __syncthreads();
}

constexpr int NPHASE = 11;
__global__ void __launch_bounds__(NTHR, 2) mk_fwd(Args args) {
    extern __shared__ __attribute__((aligned(16))) unsigned char lds[];
    Ctx F;
    F.lds = lds; F.tid = threadIdx.x; F.lane = F.tid & 63; F.wave = __builtin_amdgcn_readfirstlane(F.tid >> 6); F.G = gridDim.x; F.bid = blockIdx.x;
    F.x = args.in[0]; F.g1 = args.in[1]; F.w_in = args.in[2]; F.conv_w = args.in[3]; F.qg = args.in[4]; F.kg = args.in[5]; F.w_o = args.in[6]; F.g2 = args.in[7];
    F.pwq = args.in[8]; F.pk1 = args.in[9]; F.pk2 = args.in[10]; F.pu = args.in[11]; F.pv = args.in[12]; F.out = args.out;
    unsigned char* ws = args.ws;
    F.WIN = (bf16*)(ws + WS_WIN); F.WO = (bf16*)(ws + WS_WO); F.WQ = (bf16*)(ws + WS_WQ); F.K1 = (bf16*)(ws + WS_K1); F.K2 = (bf16*)(ws + WS_K2);
    F.UB = (bf16*)(ws + WS_UB); F.VB = (bf16*)(ws + WS_VB); F.XN = (bf16*)(ws + WS_XN); F.P1 = (bf16*)(ws + WS_P1); F.U = (bf16*)(ws + WS_U);
    F.Q = (bf16*)(ws + WS_Q); F.K = (bf16*)(ws + WS_K); F.V = (bf16*)(ws + WS_V); F.QI = (bf16*)(ws + WS_QI); F.KI = (bf16*)(ws + WS_KI);
    F.SGB = (bf16*)args.out; F.PQ = (bf16*)(ws + WS_PQ); F.WI = (float*)(ws + WS_WI); F.GATE = (float*)(ws + WS_GATE); F.MASK = (unsigned*)(ws + WS_MASK); F.EIDX = (int*)(ws + WS_EIDX); F.PD = (float*)(ws + WS_PQ);
    volatile LAS unsigned* MISC = (volatile LAS unsigned*)((LAS unsigned char*)lds + MISC_OFF);
    if (F.tid < 64) MISC[F.tid] = 0u;
    __syncthreads();
    XcdBarrier xbar = xcd_barrier_post((unsigned*)(ws + WS_CTL) + CW_BAR, MISC + 8);
    if (F.tid == 0) MISC[16] = xb_add((unsigned*)(ws + WS_CTL) + CW_RANK + 64 * xbar.x, 1u);
    F.cls = F.bid & 7; F.crank = F.bid >> 3; F.cnb = (F.G - F.cls + 7) >> 3;
    const int lo = args.ph_lo, hi = args.ph_hi;
    F.late_jobs = (lo == 0 && hi == NPHASE);
#define IN(k) (lo <= (k) && (k) < hi)
#define SEAM(k) do { if (IN(k) && IN((k) + 1)) { if (hi > NPHASE) cg::this_grid().sync();   else xcd_barrier(xbar); } } while (0)
    PG8_LAS unsigned char* lds3 = (PG8_LAS unsigned char*)lds;
    if (IN(0)) { phase_prologue(F); } SEAM(0);
    if (IN(1)) { pg8::Gemm g{F.XN, F.WIN, T, NPROJ, D}; pg8::StaticOrder S; S.init(T, NPROJ, F.G, F.bid);
        pg8::EpiProj E{F.U, F.P1, F.Q, F.K, F.V, F.QI, F.SGB};
        pg8::gemm_phase<pg8::EpiProj, pg8::StaticOrder, true, true>(lds3, g, S, E);
        phase_ki(F); } SEAM(1);
    if (IN(2) && IN(3)) { const int gw_ = F.bid * NWAVES + F.wave, NGW_ = F.G * NWAVES; const size_t gt_ = (size_t)F.bid * NTHR + F.tid, NGT_ = (size_t)F.G * NTHR;
        float* scr_ = (float*)(F.lds + 16384 + F.wave * 8704);
        if (F.wave < 4) { phase_post(F); if (F.late_jobs) { late_weights_job(F, scr_, gw_, NGW_, gt_, NGT_); tables_job(F, gt_, NGT_); } phase_indexer(F); }
        else { phase_indexer(F); phase_post(F); if (F.late_jobs) { late_weights_job(F, scr_, gw_, NGW_, gt_, NGT_); tables_job(F, gt_, NGT_); } } }
    else { if (IN(2)) phase_post(F); if (IN(3)) phase_indexer(F); }
    SEAM(3);
    if (IN(4)) { phase_attn(F); } SEAM(4);
    if (IN(5)) { pg8::Gemm g{F.XN, F.WO, T, D, D}; pg8::StaticOrder S; S.init(T, D, F.G, F.bid);
        pg8::EpiResNorm E{F.x, HB_OF(F), SSQ_OF(F), D};
        pg8::gemm_phase<pg8::EpiResNorm, pg8::StaticOrder, true, true>(lds3, g, S, E); } SEAM(5);
    if (IN(7)) { pg8::Gemm g{HB_OF(F), F.WQ, T, 2048, D}; pg8::StaticOrder S; S.init(T, 2048, F.G, F.bid);
        pg8::Unit u0, u1, u2; const bool h0 = S.next(0, u0), h1 = S.next(1, u1), h2 = S.next(2, u2); const bool use_tab = h0 && !h2;
        PG8_LAS float* rtab = (PG8_LAS float*)(lds3 + 140288);
        if (use_tab) { const int slot = F.tid >> 8, rr = F.tid & 255; const int upm = slot ? u1.pm : u0.pm, upn = slot ? u1.pn : u0.pn;
            if (slot == 0 || h1) { const int row = upm * 256 + rr; const f32x4* sp = (const f32x4*)(SSQ_OF(F) + (size_t)row * 16); const f32x4 s4 = (sp[0] + sp[1]) + (sp[2] + sp[3]);
                const float r = __builtin_amdgcn_rsqf(((s4[0] + s4[1]) + (s4[2] + s4[3])) * (1.f / 1024.f) + 1e-6f); rtab[slot * 256 + rr] = r; if (upn == 0) RSTD_OF(F)[row] = r; }
            __syncthreads(); }
        pg8::EpiBf16Scale E{F.PQ, 2048, SSQ_OF(F), RSTD_OF(F), rtab, u0.pm, u0.pn, use_tab};
        pg8::gemm_phase<pg8::EpiBf16Scale, pg8::StaticOrder, true, true>(lds3, g, S, E); } SEAM(7);
    if (IN(8)) { phase_route(F); } SEAM(8);
    if (IN(9) || IN(10)) {
        unsigned* bw = (unsigned*)(ws + WS_CTL) + CW_BAR; bool ok = (lo == 0);
        for (int j = 0; j < 16; ++j) { const unsigned c = xb_ld(&bw[XB_XCNT(j)]); ok = ok && ((j < 8) ? (c > 0u) : (c == 0u)); }
        if (ok) { F.cls = (int)xbar.x; F.crank = (int)MISC[16]; F.cnb = (int)xb_ld(&bw[XB_XCNT(xbar.x)]); }
    }
    if (IN(9)) { phase_gather_dots(F); } SEAM(9);
    if (IN(10)) { phase_gather_axpy(F); }
#undef IN
#undef SEAM
}

#ifndef MK_ONE_LAUNCH
#define MK_ONE_LAUNCH 1
#endif
extern "C" void kernel_launch(void* const* d_in, const int* in_sizes, int n_in, void* d_out, int out_size, void* d_ws, size_t ws_size, hipStream_t stream) {
    static int grid = 0;
    if (grid == 0) {
        if (n_in != 13 || in_sizes[0] != T * D || out_size != T * D || ws_size < WS_END) { fprintf(stderr, "kernel_launch: unexpected shapes (n_in %d, in0 %d, out %d, ws %zu); nothing launched\n", n_in, n_in > 0 ? in_sizes[0] : -1, out_size, ws_size); grid = -1; return; }
        int dev = 0, cus = 0, per_cu = 0;
        if (hipGetDevice(&dev) != hipSuccess || hipDeviceGetAttribute(&cus, hipDeviceAttributeMultiprocessorCount, dev) != hipSuccess) { fprintf(stderr, "kernel_launch: device query failed\n"); grid = -1; return; }
        if (hipFuncSetAttribute((const void*)mk_fwd, hipFuncAttributeMaxDynamicSharedMemorySize, LDS_BYTES) != hipSuccess) { fprintf(stderr, "kernel_launch: hipFuncSetAttribute failed\n"); grid = -1; return; }
        if (hipOccupancyMaxActiveBlocksPerMultiprocessor(&per_cu, (const void*)mk_fwd, NTHR, LDS_BYTES) != hipSuccess || per_cu < 1) { fprintf(stderr, "kernel_launch: occupancy query says %d blocks per CU\n", per_cu); per_cu = 1; }
        (void)hipGetLastError();
        grid = cus * (per_cu < 1 ? 1 : 1);
    }
    if (grid < 0) return;
    if (hipMemsetAsync((char*)d_ws + WS_CTL, 0, CTL_ZERO_BYTES, stream) != hipSuccess) { fprintf(stderr, "kernel_launch: memset of control words failed\n"); return; }
    Args a{};
    for (int i = 0; i < 13; ++i) a.in[i] = (const float*)d_in[i];
    a.out = (float*)d_out; a.ws = (unsigned char*)d_ws;
#if MK_ONE_LAUNCH
    a.ph_lo = 0; a.ph_hi = NPHASE;
    void* kargs[] = {&a};
    hipError_t e = hipLaunchCooperativeKernel((const void*)mk_fwd, dim3(grid), dim3(NTHR), kargs, LDS_BYTES, stream);
    if (e != hipSuccess) fprintf(stderr, "kernel_launch: cooperative launch failed: %s (grid %d)\n", hipGetErrorString(e), grid);
#else
    for (int p = 0; p < NPHASE; ++p) { a.ph_lo = p; a.ph_hi = p + 1; hipLaunchKernelGGL(mk_fwd, dim3(grid), dim3(NTHR), LDS_BYTES, stream, a); }
#endif
}
```

```cpp
#include <hip/hip_runtime.h>
#include <hip/hip_cooperative_groups.h>
#include <cstdio>
#include <cstdint>
namespace cg = cooperative_groups;

__device__ __forceinline__ int hw_lane() { int l; asm volatile("v_mbcnt_lo_u32_b32 %0, -1, 0\n\tv_mbcnt_hi_u32_b32 %0, -1, %0" : "=v"(l)); return l; }
namespace pg8 {
#define PG8_LAS __attribute__((address_space(3)))
typedef unsigned short bf16_t;
typedef short bf16x8 __attribute__((ext_vector_type(8)));
typedef float f32x4 __attribute__((ext_vector_type(4)));
typedef unsigned u32x4 __attribute__((ext_vector_type(4)));
constexpr int BM = 256, BK = 64, HALF = 128, HTB = HALF * BK * 2  , STAGE_BYTES = 8 * HTB, NXCD = 8, WGM = 8;

__host__ __device__ __forceinline__ int lds_byte(int r, int c) { const int st = (r >> 4) * 2 + (c >> 5), rr = r & 15, cc = c & 31, ob = rr * 64 + cc * 2; return st * 1024 + (ob ^ (((ob >> 9) & 1) << 5)); }
__host__ __device__ __forceinline__ void stage_rc(int b, int& R, int& C) { const int st = b / 1024, sb = b % 1024, swz = sb ^ (((sb >> 9) & 1) << 5); R = (st >> 1) * 16 + swz / 64; C = (st & 1) * 32 + (swz % 64) / 2; }
__host__ __device__ __forceinline__ int perm32(int rho) { const int n = rho >> 4, i = rho & 15; return 8 * (i >> 2) + 4 * n + (i & 3); }

struct Unit { int pm, pn; };
struct Gemm { const bf16_t* A; const bf16_t* Bt; int M, N, K; };

struct StaticOrder {
    int nM, nN, nwg, G, c;
    __host__ __device__ void init(int M, int N, int G_, int c_) { nM = M / BM; nN = N / BM; nwg = nM * nN; G = G_; c = c_; }
    __host__ __device__ __forceinline__ bool next(int i, Unit& u) const {
        const long L = (long)i * G + c; if (L >= nwg) return false;
        int wgid = (int)L; { const int q = nwg / NXCD, r = nwg % NXCD, xcd = wgid % NXCD, off = wgid / NXCD; wgid = (xcd < r ? xcd * (q + 1) : r * (q + 1) + (xcd - r) * q) + off; }
        const int nig = WGM * nN, gid = wgid / nig, fm = gid * WGM, gsz = (nM - fm) < WGM ? (nM - fm) : WGM;
        u.pm = fm + ((wgid % nig) % gsz); u.pn = (wgid % nig) / gsz; return true;
    }
    __device__ __forceinline__ void a_ready(const Unit&) const {}
    __device__ __forceinline__ void done(const Unit&) const {}
};

__device__ __forceinline__ unsigned cvt_pk_bf16(float lo, float hi) { unsigned r; asm volatile("v_cvt_pk_bf16_f32 %0, %1, %2" : "=v"(r) : "v"(lo), "v"(hi)); return r; }
typedef float f32x2 __attribute__((ext_vector_type(2)));
__device__ __forceinline__ float sigm(float x) { return __builtin_amdgcn_rcpf(1.0f + __expf(-x)); }
__device__ __forceinline__ void st8(bf16_t* p, const f32x4& v0, const f32x4& v1) {
    u32x4 w; w.x = cvt_pk_bf16(v0[0], v0[1]); w.y = cvt_pk_bf16(v0[2], v0[3]); w.z = cvt_pk_bf16(v1[0], v1[1]); w.w = cvt_pk_bf16(v1[2], v1[3]); *(u32x4*)p = w; }
__device__ __forceinline__ f32x4 sigm4(const f32x4& v) { return (f32x4){sigm(v[0]), sigm(v[1]), sigm(v[2]), sigm(v[3])}; }
struct EpiProj {
    static constexpr bool PERM = true, AFTER_DRAIN = false;
    bf16_t *U, *P1, *Q, *K, *V, *QI, *SGB;
    __device__ __forceinline__ void operator()(const f32x4 (&acc)[2][2][4][2], const Unit& u, int wr, int wc, int fr, int fq) const {
        const int row0 = u.pm * BM + wr * 64 + fr, pn = u.pn, cw = wc * 32 + 8 * fq;
        if (pn < 16) {
            bf16_t* base = (pn < 8 ? U : P1) + (size_t)(pn & 7) * 128 + cw;
#pragma unroll
            for (int ai = 0; ai < 2; ++ai)
#pragma unroll
                for (int m = 0; m < 4; ++m) {
                    f32x4 a0 = acc[ai][0][m][0], a1 = acc[ai][0][m][1], b0 = acc[ai][1][m][0], b1 = acc[ai][1][m][1];
                    if (pn >= 8) { b0 = sigm4(b0); b1 = sigm4(b1); }
                    st8(base + (size_t)(row0 + ai * HALF + m * 16) * 1024, a0 * b0, a1 * b1); }
        } else if (pn < 22 || (pn >= 24 && pn < 28)) {
            bf16_t* base; int ld; bool sg = false;
            if (pn < 20) { base = Q + (pn - 16) * 256; ld = 1024; }
            else if (pn == 20) { base = K; ld = 256; }
            else if (pn == 21) { base = V; ld = 256; }
            else { base = SGB + (pn - 24) * 256; ld = 1024; sg = true; }
#pragma unroll
            for (int ai = 0; ai < 2; ++ai)
#pragma unroll
                for (int m = 0; m < 4; ++m) { bf16_t* rowp = base + (size_t)(row0 + ai * HALF + m * 16) * ld + cw;
#pragma unroll
                    for (int bj = 0; bj < 2; ++bj) { f32x4 v0 = acc[ai][bj][m][0], v1 = acc[ai][bj][m][1];
                        if (sg) { v0 = sigm4(v0); v1 = sigm4(v1); }
                        st8(rowp + bj * HALF, v0, v1); } }
        } else {
            const bool isx1 = (fq == 0), roped = (((32 * wc + 8 * fq) & 63) < 16);
#pragma unroll
            for (int ai = 0; ai < 2; ++ai)
#pragma unroll
                for (int m = 0; m < 4; ++m) { const int row = row0 + ai * HALF + m * 16; const float pos = (float)(row & 2047);
                    float cs[8], sn[8];
#pragma unroll
                    for (int i = 0; i < 8; ++i) { const float inv = exp2f(-(float)i * (18.931568569324174f / 8.f)), ang = pos * inv; float rev = ang * 0.15915494309189535f; rev -= floorf(rev);
                        sn[i] = __builtin_amdgcn_sinf(rev); cs[i] = __builtin_amdgcn_cosf(rev); }
#pragma unroll
                    for (int bj = 0; bj < 2; ++bj) {
                        f32x4 v0 = acc[ai][bj][m][0], v1 = acc[ai][bj][m][1]; f32x4 o0, o1;
#pragma unroll
                        for (int i = 0; i < 4; ++i) { o0[i] = __shfl_xor(v0[i], 16); o1[i] = __shfl_xor(v1[i], 16); }
                        if (roped) {
#pragma unroll
                            for (int i = 0; i < 4; ++i) { v0[i] = isx1 ? v0[i] * cs[i] - o0[i] * sn[i] : v0[i] * cs[i] + o0[i] * sn[i]; v1[i] = isx1 ? v1[i] * cs[4 + i] - o1[i] * sn[4 + i] : v1[i] * cs[4 + i] + o1[i] * sn[4 + i]; } }
                        st8(QI + (size_t)row * 512 + (pn - 22) * 256 + bj * HALF + cw, v0, v1); } }
        }
    }
};
struct EpiBf16 {
    static constexpr bool PERM = true, AFTER_DRAIN = false;
    bf16_t* O; int ldc;
    __device__ __forceinline__ void operator()(const f32x4 (&acc)[2][2][4][2], const Unit& u, int wr, int wc, int fr, int fq) const {
        const int row0 = u.pm * BM + wr * 64 + fr, col0 = u.pn * BM + wc * 32 + 8 * fq;
#pragma unroll
        for (int ai = 0; ai < 2; ++ai)
#pragma unroll
            for (int m = 0; m < 4; ++m) { bf16_t* rowp = O + (size_t)(row0 + ai * HALF + m * 16) * ldc + col0;
#pragma unroll
                for (int bj = 0; bj < 2; ++bj) st8(rowp + bj * HALF, acc[ai][bj][m][0], acc[ai][bj][m][1]); }
    }
};
struct EpiResF32 {
    static constexpr bool PERM = false, AFTER_DRAIN = false;
    const float* base; float* out; int ldc;
    __device__ __forceinline__ void operator()(const f32x4 (&acc)[2][2][4][2], const Unit& u, int wr, int wc, int fr, int fq) const {
        const int row0 = u.pm * BM + wr * 64 + fr, col0 = u.pn * BM + wc * 32 + 4 * fq;
#pragma unroll
        for (int ai = 0; ai < 2; ++ai)
#pragma unroll
            for (int m = 0; m < 4; ++m) { const size_t off = (size_t)(row0 + ai * HALF + m * 16) * ldc + col0;
#pragma unroll
                for (int bj = 0; bj < 2; ++bj)
#pragma unroll
                    for (int n = 0; n < 2; ++n) { const size_t o = off + bj * HALF + n * 16; *(f32x4*)(out + o) = *(const f32x4*)(base + o) + acc[ai][bj][m][n]; } }
    }
};

__device__ __forceinline__ void epi_ld16(u32x4& d, unsigned off, const void* base) { asm volatile("global_load_dwordx4 %0, %1, %2" : "=&v"(d) : "v"(off), "s"(base) : "memory"); }
__device__ __forceinline__ u32x4 epi_mov4(const u32x4& s) { u32x4 d; asm volatile("v_mov_b32 %0, %4\n\tv_mov_b32 %1, %5\n\tv_mov_b32 %2, %6\n\tv_mov_b32 %3, %7" : "=&v"(d.x), "=&v"(d.y), "=&v"(d.z), "=&v"(d.w) : "v"(s.x), "v"(s.y), "v"(s.z), "v"(s.w)); return d; }
struct EpiResNorm {
    static constexpr bool PERM = false, AFTER_DRAIN = false;
    const float* base; bf16_t* HB; float* SSQ; int ldc;
    __device__ __forceinline__ void operator()(const f32x4 (&acc)[2][2][4][2], const Unit& u, int wr, int wc, int fr, int fq) const {
        const int row0 = u.pm * BM + wr * 64 + fr, col0 = u.pn * BM + wc * 32 + 4 * fq;
        const void* xb = base;
        u32x4 bufA[8], bufB[8];
#define EPI_ISSUE(BUF, G) do { _Pragma("unroll") for (int q_ = 0; q_ < 2; ++q_) { const int rg_ = 2 * (G) + q_, row_ = row0 + (rg_ >> 2) * HALF + (rg_ & 3) * 16; \
            _Pragma("unroll") for (int bj = 0; bj < 2; ++bj) _Pragma("unroll") for (int n = 0; n < 2; ++n) epi_ld16(BUF[q_ * 4 + bj * 2 + n], (unsigned)(row_ * ldc + col0 + bj * HALF + n * 16) * 4u, xb); } } while (0)
#define EPI_PROC(BUF, G) do { _Pragma("unroll") for (int q_ = 0; q_ < 2; ++q_) { const int rg_ = 2 * (G) + q_, ai = rg_ >> 2, m = rg_ & 3, row = row0 + ai * HALF + m * 16; const size_t off = (size_t)row * ldc + col0; float ss = 0.f; \
            _Pragma("unroll") for (int bj = 0; bj < 2; ++bj) _Pragma("unroll") for (int n = 0; n < 2; ++n) { const size_t o = off + bj * HALF + n * 16; const u32x4 xw_ = epi_mov4(BUF[q_ * 4 + bj * 2 + n]); \
                const f32x4 v = __builtin_bit_cast(f32x4, xw_) + acc[ai][bj][m][n]; \
                ss += (v[0] * v[0] + v[1] * v[1]) + (v[2] * v[2] + v[3] * v[3]); \
                f32x2 w; w.x = __builtin_bit_cast(float, cvt_pk_bf16(v[0], v[1])); w.y = __builtin_bit_cast(float, cvt_pk_bf16(v[2], v[3])); *(f32x2*)(HB + o) = w; } \
            ss += __shfl_xor(ss, 16); ss += __shfl_xor(ss, 32); \
            if (fq == 0) SSQ[(size_t)row * 16 + u.pn * 4 + wc] = ss; } } while (0)
#define EPI_WAIT(N) asm volatile("s_waitcnt vmcnt(" #N ")" ::: "memory")
        EPI_ISSUE(bufA, 0); EPI_ISSUE(bufB, 1);
        EPI_WAIT(8); EPI_PROC(bufA, 0); EPI_ISSUE(bufA, 2);
        EPI_WAIT(8); EPI_PROC(bufB, 1); EPI_ISSUE(bufB, 3);
        EPI_WAIT(8); EPI_PROC(bufA, 2);
        EPI_WAIT(0); EPI_PROC(bufB, 3);
#undef EPI_ISSUE
#undef EPI_PROC
#undef EPI_WAIT
    }
};
struct EpiBf16Scale {
    static constexpr bool PERM = true, AFTER_DRAIN = false;
    bf16_t* O; int ldc; const float* SSQ; float* RSTD; const PG8_LAS float* tab; int pm0, pn0; bool use_tab;
    __device__ __forceinline__ void operator()(const f32x4 (&acc)[2][2][4][2], const Unit& u, int wr, int wc, int fr, int fq) const {
        const int row0 = u.pm * BM + wr * 64 + fr, col0 = u.pn * BM + wc * 32 + 8 * fq;
        const PG8_LAS float* tb = tab + ((u.pm == pm0 && u.pn == pn0) ? 0 : 256) + wr * 64 + fr;
#pragma unroll
        for (int ai = 0; ai < 2; ++ai)
#pragma unroll
            for (int m = 0; m < 4; ++m) { const int row = row0 + ai * HALF + m * 16; float r;
                if (use_tab) r = tb[ai * HALF + m * 16];
                else { const f32x4* sp = (const f32x4*)(SSQ + (size_t)row * 16); const f32x4 s4 = (sp[0] + sp[1]) + (sp[2] + sp[3]); r = __builtin_amdgcn_rsqf(((s4[0] + s4[1]) + (s4[2] + s4[3])) * (1.f / 1024.f) + 1e-6f);
                    if (u.pn == 0 && wc == 0 && fq == 0) RSTD[row] = r; }
#pragma unroll
                for (int bj = 0; bj < 2; ++bj) { const int dim = wc * 32 + 8 * fq + bj * HALF;
                    st8(O + (((((size_t)(row >> 5) * 8 + u.pn) * 16 + (dim >> 4)) * 64 + ((dim >> 3) & 1) * 32 + (row & 31)) * 8), acc[ai][bj][m][0] * r, acc[ai][bj][m][1] * r); } }
    }
};

template <class Epi, class Sched, bool ALIGN_EPI = false, bool SP2 = false>
__device__ __forceinline__ void gemm_phase(PG8_LAS unsigned char* lds, const Gemm g, const Sched& S, const Epi& E, const int wid) {
    const int lane = hw_lane(), tid = wid * 64 + lane, wr = wid >> 2, wc = wid & 3, fr = lane & 15, fq = lane >> 4;
    const int K = g.K, nt = K / BK;
    unsigned voffA[2], voffB[2];
#pragma unroll
    for (int i = 0; i < 2; ++i) { int R, C; stage_rc(tid * 16 + i * 8192, R, C); const int Rb = Epi::PERM ? ((R & ~31) + perm32(R & 31)) : R;
        voffA[i] = (unsigned)(R * K + C) * 2u; voffB[i] = (unsigned)(Rb * K + C) * 2u; }
    const size_t kstep = (size_t)(BK * 2);
    const size_t hstep = (size_t)HALF * K * 2;
    const size_t tstep = 2 * hstep;
    const unsigned ldsw = (unsigned)wid * 1024u;
    const int aoff = lds_byte(wr * 64 + fr, fq * 8), boff = lds_byte(wc * 32 + fr, fq * 8);
#define PG8_SA(b, h) (((b) * 2 + (h)) * HTB)
#define PG8_SB(b, h) ((4 + (b) * 2 + (h)) * HTB)
#define PG8_STAGE(bufoff, gbase, voff) do { _Pragma("unroll") for (int _i = 0; _i < 2; ++_i) \
        __builtin_amdgcn_global_load_lds((const unsigned*)((const char*)(gbase) + (voff)[_i]), (PG8_LAS unsigned*)(lds + (bufoff) + ldsw + _i * 8192), 16, 0, 0); } while (0)
#define PG8_LDA(dst, b, h) do { _Pragma("unroll") for (int m = 0; m < 4; ++m) _Pragma("unroll") for (int k = 0; k < 2; ++k) dst[m][k] = *(const PG8_LAS bf16x8*)(lds + PG8_SA(b, h) + aoff + m * 2048 + k * 1024); } while (0)
#define PG8_LDB(dst, b, h) do { _Pragma("unroll") for (int n = 0; n < 2; ++n) _Pragma("unroll") for (int k = 0; k < 2; ++k) dst[n][k] = *(const PG8_LAS bf16x8*)(lds + PG8_SB(b, h) + boff + n * 2048 + k * 1024); } while (0)
#define PG8_MMA(ai, bj, At, Bt) do { __builtin_amdgcn_s_setprio(1); _Pragma("unroll") for (int m = 0; m < 4; ++m) _Pragma("unroll") for (int n = 0; n < 2; ++n) _Pragma("unroll") for (int k = 0; k < 2; ++k) \
        acc[ai][bj][m][n] = __builtin_amdgcn_mfma_f32_16x16x32_bf16(Bt[n][k], At[m][k], acc[ai][bj][m][n], 0, 0, 0); __builtin_amdgcn_s_setprio(0); } while (0)
#define PG8_WAIT_V(n) asm volatile("s_waitcnt vmcnt(" #n ")" ::: "memory")
#define PG8_WAIT_L(n) asm volatile("s_waitcnt lgkmcnt(" #n ")" ::: "memory")
#define PG8_BAR __builtin_amdgcn_s_barrier()
#define PG8_SCHED __builtin_amdgcn_sched_barrier(0)
    Unit cur, nxt; int ui = 0;
    if (!S.next(0, cur)) return;
    f32x4 acc[2][2][4][2];
#pragma unroll
    for (int a = 0; a < 2; ++a)
#pragma unroll
        for (int b = 0; b < 2; ++b)
#pragma unroll
            for (int m = 0; m < 4; ++m)
#pragma unroll
                for (int n = 0; n < 2; ++n) acc[a][b][m][n] = (f32x4){0.f, 0.f, 0.f, 0.f};
    bf16x8 At[4][2], B0[2][2], B1[2][2];
    const char* cA = (const char*)g.A + (size_t)cur.pm * tstep; const char* cB = (const char*)g.Bt + (size_t)cur.pn * tstep;
    S.a_ready(cur);
    if constexpr (SP2) {
        PG8_STAGE(PG8_SB(0, 0), cB, voffB); PG8_STAGE(PG8_SB(0, 1), cB + hstep, voffB); PG8_STAGE(PG8_SA(0, 0), cA, voffA); PG8_STAGE(PG8_SA(0, 1), cA + hstep, voffA);
        if (wr == 1) PG8_BAR;
        PG8_WAIT_V(2); PG8_BAR;
        PG8_STAGE(PG8_SB(1, 0), cB + kstep, voffB); PG8_STAGE(PG8_SA(1, 0), cA + kstep, voffA); PG8_STAGE(PG8_SB(1, 1), cB + hstep + kstep, voffB);
        PG8_WAIT_V(6); PG8_BAR;
    } else {
        PG8_STAGE(PG8_SB(0, 0), cB, voffB); PG8_STAGE(PG8_SA(0, 0), cA, voffA); PG8_STAGE(PG8_SB(0, 1), cB + hstep, voffB); PG8_STAGE(PG8_SA(0, 1), cA + hstep, voffA);
        if (wr == 1) PG8_BAR;
        PG8_WAIT_V(4); PG8_BAR;
        PG8_STAGE(PG8_SB(1, 0), cB + kstep, voffB); PG8_STAGE(PG8_SA(1, 0), cA + kstep, voffA); PG8_STAGE(PG8_SB(1, 1), cB + hstep + kstep, voffB);
        PG8_WAIT_V(6); PG8_BAR;
    }
    for (;;) {
        const bool has_next = S.next(ui + 1, nxt);
        const char* nA = has_next ? (const char*)g.A + (size_t)nxt.pm * tstep : cA; const char* nB = has_next ? (const char*)g.Bt + (size_t)nxt.pn * tstep : cB;
        for (int t = 0; t < nt; t += 2) {
            const bool last = (t == nt - 2);
            const char* a1 = cA + (size_t)(t + 1) * kstep;
            const char* a2 = last ? nA : cA + (size_t)(t + 2) * kstep; const char* b2 = last ? nB : cB + (size_t)(t + 2) * kstep;
            const char* a3 = a2 + kstep; const char* b3 = b2 + kstep;
            if (last && has_next) S.a_ready(nxt);
            if constexpr (SP2) {
            PG8_LDB(B0, 0, 0); PG8_LDB(B1, 0, 1); PG8_SCHED; PG8_LDA(At, 0, 0); PG8_STAGE(PG8_SA(1, 1), a1 + hstep, voffA);
            PG8_WAIT_V(8); PG8_WAIT_L(0); PG8_BAR; PG8_MMA(0, 0, At, B0); PG8_MMA(0, 1, At, B1); PG8_BAR; PG8_SCHED;
            PG8_LDA(At, 0, 1); PG8_STAGE(PG8_SB(0, 0), b2, voffB); PG8_STAGE(PG8_SB(0, 1), b2 + hstep, voffB); PG8_STAGE(PG8_SA(0, 0), a2, voffA);
            PG8_WAIT_V(8); PG8_WAIT_L(0); PG8_BAR; PG8_MMA(1, 0, At, B0); PG8_MMA(1, 1, At, B1); PG8_BAR; PG8_SCHED;
            PG8_LDB(B0, 1, 0); PG8_LDB(B1, 1, 1); PG8_SCHED; PG8_LDA(At, 1, 0); PG8_STAGE(PG8_SA(0, 1), a2 + hstep, voffA);
            PG8_WAIT_V(8); PG8_WAIT_L(0); PG8_BAR; PG8_MMA(0, 0, At, B0); PG8_MMA(0, 1, At, B1); PG8_BAR; PG8_SCHED;
            PG8_LDA(At, 1, 1); PG8_STAGE(PG8_SB(1, 0), b3, voffB); PG8_STAGE(PG8_SB(1, 1), b3 + hstep, voffB); PG8_STAGE(PG8_SA(1, 0), a3, voffA);
            PG8_WAIT_V(8); PG8_WAIT_L(0); PG8_BAR; PG8_MMA(1, 0, At, B0); PG8_MMA(1, 1, At, B1); PG8_BAR; PG8_SCHED;
            } else {
            PG8_LDB(B0, 0, 0); PG8_SCHED; PG8_LDA(At, 0, 0); PG8_STAGE(PG8_SA(1, 1), a1 + hstep, voffA);
            PG8_WAIT_L(8); PG8_BAR; PG8_WAIT_L(0); PG8_MMA(0, 0, At, B0); PG8_BAR; PG8_SCHED;
            PG8_LDB(B1, 0, 1); PG8_STAGE(PG8_SB(0, 0), b2, voffB);
            PG8_BAR; PG8_WAIT_L(0); PG8_MMA(0, 1, At, B1); PG8_BAR;
            PG8_LDA(At, 0, 1); PG8_STAGE(PG8_SA(0, 0), a2, voffA);
            PG8_BAR; PG8_WAIT_L(0); PG8_MMA(1, 0, At, B0); PG8_BAR; PG8_SCHED;
            PG8_STAGE(PG8_SB(0, 1), b2 + hstep, voffB);
            PG8_WAIT_V(6); PG8_BAR; PG8_MMA(1, 1, At, B1); PG8_BAR;
            PG8_LDB(B0, 1, 0); PG8_SCHED; PG8_LDA(At, 1, 0); PG8_STAGE(PG8_SA(0, 1), a2 + hstep, voffA);
            PG8_WAIT_L(8); PG8_BAR; PG8_WAIT_L(0); PG8_MMA(0, 0, At, B0); PG8_BAR; PG8_SCHED;
            PG8_LDB(B1, 1, 1); PG8_STAGE(PG8_SB(1, 0), b3, voffB);
            PG8_BAR; PG8_WAIT_L(0); PG8_MMA(0, 1, At, B1); PG8_BAR;
            PG8_LDA(At, 1, 1); PG8_STAGE(PG8_SA(1, 0), a3, voffA);
            PG8_BAR; PG8_WAIT_L(0); PG8_MMA(1, 0, At, B0); PG8_BAR; PG8_SCHED;
            PG8_STAGE(PG8_SB(1, 1), b3 + hstep, voffB);
            PG8_WAIT_V(6); PG8_BAR; PG8_MMA(1, 1, At, B1); PG8_BAR;
            }
        }
        if constexpr (ALIGN_EPI) { if (wr == 0) PG8_BAR; }
        if constexpr (!Epi::AFTER_DRAIN) { E(acc, cur, wr, wc, fr, fq); S.done(cur); }
        if (!has_next) break;
#pragma unroll
        for (int a = 0; a < 2; ++a)
#pragma unroll
            for (int b = 0; b < 2; ++b)
#pragma unroll
                for (int m = 0; m < 4; ++m)
#pragma unroll
                    for (int n = 0; n < 2; ++n) acc[a][b][m][n] = (f32x4){0.f, 0.f, 0.f, 0.f};
        cur = nxt; cA = nA; cB = nB; ++ui;
        if constexpr (ALIGN_EPI) { if (wr == 1) PG8_BAR; }
    }
    PG8_WAIT_V(0);
    if constexpr (!ALIGN_EPI) { if (wr == 0) PG8_BAR; }
    PG8_BAR;
    if constexpr (Epi::AFTER_DRAIN) { E.fused(acc, cur, wr, wc, fr, fq, lds, wid, lane); S.done(cur); }
#undef PG8_SA
#undef PG8_SB
#undef PG8_STAGE
#undef PG8_LDA
#undef PG8_LDB
#undef PG8_MMA
#undef PG8_WAIT_V
#undef PG8_WAIT_L
#undef PG8_BAR
#undef PG8_SCHED
}
}
constexpr int T = 16384, D = 1024, SEQ = 2048, NBATCH = 8;
constexpr int NPROJ = 7168;
constexpr int NPROJ_T = 7264;
constexpr float EPS = 1e-6f;
constexpr float ATTN_SCALE = 0.08838834764831845f, IDX_SCALE = 0.125f, IDX_W_SCALE = 0.35355339059327373f;
constexpr float LOG2_THETA = 18.931568569324174f;
constexpr int NWAVES = 8, NTHR = 512;

constexpr size_t MiB = 1u << 20;
constexpr size_t WS_CTL = 0, CTL_ZERO_BYTES = 64 * 1024;
constexpr size_t WS_WIN = 1 * MiB;
constexpr size_t WS_WO = 16 * MiB;
constexpr size_t WS_WQ = 18 * MiB;
constexpr size_t WS_K1 = 22 * MiB, WS_K2 = WS_K1 + 256 * 1024;
constexpr size_t WS_UB = 24 * MiB, WS_VB = 56 * MiB;
constexpr size_t WS_XN = 88 * MiB;
constexpr size_t WS_P1 = 120 * MiB;
constexpr size_t WS_U = 152 * MiB;
constexpr size_t WS_Q = 184 * MiB;
constexpr size_t WS_K = 216 * MiB, WS_V = 224 * MiB;
constexpr size_t WS_QI = 232 * MiB;
constexpr size_t WS_KI = 248 * MiB;
constexpr size_t WS_WI = 250 * MiB;
constexpr size_t WS_MASK = 251 * MiB;
constexpr size_t WS_END = 256 * MiB;
constexpr size_t WS_PQ = 120 * MiB;
constexpr size_t WS_EIDX = 184 * MiB, WS_GATE = 192 * MiB;

constexpr int LDS_BYTES = 147456;
constexpr int MISC_OFF = 147456 - 256;
constexpr int CW_RANK = 8192;
constexpr int CW_BAR = 1024;

#define LAS __attribute__((address_space(3)))
typedef unsigned short bf16;
typedef unsigned v4u __attribute__((ext_vector_type(4)));
typedef unsigned v2u __attribute__((ext_vector_type(2)));
typedef float f32x4 __attribute__((ext_vector_type(4)));
typedef __bf16 bf16x2_t __attribute__((ext_vector_type(2)));

__device__ __forceinline__ unsigned f2bf(float f) { unsigned u = __builtin_bit_cast(unsigned, f); return (u + 0x7fffu + ((u >> 16) & 1u)) >> 16; }
__device__ __forceinline__ unsigned pk2(float lo, float hi) { return f2bf(lo) | (f2bf(hi) << 16); }
__device__ __forceinline__ float bflo(unsigned w) { return __builtin_bit_cast(float, w << 16); }
__device__ __forceinline__ float bfhi(unsigned w) { return __builtin_bit_cast(float, w & 0xffff0000u); }
__device__ __forceinline__ float bf1(bf16 h) { return __builtin_bit_cast(float, (unsigned)h << 16); }
__device__ __forceinline__ float dot2bf(unsigned a, unsigned b, float acc) { return __builtin_amdgcn_fdot2_f32_bf16(__builtin_bit_cast(bf16x2_t, a), __builtin_bit_cast(bf16x2_t, b), acc, false); }
#define DPP_XOR1 0xB1
#define DPP_XOR2 0x4E
#define DPP_ROR(n) (0x120 + (n))
__device__ __forceinline__ float wave_sum(float v) {
#pragma unroll
    for (int o = 1; o < 64; o <<= 1) v += __shfl_xor(v, o);
    return v; }
__device__ __forceinline__ float wave_max(float v) {
#pragma unroll
    for (int o = 1; o < 64; o <<= 1) v = fmaxf(v, __shfl_xor(v, o));
    return v; }
__device__ __forceinline__ int wave_sumi(int v) {
#pragma unroll
    for (int o = 1; o < 64; o <<= 1) v += __shfl_xor(v, o);
    return v; }
__device__ __forceinline__ int wave_mini(int v) {
#pragma unroll
    for (int o = 1; o < 64; o <<= 1) v = min(v, __shfl_xor(v, o));
    return v; }
__device__ __forceinline__ int wave_incl_scan(int v, int lane) {
#pragma unroll
    for (int o = 1; o < 64; o <<= 1) { const int x = __shfl_up(v, o); if (lane >= o) v += x; }
    return v; }
#define LDS_WAIT() asm volatile("s_waitcnt lgkmcnt(0)" ::: "memory")

struct Args { const float* in[13]; float* out; unsigned char* ws; int ph_lo, ph_hi; };

struct Ctx {
    unsigned char* lds; int wave, G, bid;
    const float *x, *g1, *w_in, *conv_w, *qg, *kg, *w_o, *g2, *pwq, *pk1, *pk2, *pu, *pv; float* out;
    bf16 *WIN, *WO, *WQ, *K1, *K2, *UB, *VB, *XN, *P1, *U, *Q, *K, *V, *QI, *KI, *SGB, *PQ;
    float *WI, *GATE, *PD; unsigned* MASK; int* EIDX;
    bool late_jobs;
    int cls, crank, cnb;
};

#define HB_OF(F) ((bf16*)((unsigned char*)(F).Q + 16 * MiB))
#define SSQ_OF(F) ((float*)((unsigned char*)(F).MASK + 4 * MiB))
#define RSTD_OF(F) ((float*)((unsigned char*)(F).K1 + 512 * 1024))
__device__ __forceinline__ int win_src_col(int n) {
    if (n < 2048) { const int ch = ((n >> 8) << 7) + (n & 127); return ((n >> 7) & 1) ? 2048 + ch : 1024 + ch; }
    if (n < 4096) { const int m = n - 2048, ch = ((m >> 8) << 7) + (m & 127); return ((m >> 7) & 1) ? 5192 + ch : ch; }
    if (n < 5120) return 3072 + (n - 4096);
    if (n < 5376) return 4096 + (n - 5120);
    if (n < 5632) return 4352 + (n - 5376);
    if (n < 6144) return 4608 + (n - 5632);
    if (n < 7168) return 6216 + (n - 6144);
    if (n < 7232) return 5120 + (n - 7168);
    if (n < 7240) return 5184 + (n - 7232);
    return -1;
}

template <bool MAPPED, bool GAIN = false>
__device__ __forceinline__ void transpose_item(const float* W, int K, int N, bf16* WT, float* scr, int item, int nblk, int lane, const float* gain = nullptr) {
    const int kb = item / nblk, nb = item % nblk, k0 = 64 * kb, n0 = 32 * nb;
    int src = n0 + (lane & 31); if (MAPPED) src = win_src_col(src);
    float tv[32];
#pragma unroll
    for (int i = 0; i < 32; ++i) { const int kk = 2 * i + (lane >> 5); tv[i] = (src >= 0) ? W[(size_t)(k0 + kk) * N + src] : 0.f; }
#pragma unroll
    for (int i = 0; i < 32; ++i) { const int kk = 2 * i + (lane >> 5); scr[kk * 33 + (lane & 31)] = tv[i]; }
    LDS_WAIT(); asm volatile("" ::: "memory");
    const int c = lane & 7;
    f32x4 ga = {1.f, 1.f, 1.f, 1.f}, gb = ga; if (GAIN) { ga = *(const f32x4*)(gain + k0 + 8 * c); gb = *(const f32x4*)(gain + k0 + 8 * c + 4); }
#pragma unroll
    for (int j = 0; j < 4; ++j) { const int n = (lane >> 3) + 8 * j; const float* s = scr + (8 * c) * 33 + n;
        v4u o; o.x = pk2(s[0 * 33] * ga[0], s[1 * 33] * ga[1]); o.y = pk2(s[2 * 33] * ga[2], s[3 * 33] * ga[3]); o.z = pk2(s[4 * 33] * gb[0], s[5 * 33] * gb[1]); o.w = pk2(s[6 * 33] * gb[2], s[7 * 33] * gb[3]);
        size_t wo = (size_t)(n0 + n) * K + k0 + 8 * c;
        if (MAPPED && n0 >= NPROJ) { const int nr = n0 + n - NPROJ, kc = (k0 >> 3) + c;
            wo = (size_t)NPROJ * K + ((((size_t)(nr >> 4) * 32 + (kc >> 2)) * 64 + (kc & 3) * 16 + (nr & 15)) * 8); }
        *(v4u*)(WT + wo) = o; }
    LDS_WAIT(); asm volatile("" ::: "memory");
}
__device__ __forceinline__ void cvt8(const float* src, bf16* dst, size_t i) {
    const f32x4 a = *(const f32x4*)(src + i), b = *(const f32x4*)(src + i + 4);
    v4u o; o.x = pk2(a[0], a[1]); o.y = pk2(a[2], a[3]); o.z = pk2(b[0], b[1]); o.w = pk2(b[2], b[3]); *(v4u*)(dst + i) = o;
}
constexpr float U8_SCALE = 64.f, V8_SCALE = 8.f;
__device__ __forceinline__ size_t tbl8_off(size_t c16) { const size_t e = c16 >> 6, q = c16 & 63; return (q >> 3) * (size_t)(16384 * 128) + e * 128 + (q & 7) * 16; }
__device__ __forceinline__ unsigned pk4_fp8(const f32x4& a, float s) { int p = 0; p = __builtin_amdgcn_cvt_pk_fp8_f32(a[0] * s, a[1] * s, p, false); p = __builtin_amdgcn_cvt_pk_fp8_f32(a[2] * s, a[3] * s, p, true); return (unsigned)p; }
__device__ __forceinline__ void cvt16_fp8(const float* src, unsigned char* dst, size_t i, float s) {
    const f32x4 a = *(const f32x4*)(src + i), b = *(const f32x4*)(src + i + 4), c = *(const f32x4*)(src + i + 8), d = *(const f32x4*)(src + i + 12);
    v4u o; o.x = pk4_fp8(a, s); o.y = pk4_fp8(b, s); o.z = pk4_fp8(c, s); o.w = pk4_fp8(d, s); *(v4u*)(dst + i) = o;
}
__device__ __forceinline__ void rms_row2_to_bf16(const float* xrow0, const float* xrow1, const float* g, bf16* orow0, bf16* orow1, int lane) {
    const f32x4* xa = (const f32x4*)xrow0 + lane; const f32x4* xb = (const f32x4*)xrow1 + lane; f32x4 va[4], vb[4]; float sa = 0.f, sb = 0.f;
#pragma unroll
    for (int j = 0; j < 4; ++j) { va[j] = xa[64 * j]; vb[j] = xb[64 * j]; }
#pragma unroll
    for (int j = 0; j < 4; ++j) { sa += (va[j].x * va[j].x + va[j].y * va[j].y) + (va[j].z * va[j].z + va[j].w * va[j].w); sb += (vb[j].x * vb[j].x + vb[j].y * vb[j].y) + (vb[j].z * vb[j].z + vb[j].w * vb[j].w); }
#pragma unroll
    for (int o = 1; o < 64; o <<= 1) { sa += __shfl_xor(sa, o); sb += __shfl_xor(sb, o); }
    const float ra = rsqrtf(sa * (1.f / 1024.f) + EPS), rb = rsqrtf(sb * (1.f / 1024.f) + EPS);
    v2u* oa = (v2u*)orow0 + lane; v2u* ob = (v2u*)orow1 + lane;
#pragma unroll
    for (int j = 0; j < 4; ++j) { const f32x4 gv = ((const f32x4*)g)[lane + 64 * j]; v2u w;
        w.x = pk2(va[j].x * ra * gv.x, va[j].y * ra * gv.y); w.y = pk2(va[j].z * ra * gv.z, va[j].w * ra * gv.w); oa[64 * j] = w;
        w.x = pk2(vb[j].x * rb * gv.x, vb[j].y * rb * gv.y); w.y = pk2(vb[j].z * rb * gv.z, vb[j].w * rb * gv.w); ob[64 * j] = w; }
}
__device__ __forceinline__ void rms_rows(const float* X, const float* g, bf16* O, int gw, int NGW, int lane) {
    f32x4 gq[4];
#pragma unroll
    for (int q = 0; q < 4; ++q) gq[q] = ((const f32x4*)g)[lane + 64 * q];
    for (int m0 = gw; m0 < T; m0 += 4 * NGW) {
        int mr[4]; f32x4 v[4][4]; float ss[4];
#pragma unroll
        for (int j = 0; j < 4; ++j) { mr[j] = (m0 + j * NGW < T) ? m0 + j * NGW : m0; const f32x4* xr = (const f32x4*)(X + (size_t)mr[j] * D) + lane;
#pragma unroll
            for (int q = 0; q < 4; ++q) v[j][q] = xr[64 * q]; }
#pragma unroll
        for (int j = 0; j < 4; ++j) { float s = 0.f;
#pragma unroll
            for (int q = 0; q < 4; ++q) s += (v[j][q].x * v[j][q].x + v[j][q].y * v[j][q].y) + (v[j][q].z * v[j][q].z + v[j][q].w * v[j][q].w);
            ss[j] = s; }
#pragma unroll
        for (int o = 1; o < 64; o <<= 1) {
#pragma unroll
            for (int j = 0; j < 4; ++j) ss[j] += __shfl_xor(ss[j], o); }
#pragma unroll
        for (int j = 0; j < 4; ++j) { const float r = rsqrtf(ss[j] * (1.f / 1024.f) + EPS); v2u* op = (v2u*)(O + (size_t)mr[j] * D) + lane;
#pragma unroll
            for (int q = 0; q < 4; ++q) { const f32x4 gv = gq[q]; v2u w;
                w.x = pk2(v[j][q].x * r * gv.x, v[j][q].y * r * gv.y); w.y = pk2(v[j][q].z * r * gv.z, v[j][q].w * r * gv.w); op[64 * q] = w; } }
    }
}
__device__ __forceinline__ void rms_row_to_bf16(const float* xrow, const float* g, bf16* orow, int lane) {
    const f32x4* xr = (const f32x4*)xrow + lane; f32x4 v[4]; float s = 0.f;
#pragma unroll
    for (int j = 0; j < 4; ++j) { v[j] = xr[64 * j]; s += (v[j].x * v[j].x + v[j].y * v[j].y) + (v[j].z * v[j].z + v[j].w * v[j].w); }
    const float rstd = rsqrtf(wave_sum(s) * (1.f / 1024.f) + EPS);
    v2u* o8 = (v2u*)orow + lane;
#pragma unroll
    for (int j = 0; j < 4; ++j) { const f32x4 gv = ((const f32x4*)g)[lane + 64 * j]; v2u w; w.x = pk2(v[j].x * rstd * gv.x, v[j].y * rstd * gv.y); w.y = pk2(v[j].z * rstd * gv.z, v[j].w * rstd * gv.w); o8[64 * j] = w; }
}
constexpr float U4_SCALE = 64.f, V4_SCALE = 5.656854249f;
__device__ __forceinline__ size_t tbl4_off(size_t c32) { const size_t e = c32 >> 5, q = c32 & 31; return (q >> 3) * (size_t)(16384 * 128) + e * 128 + (q & 7) * 16; }
__device__ __forceinline__ unsigned pk8_fp4(const f32x4& a, const f32x4& b, float s) { unsigned p = 0;
    p = __builtin_amdgcn_cvt_scalef32_pk_fp4_f32(p, a[0] * s, a[1] * s, 1.0f, 0); p = __builtin_amdgcn_cvt_scalef32_pk_fp4_f32(p, a[2] * s, a[3] * s, 1.0f, 1);
    p = __builtin_amdgcn_cvt_scalef32_pk_fp4_f32(p, b[0] * s, b[1] * s, 1.0f, 2); p = __builtin_amdgcn_cvt_scalef32_pk_fp4_f32(p, b[2] * s, b[3] * s, 1.0f, 3); return p; }
__device__ __forceinline__ void tables_job(Ctx& F, size_t gt, size_t NGT) {
    const int lane = (int)(gt & 63); const size_t wv = gt >> 6, NWV = NGT >> 6;
    constexpr size_t NIT = (size_t)16384 * 4;
    f32x4 gc[4];
#pragma unroll
    for (int c = 0; c < 4; ++c) gc[c] = *(const f32x4*)(F.g2 + c * 256 + lane * 4);
    for (size_t i0 = wv; i0 < NIT; i0 += 8 * NWV) {
        size_t it[8]; f32x4 a[8], b[8];
#pragma unroll
        for (int j = 0; j < 8; ++j) { it[j] = (i0 + j * NWV < NIT) ? i0 + j * NWV : i0; const size_t src = it[j] * 256 + lane * 4;
            a[j] = *(const f32x4*)(F.pu + src); b[j] = *(const f32x4*)(F.pv + src); }
#pragma unroll
        for (int j = 0; j < 8; ++j) { const size_t e = it[j] >> 2, c = it[j] & 3; const size_t dst = c * (size_t)(16384 * 128) + e * 128 + lane * 2;
            const f32x4 gq = (c == 0) ? gc[0] : (c == 1) ? gc[1] : (c == 2) ? gc[2] : gc[3]; const f32x4 au = a[j] * gq;
            unsigned pu4 = 0, pv4 = 0;
            pu4 = __builtin_amdgcn_cvt_scalef32_pk_fp4_f32(pu4, au[0] * U4_SCALE, au[1] * U4_SCALE, 1.0f, 0); pu4 = __builtin_amdgcn_cvt_scalef32_pk_fp4_f32(pu4, au[2] * U4_SCALE, au[3] * U4_SCALE, 1.0f, 1);
            pv4 = __builtin_amdgcn_cvt_scalef32_pk_fp4_f32(pv4, b[j][0] * V4_SCALE, b[j][1] * V4_SCALE, 1.0f, 0); pv4 = __builtin_amdgcn_cvt_scalef32_pk_fp4_f32(pv4, b[j][2] * V4_SCALE, b[j][3] * V4_SCALE, 1.0f, 1);
            *(unsigned short*)((unsigned char*)F.UB + dst) = (unsigned short)pu4; *(unsigned short*)((unsigned char*)F.VB + dst) = (unsigned short)pv4; }
    }
}
__device__ __forceinline__ void late_weights_job(Ctx& F, float* scr, int gw, int NGW, size_t gt, size_t NGT) {
    constexpr int I_O = 16 * 32, I_Q = 16 * 64;
    for (int it = gw; it < I_O + I_Q; it += NGW) {
        if (it < I_O) transpose_item<false>(F.w_o, 1024, 1024, F.WO, scr, it, 32, hw_lane());
        else transpose_item<false, true>(F.pwq, 1024, 2048, F.WQ, scr, it - I_O, 64, hw_lane(), F.g2); }
    for (size_t i = gt; i < (size_t)(8 * 128 * 128) / 8; i += NGT) { cvt8(F.pk1, F.K1, i * 8); cvt8(F.pk2, F.K2, i * 8); }
}
__device__ __forceinline__ void phase_prologue(Ctx& F) {
    float* scr = (float*)(F.lds + F.wave * 16384);
    const int gw = F.bid * NWAVES + F.wave, NGW = F.G * NWAVES;
    constexpr int I_IN = 16 * (NPROJ_T / 32);
    const size_t gt = (size_t)F.bid * NTHR + (F.wave * 64 + hw_lane()), NGT = (size_t)F.G * NTHR;
    for (int st = 0; st < 2; ++st) { const int which = (st + F.wave) & 1;
    if (which == 0) {
    for (int it = gw; it < I_IN; it += NGW) transpose_item<true>(F.w_in, 1024, 7240, F.WIN, scr, it, NPROJ_T / 32, hw_lane());
    } else {
    rms_rows(F.x, F.g1, F.XN, gw, NGW, hw_lane());
    } }
    if (!F.late_jobs) { late_weights_job(F, scr, gw, NGW, gt, NGT); tables_job(F, gt, NGT); }
}

__device__ __forceinline__ void rope_cs(float pos, int i, float inv_half, float& c, float& s) {
    const float inv = exp2f(-(float)i * inv_half * LOG2_THETA), ang = pos * inv;
    float rev = ang * 0.15915494309189535f; rev -= floorf(rev);
    s = __builtin_amdgcn_sinf(rev); c = __builtin_amdgcn_cosf(rev);
}
__device__ __forceinline__ void phase_ki(Ctx& F) {
    typedef short bf16x8 __attribute__((ext_vector_type(8)));
    int lane = hw_lane(); asm volatile("" : "+v"(lane));
    const int w = F.wave, fr = lane & 15, fq = lane >> 4;
    LAS f32x4* red = (LAS f32x4*)F.lds;
    for (int tb = F.bid; tb < T / 64; tb += F.G) {
        const char* Ab = (const char*)F.XN + ((size_t)(tb * 64 + fr) * 1024 + w * 128 + fq * 8) * 2;
        const char* Bb = (const char*)F.WIN + ((size_t)NPROJ * 1024 + ((size_t)(4 * w) * 64 + lane) * 8) * 2;
        bf16x8 a[4][4], b[5][4];
#pragma unroll
        for (int kk = 0; kk < 4; ++kk) {
#pragma unroll
            for (int m = 0; m < 4; ++m) a[m][kk] = *(const bf16x8*)(Ab + m * (16 * 2048) + kk * 64);
#pragma unroll
            for (int n = 0; n < 5; ++n) b[n][kk] = *(const bf16x8*)(Bb + (n * 32 + kk) * 1024); }
        __builtin_amdgcn_sched_barrier(0);
        f32x4 acc[4][5];
#pragma unroll
        for (int m = 0; m < 4; ++m)
#pragma unroll
            for (int n = 0; n < 5; ++n) acc[m][n] = (f32x4){0.f, 0.f, 0.f, 0.f};
#pragma unroll
        for (int kk = 0; kk < 4; ++kk)
#pragma unroll
            for (int m = 0; m < 4; ++m)
#pragma unroll
                for (int n = 0; n < 5; ++n) acc[m][n] = __builtin_amdgcn_mfma_f32_16x16x32_bf16(b[n][kk], a[m][kk], acc[m][n], 0, 0, 0);
        LAS f32x4* mine = red + (w & 3) * (20 * 64) + lane;
        if (w >= 4) {
#pragma unroll
            for (int m = 0; m < 4; ++m)
#pragma unroll
                for (int n = 0; n < 5; ++n) mine[(m * 5 + n) * 64] = acc[m][n]; }
        __syncthreads();
        if (w < 4) {
#pragma unroll
            for (int m = 0; m < 4; ++m)
#pragma unroll
                for (int n = 0; n < 5; ++n) mine[(m * 5 + n) * 64] = acc[m][n] + mine[(m * 5 + n) * 64]; }
        __syncthreads();
        const int mf = w & 3, token = tb * 64 + mf * 16 + fr, nf0 = (w < 4) ? 0 : 3, nfn = (w < 4) ? 3 : 2;
        for (int q = 0; q < nfn; ++q) { const int nf = nf0 + q; LAS f32x4* rp = red + (mf * 5 + nf) * 64 + lane;
            f32x4 v = (rp[0] + rp[20 * 64]) + (rp[40 * 64] + rp[60 * 64]);
            if (nf == 0) { const float pos = (float)(token & 2047);
#pragma unroll
                for (int r = 0; r < 4; ++r) { const float o = __shfl_xor(v[r], 32); float c, s; rope_cs(pos, 4 * (fq & 1) + r, 1.f / 8.f, c, s); v[r] = (fq < 2) ? v[r] * c - o * s : v[r] * c + o * s; } }
            if (nf < 4) { v2u o; o.x = pk2(v[0], v[1]); o.y = pk2(v[2], v[3]);
                *(v2u*)(F.KI + ((((size_t)(token >> 5) * 4 + nf) * 64 + ((fq >> 1) & 1) * 32 + (token & 31)) * 8 + (fq & 1) * 4)) = o; }
            else if (fq < 2) *(f32x4*)(F.WI + (size_t)token * 8 + fq * 4) = v * IDX_W_SCALE; }
        __syncthreads();
    }
}

__device__ __forceinline__ void phase_post(Ctx& F) {
    const int gw = F.bid * NWAVES + F.wave, NGW = F.G * NWAVES, lane = hw_lane();
    const int gt = F.bid * NTHR + (F.wave * 64 + hw_lane()), NGT = F.G * NTHR;
    for (int st = 0; st < 2; ++st) { const int which = (st + F.wave) & 1;
    if (which == 0) {
    { constexpr int NWI = T * 2 / 8; const int sub = lane & 7;
      for (int wi0 = gw; wi0 < NWI; wi0 += 4 * NGW) {
        bf16* p[4]; const float* g[4]; v4u a[4], b[4]; float pos[4];
#pragma unroll
        for (int j = 0; j < 4; ++j) { const int wi = (wi0 + j * NGW < NWI) ? wi0 + j * NGW : wi0; const int unit = wi * 8 + (lane >> 3), t = unit >> 1, hh = unit & 1;
            p[j] = F.K + (size_t)t * 256 + hh * 128 + sub * 16;
            g[j] = F.kg + sub * 16; pos[j] = (float)(t & (SEQ - 1));
            a[j] = *(const v4u*)p[j]; b[j] = *(const v4u*)(p[j] + 8); }
#pragma unroll
        for (int j = 0; j < 4; ++j) {
            float v[16];
            v[0] = bflo(a[j].x); v[1] = bfhi(a[j].x); v[2] = bflo(a[j].y); v[3] = bfhi(a[j].y); v[4] = bflo(a[j].z); v[5] = bfhi(a[j].z); v[6] = bflo(a[j].w); v[7] = bfhi(a[j].w);
            v[8] = bflo(b[j].x); v[9] = bfhi(b[j].x); v[10] = bflo(b[j].y); v[11] = bfhi(b[j].y); v[12] = bflo(b[j].z); v[13] = bfhi(b[j].z); v[14] = bflo(b[j].w); v[15] = bfhi(b[j].w);
            float ss = 0.f;
#pragma unroll
            for (int i = 0; i < 16; ++i) ss += v[i] * v[i];
            ss += __int_as_float(__builtin_amdgcn_mov_dpp(__float_as_int(ss), DPP_XOR1, 0xF, 0xF, true)); ss += __int_as_float(__builtin_amdgcn_mov_dpp(__float_as_int(ss), DPP_XOR2, 0xF, 0xF, true)); ss += __shfl_xor(ss, 4);
            const float rstd = rsqrtf(ss * (1.f / 128.f) + EPS);
#pragma unroll
            for (int i = 0; i < 16; ++i) v[i] = v[i] * rstd * g[j][i];
#pragma unroll
            for (int i = 0; i < 16; ++i) { const float o = __int_as_float(__builtin_amdgcn_mov_dpp(__float_as_int(v[i]), DPP_XOR1, 0xF, 0xF, true)); float c, s; rope_cs(pos[j], i, 1.f / 16.f, c, s);
                if (sub == 0) v[i] = v[i] * c - o * s; else if (sub == 1) v[i] = v[i] * c + o * s; }
            v4u oa, ob;
            oa.x = pk2(v[0], v[1]); oa.y = pk2(v[2], v[3]); oa.z = pk2(v[4], v[5]); oa.w = pk2(v[6], v[7]);
            ob.x = pk2(v[8], v[9]); ob.y = pk2(v[10], v[11]); ob.z = pk2(v[12], v[13]); ob.w = pk2(v[14], v[15]);
            if (j == 0 || wi0 + j * NGW < NWI) { *(v4u*)p[j] = oa; *(v4u*)(p[j] + 8) = ob; }
        }
      } }
    } else {
    } }
}

__device__ __forceinline__ unsigned f2key(float f) { const unsigned u = __builtin_bit_cast(unsigned, f); return (u >> 31) ? ~u : (u | 0x80000000u); }
__device__ __forceinline__ unsigned causal_word(int j, int s) { const int lo = 32 * j; return (lo + 31 <= s) ? 0xffffffffu : (lo > s ? 0u : ((1u << (s - lo + 1)) - 1u)); }
__device__ __forceinline__ void phase_indexer_simple(Ctx& F) {
    float* qf = (float*)F.lds; float* wsc = qf + 512; int* cnts = (int*)(wsc + 8); unsigned* gew = (unsigned*)(cnts + 16); unsigned* gtw = gew + 64;
    const int tid = (F.wave * 64 + hw_lane()), lane = hw_lane(), wave = F.wave;
    for (int t = F.bid; t < T; t += F.G) {
        const int s = t & (SEQ - 1), b = t >> 11;
        unsigned* mrow = F.MASK + (size_t)t * 64;
        if (s < 256) { if (tid < 64) mrow[tid] = causal_word(tid, s); continue; }
        qf[tid] = bf1(F.QI[(size_t)t * 512 + tid]); if (tid < 8) wsc[tid] = F.WI[(size_t)t * 8 + tid] * IDX_SCALE;
        __syncthreads();
        unsigned key[4];
#pragma unroll 1
        for (int j = 0; j < 4; ++j) {
            const int sk = tid + 512 * j; key[j] = 0u;
            if (sk <= s) {
                const v4u* kr = (const v4u*)(F.KI + ((size_t)b * SEQ + sk) * 64);
                float kf[64];
#pragma unroll
                for (int c = 0; c < 8; ++c) { const v4u w = kr[c]; kf[8 * c] = bflo(w.x); kf[8 * c + 1] = bfhi(w.x); kf[8 * c + 2] = bflo(w.y); kf[8 * c + 3] = bfhi(w.y); kf[8 * c + 4] = bflo(w.z); kf[8 * c + 5] = bfhi(w.z); kf[8 * c + 6] = bflo(w.w); kf[8 * c + 7] = bfhi(w.w); }
                float sc = 0.f;
#pragma unroll
                for (int h = 0; h < 8; ++h) { float d = 0.f;
#pragma unroll
                    for (int e = 0; e < 64; ++e) d += qf[h * 64 + e] * kf[e];
                    sc += wsc[h] * fmaxf(d, 0.f); }
                key[j] = f2key(sc);
            }
        }
        unsigned thr = 0u;
        for (int bit = 31; bit >= 0; --bit) {
            const unsigned cand = thr | (1u << bit);
            int c = (key[0] >= cand) + (key[1] >= cand) + (key[2] >= cand) + (key[3] >= cand);
            c = wave_sumi(c);
            if (lane == 0) cnts[(bit & 1) * 8 + wave] = c;
            __syncthreads();
            int tot = 0;
#pragma unroll
            for (int w = 0; w < 8; ++w) tot += cnts[(bit & 1) * 8 + w];
            if (tot >= 256) thr = cand;
        }
#pragma unroll
        for (int j = 0; j < 4; ++j) { const unsigned long long ge = __ballot(key[j] >= thr), gt = __ballot(key[j] > thr);
            if (lane == 0) { const int w = 16 * j + 2 * wave; gew[w] = (unsigned)ge; gew[w + 1] = (unsigned)(ge >> 32); gtw[w] = (unsigned)gt; gtw[w + 1] = (unsigned)(gt >> 32); } }
        __syncthreads();
        if (wave == 0) {
            const unsigned ge = gew[lane], gt = gtw[lane], eq = ge & ~gt;
            const int need = 256 - wave_sumi(__popc(gt)), pe = __popc(eq), excl = wave_incl_scan(pe, lane) - pe;
            const int keep = min(max(need - excl, 0), pe);
            unsigned kept = 0u, e = eq;
            for (int i = 0; i < keep; ++i) { const unsigned bb = e & (0u - e); kept |= bb; e ^= bb; }
            mrow[lane] = (gt | kept) & causal_word(lane, s);
        }
        __syncthreads();
    }
}

__device__ __forceinline__ unsigned idx_fixup(unsigned ge, unsigned gt, int lane) {
    const unsigned eq = ge & ~gt;
    const int need = 256 - wave_sumi(__popc(gt)), pe = __popc(eq), excl = wave_incl_scan(pe, lane) - pe;
    const int keep = min(max(need - excl, 0), pe);
    unsigned kept = 0u, e = eq;
    for (int i = 0; i < keep; ++i) { const unsigned bb = e & (0u - e); kept |= bb; e ^= bb; }
    return gt | kept;
}
__device__ __forceinline__ void phase_indexer(Ctx& F) {
    typedef short bf16x8 __attribute__((ext_vector_type(8)));
    typedef float f32x16 __attribute__((ext_vector_type(16)));
    for (int vw = F.bid * NWAVES + F.wave; vw < 2048; vw += F.G * NWAVES) {
        const int vb = vw >> 3, batch = vb & 7, p = (vb >> 3) * 8 + (vw & 7);
#pragma unroll 1
        for (int pass = 0; pass < 2; ++pass) {
            int lane = hw_lane(); asm volatile("" : "+v"(lane));
            const int r32 = lane & 31, hi = lane >> 5;
            const int gi = ((pass != 0) != (F.wave >= 4)) ? 511 - p : p, s0 = gi * 4; const size_t tok0 = (size_t)batch * SEQ + s0;
            unsigned* mrow = F.MASK + tok0 * 64;
            if (s0 + 3 < 256) {
#pragma unroll
                for (int tk = 0; tk < 4; ++tk) mrow[tk * 64 + lane] = causal_word(lane, s0 + tk);
                continue;
            }
            bf16x8 aq[4];
            { const size_t trow = tok0 + 2 * ((r32 >> 2) & 1) + (r32 >> 4); const int hrow = (r32 & 3) + 4 * ((r32 >> 3) & 1);
              const bf16* qp = F.QI + trow * 512 + hrow * 64 + 8 * hi;
#pragma unroll
              for (int s = 0; s < 4; ++s) aq[s] = *(const bf16x8*)(qp + 16 * s); }
            float w0[8], w1[8];
            { const f32x4* wp = (const f32x4*)(F.WI + (tok0 + 2 * hi) * 8); const f32x4 a = wp[0], b = wp[1], c = wp[2], d = wp[3];
              w0[0] = a[0] * IDX_SCALE; w0[1] = a[1] * IDX_SCALE; w0[2] = a[2] * IDX_SCALE; w0[3] = a[3] * IDX_SCALE; w0[4] = b[0] * IDX_SCALE; w0[5] = b[1] * IDX_SCALE; w0[6] = b[2] * IDX_SCALE; w0[7] = b[3] * IDX_SCALE;
              w1[0] = c[0] * IDX_SCALE; w1[1] = c[1] * IDX_SCALE; w1[2] = c[2] * IDX_SCALE; w1[3] = c[3] * IDX_SCALE; w1[4] = d[0] * IDX_SCALE; w1[5] = d[1] * IDX_SCALE; w1[6] = d[2] * IDX_SCALE; w1[7] = d[3] * IDX_SCALE; }
            const int jmax = (s0 + 3) >> 5;
            const bf16* kp = F.KI + (size_t)batch * SEQ * 64 + lane * 8;
            unsigned ka[64], kb[64];
            bf16x8 bq[2][4];
#pragma unroll
            for (int s = 0; s < 4; ++s) bq[0][s] = *(const bf16x8*)(kp + 512 * s);
#pragma unroll
            for (int j = 0; j < 64; ++j) {
                unsigned k0 = 0u, k1 = 0u;
                if (j <= jmax) {
                    if (j + 1 <= jmax) {
#pragma unroll
                        for (int s = 0; s < 4; ++s) bq[(j + 1) & 1][s] = *(const bf16x8*)(kp + (size_t)(j + 1) * 2048 + 512 * s); }
                    f32x16 acc = {};
#pragma unroll
                    for (int s = 0; s < 4; ++s) acc = __builtin_amdgcn_mfma_f32_32x32x16_bf16(aq[s], bq[j & 1][s], acc, 0, 0, 0);
                    float sc0 = 0.f, sc1 = 0.f;
#pragma unroll
                    for (int h = 0; h < 8; ++h) { sc0 += w0[h] * fmaxf(acc[h], 0.f); sc1 += w1[h] * fmaxf(acc[8 + h], 0.f); }
                    k0 = f2key(sc0); k1 = f2key(sc1);
                    if (j == jmax) { const int kpos = 32 * j + r32; if (kpos > s0 + 2 * hi) k0 = 0u; if (kpos > s0 + 2 * hi + 1) k1 = 0u; }
                }
                asm volatile("" : "+v"(k0), "+v"(k1));
                ka[j] = k0; kb[j] = k1;
            }
            unsigned t0 = 0u, t1 = 0u; int n0 = 2048, n1 = 2048;
#pragma unroll 1
            for (int bit = 31; bit >= 0; --bit) {
                const unsigned c0 = t0 | (1u << bit), c1 = t1 | (1u << bit);
                int a0 = 0, a1 = 0;
#pragma unroll
                for (int j8 = 0; j8 < 64; j8 += 8) if (j8 <= jmax) {
#define IDX_P(KA0, KB0, KA1, KB1) "v_cmp_ge_u32_e64 %2, %" #KA0 ", %22\n\tv_cmp_ge_u32_e64 %3, %" #KB0 ", %23\n\tv_cmp_ge_u32_e64 %4, %" #KA1 ", %22\n\tv_cmp_ge_u32_e64 %5, %" #KB1 ", %23\n\t" \
                      "v_addc_co_u32_e64 %0, %2, 0, %0, %2\n\tv_addc_co_u32_e64 %1, %3, 0, %1, %3\n\tv_addc_co_u32_e64 %0, %4, 0, %0, %4\n\tv_addc_co_u32_e64 %1, %5, 0, %1, %5\n\t"
                    { unsigned long long q0_, q1_, q2_, q3_;
                    asm(IDX_P(6, 14, 7, 15) IDX_P(8, 16, 9, 17) IDX_P(10, 18, 11, 19) IDX_P(12, 20, 13, 21)
                        : "+v"(a0), "+v"(a1), "=&s"(q0_), "=&s"(q1_), "=&s"(q2_), "=&s"(q3_)
                        : "v"(ka[j8]), "v"(ka[j8 + 1]), "v"(ka[j8 + 2]), "v"(ka[j8 + 3]), "v"(ka[j8 + 4]), "v"(ka[j8 + 5]), "v"(ka[j8 + 6]), "v"(ka[j8 + 7]),
                          "v"(kb[j8]), "v"(kb[j8 + 1]), "v"(kb[j8 + 2]), "v"(kb[j8 + 3]), "v"(kb[j8 + 4]), "v"(kb[j8 + 5]), "v"(kb[j8 + 6]), "v"(kb[j8 + 7]), "v"(c0), "v"(c1)); }
#undef IDX_P
                }
                int c = a0 | (a1 << 16);
                c += __builtin_amdgcn_mov_dpp(c, DPP_XOR1, 0xF, 0xF, true); c += __builtin_amdgcn_mov_dpp(c, DPP_XOR2, 0xF, 0xF, true);
                c += __builtin_amdgcn_mov_dpp(c, DPP_ROR(4), 0xF, 0xF, true) + __builtin_amdgcn_mov_dpp(c, DPP_ROR(8), 0xF, 0xF, true) + __builtin_amdgcn_mov_dpp(c, DPP_ROR(12), 0xF, 0xF, true);
                c += __shfl_xor(c, 16);
                const int tot0 = c & 0xffff, tot1 = c >> 16;
                if (tot0 >= 256) { t0 = c0; n0 = tot0; }
                if (tot1 >= 256) { t1 = c1; n1 = tot1; }
                if (__all(n0 == 256 && n1 == 256)) break;
            }
            unsigned* mt = (unsigned*)(F.lds + F.wave * 2048);
#pragma unroll
            for (int j = 0; j < 64; ++j) { const unsigned long long g0 = __ballot(ka[j] >= t0), g1 = __ballot(kb[j] >= t1);
                if (lane == 0) *(v4u*)(mt + 4 * j) = (v4u){(unsigned)g0, (unsigned)g1, (unsigned)(g0 >> 32), (unsigned)(g1 >> 32)};
                __builtin_amdgcn_sched_barrier(0); }
            LDS_WAIT(); asm volatile("" ::: "memory");
            unsigned mA = mt[4 * lane], mB = mt[4 * lane + 1], mC = mt[4 * lane + 2], mD = mt[4 * lane + 3];
            LDS_WAIT(); asm volatile("" ::: "memory");
            if (!__all(n0 == 256 && n1 == 256)) {
#pragma unroll
                for (int j = 0; j < 64; ++j) { const unsigned long long g0 = __ballot(ka[j] > t0), g1 = __ballot(kb[j] > t1);
                    if (lane == 0) *(v4u*)(mt + 4 * j) = (v4u){(unsigned)g0, (unsigned)g1, (unsigned)(g0 >> 32), (unsigned)(g1 >> 32)};
                    __builtin_amdgcn_sched_barrier(0); }
                LDS_WAIT(); asm volatile("" ::: "memory");
                const unsigned gA = mt[4 * lane], gB = mt[4 * lane + 1], gC = mt[4 * lane + 2], gD = mt[4 * lane + 3];
                LDS_WAIT(); asm volatile("" ::: "memory");
                mA = idx_fixup(mA, gA, lane); mB = idx_fixup(mB, gB, lane); mC = idx_fixup(mC, gC, lane); mD = idx_fixup(mD, gD, lane);
            }
            mrow[lane] = mA & causal_word(lane, s0); mrow[64 + lane] = mB & causal_word(lane, s0 + 1);
            mrow[128 + lane] = mC & causal_word(lane, s0 + 2); mrow[192 + lane] = mD & causal_word(lane, s0 + 3);
        }
    }
}

__device__ __forceinline__ void phase_attn_simple(Ctx& F) {
    int* list = (int*)F.lds; int* nselp = list + 256; float* qf = (float*)(F.lds + 2048); float* pbuf = (float*)(F.lds + 8192);
    const int lane = hw_lane(), h = F.wave;
    for (int t = F.bid; t < T; t += F.G) {
        const int b = t >> 11;
        if (h == 0) { unsigned w = F.MASK[(size_t)t * 64 + lane]; const int pc = __popc(w), incl = wave_incl_scan(pc, lane); int o = incl - pc;
            while (w) { const int bp = __ffs((int)w) - 1; list[o++] = 32 * lane + bp; w &= w - 1u; }
            if (lane == 63) *nselp = incl; }
        { const unsigned qq = *(const unsigned*)(F.Q + (size_t)t * 1024 + h * 128 + 2 * lane); qf[h * 128 + 2 * lane] = bflo(qq) * ATTN_SCALE; qf[h * 128 + 2 * lane + 1] = bfhi(qq) * ATTN_SCALE; }
        __syncthreads();
        const int nsel = *nselp;
        const bf16* Kb = F.K + (size_t)b * SEQ * 256 + (h >> 2) * 128; const bf16* Vb = F.V + (size_t)b * SEQ * 256 + (h >> 2) * 128;
        float sc[4]; float mx = -__builtin_inff();
#pragma unroll 1
        for (int r = 0; r < 4; ++r) { const int idx = lane + 64 * r; sc[r] = -__builtin_inff();
            if (idx < nsel) { const v4u* kr = (const v4u*)(Kb + (size_t)list[idx] * 256); float d = 0.f;
#pragma unroll
                for (int c = 0; c < 16; ++c) { const v4u w = kr[c]; const float* q = qf + h * 128 + 8 * c;
                    d += q[0] * bflo(w.x) + q[1] * bfhi(w.x) + q[2] * bflo(w.y) + q[3] * bfhi(w.y) + q[4] * bflo(w.z) + q[5] * bfhi(w.z) + q[6] * bflo(w.w) + q[7] * bfhi(w.w); }
                sc[r] = d; }
            mx = fmaxf(mx, sc[r]); }
        mx = wave_max(mx);
        float ls = 0.f;
#pragma unroll
        for (int r = 0; r < 4; ++r) { const int idx = lane + 64 * r; const float p = (idx < nsel) ? __expf(sc[r] - mx) : 0.f; pbuf[h * 256 + idx] = p; ls += p; }
        ls = wave_sum(ls);
        __syncthreads();
        float a0 = 0.f, a1 = 0.f;
        for (int i = 0; i < nsel; ++i) { const float p = pbuf[h * 256 + i]; const unsigned vv = *(const unsigned*)(Vb + (size_t)list[i] * 256 + 2 * lane); a0 += p * bflo(vv); a1 += p * bfhi(vv); }
        const float inv = 1.f / ls; const size_t o = (size_t)t * 1024 + h * 128 + 2 * lane;
        const unsigned ya = *(const unsigned*)(F.P1 + o), sg = *(const unsigned*)(F.SGB + o);
        *(unsigned*)(F.XN + o) = pk2(bflo(ya) + bflo(sg) * a0 * inv, bfhi(ya) + bfhi(sg) * a1 * inv);
        __syncthreads();
    }
}

namespace att {
typedef short bf16x8 __attribute__((ext_vector_type(8)));
typedef short s16x4 __attribute__((ext_vector_type(4)));
typedef float f32x16 __attribute__((ext_vector_type(16)));
typedef unsigned u32x4 __attribute__((ext_vector_type(4)));
typedef unsigned u32x2 __attribute__((ext_vector_type(2)));
constexpr int DH = 128, QS = 1024, KVS = 256;
constexpr float SCALE = 0.08838834764831845f, THR = 8.f;
constexpr int NW = 8, QBLK = 32, KVBLK = 64, QB = NW * QBLK;
constexpr int SHM_V = KVBLK * DH * 2, SHM_K = KVBLK * DH * 2;
constexpr int OST_OFF = 2 * SHM_V + 2 * SHM_K + NW * 64 * 4, OST_PITCH = 272, OST_WAVE = 32 * OST_PITCH;
constexpr int LDS_BYTES = OST_OFF + NW * OST_WAVE;
#define KSWZ(row, colB) ((row) * 256 + ((colB) ^ (((row) & 7) << 4)))
#define SBAR() __builtin_amdgcn_sched_barrier(0)
__device__ __forceinline__ int v_st(int k, int c) { const int kk = (k & ~0xC) | ((k & 4) << 1) | ((k & 8) >> 1); return ((kk >> 3) * 4 + (c >> 5)) * 512 + ((kk & 7) * 32 + (c & 31)) * 2; }
__device__ __forceinline__ int v_rd_base(int lane) { return ((lane & 3) << 3) | (((lane >> 2) & 3) << 6) | (((lane >> 4) & 1) << 5) | (((lane >> 5) & 1) << 8); }
constexpr int v_rd_off(int d0, int ks, int half) { return d0 * 512 + ks * 4096 + half * 2048; }
__device__ __forceinline__ int crow(int r, int hi) { return (r & 3) + 8 * (r >> 2) + 4 * hi; }
__device__ __forceinline__ unsigned cvtpk(float lo, float hi) { unsigned r; asm volatile("v_cvt_pk_bf16_f32 %0, %1, %2" : "=v"(r) : "v"(lo), "v"(hi)); return r; }
__device__ __forceinline__ bf16x8 load8(const unsigned short* p) { return *reinterpret_cast<const bf16x8*>(p); }
__device__ __forceinline__ void partialSM(f32x16& p0, f32x16& p1, float& m_reg, float& mn, float& alpha) {
    float pmax = p0[0];
#pragma unroll
    for (int r = 1; r < 16; ++r) pmax = fmaxf(pmax, p0[r]);
#pragma unroll
    for (int r = 0; r < 16; ++r) pmax = fmaxf(pmax, p1[r]);
    { auto rr = __builtin_amdgcn_permlane32_swap(__float_as_uint(pmax), __float_as_uint(pmax), false, false);
      pmax = fmaxf(__uint_as_float(rr[0]), __uint_as_float(rr[1])); }
    constexpr float C2 = 1.4426950408889634f * SCALE;
    if (__builtin_expect(__all((pmax - m_reg) * SCALE <= THR), 1)) { mn = m_reg; alpha = 1.f; }
    else { mn = fmaxf(m_reg, pmax); alpha = __builtin_amdgcn_exp2f((m_reg - mn) * C2); m_reg = mn; }
    const float mnL = -mn * C2;
#pragma unroll
    for (int r = 0; r < 16; ++r) p0[r] = fmaf(p0[r], C2, mnL);
#pragma unroll
    for (int r = 0; r < 16; ++r) p1[r] = fmaf(p1[r], C2, mnL);
#pragma unroll
    for (int r = 0; r < 16; ++r) p0[r] = __builtin_amdgcn_exp2f(p0[r]);
}
__device__ __forceinline__ void finishSM(f32x16& p0, f32x16& p1, u32x2 mw, float alpha, float& l_reg, bf16x8& pa0, bf16x8& pa1, bf16x8& pa2, bf16x8& pa3) {
#pragma unroll
    for (int r = 0; r < 16; ++r) p1[r] = __builtin_amdgcn_exp2f(p1[r]);
#pragma unroll
    for (int r = 0; r < 16; ++r) { const int c = (r & 3) + 8 * (r >> 2);
        float t0, t1;
        asm("v_bfe_i32 %0, %1, %2, 1\n\tv_and_b32 %0, %3, %0" : "=&v"(t0) : "v"(mw.x), "n"(c), "v"(p0[r]));
        asm("v_bfe_i32 %0, %1, %2, 1\n\tv_and_b32 %0, %3, %0" : "=&v"(t1) : "v"(mw.y), "n"(c), "v"(p1[r]));
        p0[r] = t0; p1[r] = t1; }
    float ps = 0;
#pragma unroll
    for (int r = 0; r < 16; ++r) ps += p0[r];
#pragma unroll
    for (int r = 0; r < 16; ++r) ps += p1[r];
    { auto rr = __builtin_amdgcn_permlane32_swap(__float_as_uint(ps), __float_as_uint(ps), false, false);
      ps = __uint_as_float(rr[0]) + __uint_as_float(rr[1]); }
    l_reg = l_reg * alpha + ps;
#define PK4(P, B_, OUT) do { unsigned a0 = cvtpk(P[B_+0], P[B_+1]), a1 = cvtpk(P[B_+2], P[B_+3]);                          \
        unsigned b0 = cvtpk(P[B_+4], P[B_+5]), b1 = cvtpk(P[B_+6], P[B_+7]);                                             \
        auto r0 = __builtin_amdgcn_permlane32_swap(a0, b0, false, false); auto r1 = __builtin_amdgcn_permlane32_swap(a1, b1, false, false); \
        u32x4 w = {r0[0], r1[0], r0[1], r1[1]}; OUT = *reinterpret_cast<bf16x8*>(&w); } while (0)
    PK4(p0, 0, pa0); PK4(p0, 8, pa1); PK4(p1, 0, pa2); PK4(p1, 8, pa3);
#undef PK4
}
template <int KB>
__device__ __forceinline__ void qkt(f32x16& p0, f32x16& p1, const char* K_lds, int r32, int hi, const bf16x8* qr) {
    p0 = f32x16{}; p1 = f32x16{};
    const char* kb[4];
#pragma unroll
    for (int dd = 0; dd < 4; ++dd) kb[dd] = K_lds + KB * SHM_K + KSWZ(r32, (dd * 16 + hi * 8) * 2);
#pragma unroll
    for (int d0 = 0; d0 < 8; ++d0) { const char* a = kb[d0 & 3] + (d0 >> 2) * 128;
        bf16x8 b0 = *reinterpret_cast<const bf16x8*>(a);
        bf16x8 b1 = *reinterpret_cast<const bf16x8*>(a + 32 * 256);
        p0 = __builtin_amdgcn_mfma_f32_32x32x16_bf16(b0, qr[d0], p0, 0, 0, 0);
        p1 = __builtin_amdgcn_mfma_f32_32x32x16_bf16(b1, qr[d0], p1, 0, 0, 0); }
}
template <int VB>
__device__ __forceinline__ void pv_tile(f32x16* o, int vb0, bf16x8 pa0, bf16x8 pa1, bf16x8 pa2, bf16x8 pa3) {
#define TRRD(dst, off) asm volatile("ds_read_b64_tr_b16 %0, %1 offset:%2" : "=&v"(dst) : "v"(vb0), "i"(off) : "memory")
#define PV_D0(d0) do { s16x4 l0, l1, l2, l3, h0, h1, h2, h3; constexpr int b_ = VB * SHM_V + v_rd_off(d0, 0, 0); \
        TRRD(l0, b_); TRRD(h0, b_ + 2048); TRRD(l1, b_ + 4096); TRRD(h1, b_ + 6144); TRRD(l2, b_ + 8192); TRRD(h2, b_ + 10240); TRRD(l3, b_ + 12288); TRRD(h3, b_ + 14336); \
        asm volatile("s_waitcnt lgkmcnt(0)" ::: "memory"); SBAR();   \
        o[d0] = __builtin_amdgcn_mfma_f32_32x32x16_bf16(pa0, (bf16x8){l0[0], l0[1], l0[2], l0[3], h0[0], h0[1], h0[2], h0[3]}, o[d0], 0, 0, 0);   \
        o[d0] = __builtin_amdgcn_mfma_f32_32x32x16_bf16(pa1, (bf16x8){l1[0], l1[1], l1[2], l1[3], h1[0], h1[1], h1[2], h1[3]}, o[d0], 0, 0, 0);   \
        o[d0] = __builtin_amdgcn_mfma_f32_32x32x16_bf16(pa2, (bf16x8){l2[0], l2[1], l2[2], l2[3], h2[0], h2[1], h2[2], h2[3]}, o[d0], 0, 0, 0);   \
        o[d0] = __builtin_amdgcn_mfma_f32_32x32x16_bf16(pa3, (bf16x8){l3[0], l3[1], l3[2], l3[3], h3[0], h3[1], h3[2], h3[3]}, o[d0], 0, 0, 0); } while (0)
    PV_D0(0); PV_D0(1); PV_D0(2); PV_D0(3);
#undef PV_D0
#undef TRRD
}
struct BlockRef { const unsigned short* Q; const unsigned short* K; const unsigned short* V; const unsigned* M; const unsigned short* YA; const unsigned short* SG; unsigned short* OUT; int P0; const float* QG; const float* CW; };
struct Seam { bf16x8 qr[8]; bf16x8 st_v0, st_v1, st_k0, st_k1; };
#define ROWKV(p, k0, rr) ((p) + (size_t)((k0) + (rr)) * KVS + sc)
#define VMW() asm volatile("s_waitcnt vmcnt(0)" ::: "memory")
#define VMWN(n) asm volatile("s_waitcnt vmcnt(%0)" :: "i"(n) : "memory")
#define SLOAD_H(Kp, Vp, k0) do { S.st_v0 = load8(ROWKV(Vp, k0, sr)); S.st_v1 = load8(ROWKV(Vp, k0, 32 + sr)); S.st_k0 = load8(ROWKV(Kp, k0, sr)); S.st_k1 = load8(ROWKV(Kp, k0, 32 + sr)); } while (0)
#define SWRITE_HK(bf) do { *(bf16x8*)(K_lds + (bf) * SHM_K + kws) = S.st_k0; *(bf16x8*)(K_lds + (bf) * SHM_K + kws + 32 * 256) = S.st_k1; } while (0)
#define SWRITE_HV(bf) do { *(bf16x8*)(V_lds + (bf) * SHM_V + vst0) = S.st_v0; *(bf16x8*)(V_lds + (bf) * SHM_V + vst1) = S.st_v1; } while (0)
#define SWRITE_H(bf) do { SWRITE_HV(bf); SWRITE_HK(bf); } while (0)
__device__ __forceinline__ void qnorm(bf16x8 (&qr)[8], const float* qg, float pos, int hi) {
    float ss = 0.f;
#pragma unroll
    for (int d0 = 0; d0 < 8; ++d0) { const u32x4 w = *reinterpret_cast<const u32x4*>(&qr[d0]);
#pragma unroll
        for (int k = 0; k < 4; ++k) { const float lo = __uint_as_float(w[k] << 16), hf = __uint_as_float(w[k] & 0xffff0000u); ss += lo * lo + hf * hf; } }
    { auto rr = __builtin_amdgcn_permlane32_swap(__float_as_uint(ss), __float_as_uint(ss), false, false); ss = __uint_as_float(rr[0]) + __uint_as_float(rr[1]); }
    const float rstd = rsqrtf(ss * (1.f / 128.f) + EPS);
    float x1[8], x2[8];
#pragma unroll
    for (int d0 = 0; d0 < 8; ++d0) { const u32x4 w = *reinterpret_cast<const u32x4*>(&qr[d0]); const f32x4 g0 = *(const f32x4*)(qg + d0 * 16 + hi * 8), g1 = *(const f32x4*)(qg + d0 * 16 + hi * 8 + 4);
        float v[8];
#pragma unroll
        for (int k = 0; k < 4; ++k) { v[2 * k] = __uint_as_float(w[k] << 16); v[2 * k + 1] = __uint_as_float(w[k] & 0xffff0000u); }
#pragma unroll
        for (int j = 0; j < 4; ++j) { v[j] = v[j] * rstd * g0[j]; v[4 + j] = v[4 + j] * rstd * g1[j]; }
        if (d0 == 0) {
#pragma unroll
            for (int j = 0; j < 8; ++j) x1[j] = v[j];
        } else if (d0 == 1) {
#pragma unroll
            for (int j = 0; j < 8; ++j) { x2[j] = v[j]; float c, sn; rope_cs(pos, hi * 8 + j, 1.f / 16.f, c, sn); const float a = x1[j] * c - x2[j] * sn, b = x2[j] * c + x1[j] * sn; x1[j] = a; v[j] = b; }
            u32x4 o0; o0[0] = cvtpk(x1[0], x1[1]); o0[1] = cvtpk(x1[2], x1[3]); o0[2] = cvtpk(x1[4], x1[5]); o0[3] = cvtpk(x1[6], x1[7]); qr[0] = *reinterpret_cast<bf16x8*>(&o0);
        }
        if (d0 >= 1) { u32x4 o; o[0] = cvtpk(v[0], v[1]); o[1] = cvtpk(v[2], v[3]); o[2] = cvtpk(v[4], v[5]); o[3] = cvtpk(v[6], v[7]); qr[d0] = *reinterpret_cast<bf16x8*>(&o); } }
}
__device__ __forceinline__ void prime(const BlockRef& cur, char* lds, Seam& S, const int wid) {
    const int lane = hw_lane(), tid = wid * 64 + lane, r32 = lane & 31, hi = lane >> 5;
    const int sr = tid >> 4, sc = (tid & 15) * 8, kws = KSWZ(sr, sc * 2); char* K_lds = lds + 2 * SHM_V;
#pragma unroll
    for (int d0 = 0; d0 < 8; ++d0) S.qr[d0] = load8(cur.Q + (size_t)(wid * QBLK + r32) * QS + d0 * 16 + hi * 8);
    SLOAD_H(cur.K, cur.V, 0); VMW(); SWRITE_HK(0);
    __syncthreads();
}
__device__ __forceinline__ void block(const BlockRef& cur, const BlockRef& nxt, char* lds, Seam& S, const int wid) {
    const int lane = hw_lane(), tid = wid * 64 + lane, r32 = lane & 31, hi = lane >> 5;
    const int NT = (cur.P0 + QB) / KVBLK;
    char* V_lds = lds; char* K_lds = lds + 2 * SHM_V;
    float* ws = (float*)(lds + 2 * SHM_V + 2 * SHM_K) + wid * 64; float* li_l = ws, * al_l = ws + 32;
    { int hiq = hi; asm volatile("" : "+v"(hiq));
      qnorm(S.qr, cur.QG, (float)(cur.P0 + wid * QBLK + r32), hiq); }
    float m_reg = -1e30f, l_reg = 0; f32x16 o[4] = {};
    const int sr = tid >> 4, sc = (tid & 15) * 8, vst0 = v_st(sr, sc), vst1 = v_st(32 + sr, sc), kws = KSWZ(sr, sc * 2);
    const int vb0 = (int)(uintptr_t)V_lds + v_rd_base(lane);
    const unsigned short* Kh = cur.K; const unsigned short* Vh = cur.V;
    char* mlds = lds + OST_OFF + wid * OST_WAVE;
    u32x4 mrow_[8];
#pragma unroll
    for (int i = 0; i < 8; ++i) mrow_[i] = *(const u32x4*)(cur.M + (size_t)(wid * QBLK) * 64 + (size_t)(i * 64 + lane) * 4);
#define RESC(a) do { if (__any((a) < 1.f)) { if (hi == 0) al_l[r32] = (a); asm volatile("s_waitcnt lgkmcnt(0)" ::: "memory");              \
                     for (int d_ = 0; d_ < 4; ++d_) for (int r = 0; r < 16; ++r) o[d_][r] *= al_l[crow(r, hi)]; } } while (0)
#define KBASE(t) ((t) * KVBLK)
#define MLOAD(t) ({ u32x2 w_ = *(const u32x2*)(mlds + (lane & 31) * 272 + (t) * 8); w_.x >>= 4 * (lane >> 5); w_.y >>= 4 * (lane >> 5); w_; })
#define SEAM_K0() do { VMWN(8); SWRITE_HK(0); SBAR(); } while (0)
    f32x16 pA0, pA1, pB0, pB1; float mnA, mnB, alA, alB; bf16x8 pa0, pa1, pa2, pa3; u32x2 mw;
    SWRITE_HV(0); SBAR();
    if (NT > 1) { SLOAD_H(Kh, Vh, KBASE(1)); }
    SBAR(); qkt<0>(pA0, pA1, K_lds, r32, hi, S.qr);
    partialSM(pA0, pA1, m_reg, mnA, alA);
    if (NT > 1) { VMW(); SWRITE_H(1); }
#pragma unroll
    for (int i = 0; i < 8; ++i) *(u32x4*)(mlds + (i * 4 + (lane >> 4)) * 272 + (lane & 15) * 16) = mrow_[i];
    __syncthreads();
#define HALF_STEP(PX0, PX1, mnX, alX, PY0, PY1, alY, t, KB, VB, SB) do {                                              \
        mw = MLOAD((t) - 1);                                                                                                  \
        SBAR(); qkt<KB>(PX0, PX1, K_lds, r32, hi, S.qr);                                                                     \
        finishSM(PY0, PY1, mw, alY, l_reg, pa0, pa1, pa2, pa3); SBAR();                                                       \
        if ((t) + 1 < NT) { SLOAD_H(Kh, Vh, KBASE((t) + 1)); SBAR(); }                                                        \
        pv_tile<VB>(o, vb0, pa0, pa1, pa2, pa3); partialSM(PX0, PX1, m_reg, mnX, alX);                                        \
        __syncthreads();                                                                                                      \
        if ((t) + 1 < NT) { VMW(); SWRITE_H(SB); }                                                                            \
        RESC(alX); __syncthreads(); } while (0)
    for (int t = 1; t + 1 < NT; t += 2) {
        HALF_STEP(pB0, pB1, mnB, alB, pA0, pA1, alA, t, 1, 0, 0);
        HALF_STEP(pA0, pA1, mnA, alA, pB0, pB1, alB, t + 1, 0, 1, 1);
    }
    mw = MLOAD(NT - 2);
    SBAR(); qkt<1>(pB0, pB1, K_lds, r32, hi, S.qr); SBAR();
    SLOAD_H(nxt.K, nxt.V, 0); SBAR();
#pragma unroll
    for (int d0 = 0; d0 < 8; ++d0) S.qr[d0] = load8(nxt.Q + (size_t)(wid * QBLK + r32) * QS + d0 * 16 + hi * 8);
    SBAR();
    finishSM(pA0, pA1, mw, alA, l_reg, pa0, pa1, pa2, pa3); SBAR();
    mw = MLOAD(NT - 1);
    pv_tile<0>(o, vb0, pa0, pa1, pa2, pa3);
    partialSM(pB0, pB1, m_reg, mnB, alB); __syncthreads(); RESC(alB);
    finishSM(pB0, pB1, mw, alB, l_reg, pa0, pa1, pa2, pa3); SBAR(); pv_tile<1>(o, vb0, pa0, pa1, pa2, pa3);
    SBAR(); SEAM_K0();
    if (hi == 0) li_l[r32] = l_reg; asm volatile("s_waitcnt lgkmcnt(0)" ::: "memory");
    { int sbo = OST_OFF + wid * OST_WAVE + 4 * hi * OST_PITCH + r32 * 2; asm volatile("" : "+v"(sbo));
      char* sb = lds + sbo; const float* lih = li_l + 4 * hi;
#pragma unroll
      for (int r = 0; r < 16; ++r) { constexpr int dummy = 0; const int ro = (r & 3) + 8 * (r >> 2); const float rl = __builtin_amdgcn_rcpf(lih[ro]);
#pragma unroll
          for (int d0 = 0; d0 < 4; ++d0) { const unsigned pk = cvtpk(o[d0][r] * rl, 0.f); *(unsigned short*)(sb + ro * OST_PITCH + d0 * 64) = (unsigned short)pk; } }
      asm volatile("s_waitcnt lgkmcnt(0)" ::: "memory");
      int rdo = OST_OFF + wid * OST_WAVE + (lane >> 4) * OST_PITCH + (lane & 15) * 16; asm volatile("" : "+v"(rdo));
      unsigned goff = (unsigned)((wid * QBLK + (lane >> 4)) * QS + (lane & 15) * 8) * 2u; asm volatile("" : "+v"(goff));
      constexpr unsigned UOFF = 32u << 20;
      f32x4 cw[6];
#pragma unroll
      for (int r = 0; r < 3; ++r) { cw[2 * r] = *(const f32x4*)(cur.CW + r * 1024 + (lane & 15) * 8); cw[2 * r + 1] = *(const f32x4*)(cur.CW + r * 1024 + (lane & 15) * 8 + 4); }
      const int srow = cur.P0 + wid * QBLK + (lane >> 4);
#pragma unroll
      for (int hb = 0; hb < 2; ++hb) {
          u32x4 yav[4], sgv[4], u0v[4], u1v[4], u2v[4];
#pragma unroll
          for (int k = 0; k < 4; ++k) { const unsigned off = goff + (hb * 4 + k) * 4 * QS * 2;
              yav[k] = *(const u32x4*)((const char*)cur.YA + off); sgv[k] = *(const u32x4*)((const char*)cur.SG + off);
              u0v[k] = *(const u32x4*)((const char*)cur.YA + UOFF + off); u1v[k] = *(const u32x4*)((const char*)cur.YA + UOFF + off - QS * 2); u2v[k] = *(const u32x4*)((const char*)cur.YA + UOFF + off - 2 * QS * 2); }
          SBAR();
#pragma unroll
          for (int k = 0; k < 4; ++k) { const int i = hb * 4 + k, sp = srow + 4 * i;
              const u32x4 ov = *(const u32x4*)(lds + rdo + i * 4 * OST_PITCH);
              const u32x4 ya = yav[k], sg = sgv[k], a0 = u0v[k]; u32x4 a1 = u1v[k], a2 = u2v[k]; u32x4 res;
              if (sp < 1) a1 = (u32x4){0u, 0u, 0u, 0u};
              if (sp < 2) a2 = (u32x4){0u, 0u, 0u, 0u};
#define LO(w_) __uint_as_float((w_) << 16)
#define HI(w_) __uint_as_float((w_) & 0xffff0000u)
#define MG(kk, W0, W1, W2, i0, i1) res.kk = cvtpk(LO(ya.kk) * (W0[i0] * LO(a2.kk) + W1[i0] * LO(a1.kk) + W2[i0] * LO(a0.kk)) + LO(sg.kk) * LO(ov.kk), HI(ya.kk) * (W0[i1] * HI(a2.kk) + W1[i1] * HI(a1.kk) + W2[i1] * HI(a0.kk)) + HI(sg.kk) * HI(ov.kk))
              MG(x, cw[0], cw[2], cw[4], 0, 1); MG(y, cw[0], cw[2], cw[4], 2, 3); MG(z, cw[1], cw[3], cw[5], 0, 1); MG(w, cw[1], cw[3], cw[5], 2, 3);
#undef MG
#undef LO
#undef HI
              *(u32x4*)((char*)cur.OUT + goff + i * 4 * QS * 2) = res; } } }
    __syncthreads();
#undef RESC
#undef KBASE
#undef MLOAD
#undef SEAM_K0
#undef HALF_STEP
}
#undef ROWKV
#undef VMW
#undef VMWN
#undef SLOAD_H
#undef SWRITE_HK
#undef SWRITE_HV
#undef SWRITE_H
#undef KSWZ
#undef SBAR
}
__device__ __forceinline__ att::BlockRef attn_ref(const Ctx& F, int bh, int qb) {
    const int b = bh >> 3, h = bh & 7; const size_t tok0 = (size_t)b * SEQ + (size_t)qb * 256;
    att::BlockRef r;
    r.Q = F.Q + tok0 * 1024 + h * 128; r.K = F.K + (size_t)b * SEQ * 256 + (h >> 2) * 128; r.V = F.V + (size_t)b * SEQ * 256 + (h >> 2) * 128;
    r.M = F.MASK + tok0 * 64; r.YA = F.P1 + tok0 * 1024 + h * 128; r.SG = F.SGB + tok0 * 1024 + h * 128; r.OUT = F.XN + tok0 * 1024 + h * 128; r.P0 = qb * 256; r.QG = F.qg; r.CW = F.conv_w + h * 128;
    return r;
}
__device__ __forceinline__ void attn_decode(int l, int& bh, int& q0, int& q1) { const int xcd = l & 7, k = l >> 3, gi = k >> 4, r = k & 15, g = gi * 8 + xcd; bh = (g >> 1) * 8 + (g & 1) * 4 + (r >> 2); q0 = r & 3; q1 = 7 - q0; }
__device__ __forceinline__ void phase_attn(Ctx& F) {
    constexpr int NITEMS = 256;
    att::Seam S;
    int L = F.bid; if (L >= NITEMS) return;
    int bh, q0, q1; attn_decode(L, bh, q0, q1); int pass = 0;
    att::BlockRef cur = attn_ref(F, bh, q0);
    att::prime(cur, (char*)F.lds, S, F.wave);
    for (;;) {
        const bool more_pass = pass == 0, more_item = L + F.G < NITEMS, last = !more_pass && !more_item;
        int bhn = bh, q0n = q0, q1n = q1, passn = pass + 1, Ln = L;
        if (!more_pass) { passn = 0; Ln = more_item ? L + F.G : L; attn_decode(Ln, bhn, q0n, q1n); }
        const att::BlockRef nxt = last ? cur : attn_ref(F, bhn, passn ? q1n : q0n);
        att::block(cur, nxt, (char*)F.lds, S, F.wave);
        if (last) break;
        cur = nxt; bh = bhn; q0 = q0n; q1 = q1n; pass = passn; L = Ln;
    }
}

template <int NV, int MODE> __device__ __forceinline__ void top16(float (&v)[NV], int lane, float& outv, int& outi) {
    outv = 0.f; outi = 0;
    for (int r = 0; r < 16; ++r) {
        float m = v[0];
#pragma unroll
        for (int k = 1; k < NV; ++k) m = fmaxf(m, v[k]);
        const float M = wave_max(m);
        int ci = 0x7fffffff;
#pragma unroll
        for (int k = NV - 1; k >= 0; --k) if (v[k] == M) ci = MODE ? NV * lane + k : lane + 64 * k;
        const int I = wave_mini(ci);
#pragma unroll
        for (int k = 0; k < NV; ++k) if ((MODE ? NV * lane + k : lane + 64 * k) == I) v[k] = -__builtin_inff();
        if (lane == r) { outv = M; outi = I; }
    }
}
__device__ __forceinline__ void phase_route_simple(Ctx& F) {
    float* qf = (float*)F.lds; const int lane = hw_lane(), h = F.wave;
    for (int t = F.bid; t < T; t += F.G) {
        { const v2u qq = *(const v2u*)(F.PQ + (size_t)t * 2048 + h * 256 + 4 * lane); float* q = qf + h * 256 + 4 * lane; q[0] = bflo(qq.x); q[1] = bfhi(qq.x); q[2] = bflo(qq.y); q[3] = bfhi(qq.y); }
        __syncthreads();
        float s1[2], s2[2];
#pragma unroll 1
        for (int hf = 0; hf < 2; ++hf) { const bf16* kb = (hf ? F.K2 : F.K1) + (size_t)h * 128 * 128;
#pragma unroll 1
            for (int r = 0; r < 2; ++r) { const v4u* kr = (const v4u*)(kb + (size_t)(lane + 64 * r) * 128); float d = 0.f;
#pragma unroll
                for (int c = 0; c < 16; ++c) { const v4u w = kr[c]; const float* q = qf + h * 256 + hf * 128 + 8 * c;
                    d += q[0] * bflo(w.x) + q[1] * bfhi(w.x) + q[2] * bflo(w.y) + q[3] * bfhi(w.y) + q[4] * bflo(w.z) + q[5] * bfhi(w.z) + q[6] * bflo(w.w) + q[7] * bfhi(w.w); }
                if (hf) s2[r] = d; else s1[r] = d; } }
        float v1, v2; int i1, i2;
        top16<2, 0>(s1, lane, v1, i1); top16<2, 0>(s2, lane, v2, i2);
        float cand[4]; const float a = __shfl(v1, lane >> 2);
#pragma unroll
        for (int k = 0; k < 4; ++k) cand[k] = a + __shfl(v2, (lane & 3) * 4 + k);
        float ts; int pos; top16<4, 1>(cand, lane, ts, pos);
        const int e1 = __shfl(i1, (pos >> 4) & 15), e2 = __shfl(i2, pos & 15);
        const float m0 = __shfl(ts, 0); const float ex = (lane < 16) ? __expf(ts - m0) : 0.f; const float sum = wave_sum(ex);
        if (lane < 16) { F.EIDX[(size_t)t * 128 + h * 16 + lane] = e1 * 128 + e2; F.GATE[(size_t)t * 128 + h * 16 + lane] = ex / sum; }
        __syncthreads();
    }
}

namespace rt {
typedef short bf16x8 __attribute__((ext_vector_type(8)));
typedef float f32x16 __attribute__((ext_vector_type(16)));
__device__ __forceinline__ unsigned skey(float f) { const unsigned u = __float_as_uint(f); return u ^ ((unsigned)((int)u >> 31) | 0x80000000u); }
__device__ __forceinline__ float unkey(unsigned k) { return __uint_as_float((k & 0x80000000u) ? (k ^ 0x80000000u) : ~k); }
__device__ __forceinline__ void ce(unsigned& a, unsigned& b) { unsigned mx, mn; asm("v_max_f32 %0, %2, %3\n\tv_min_f32 %1, %2, %3" : "=&v"(mx), "=&v"(mn) : "v"(a), "v"(b)); a = mx; b = mn; }
__device__ __forceinline__ unsigned fmaxk(unsigned a, unsigned b) { unsigned r; asm("v_max_f32 %0, %1, %2" : "=v"(r) : "v"(a), "v"(b)); return r; }
template <int N> __device__ __forceinline__ void sort_desc(unsigned* a) {
#pragma unroll
    for (int k = 2; k <= N; k <<= 1)
#pragma unroll
        for (int j = k >> 1; j > 0; j >>= 1)
#pragma unroll
            for (int i = 0; i < N; ++i) { const int l = i ^ j; if (l > i) { if ((i & k) == 0) ce(a[i], a[l]); else ce(a[l], a[i]); } }
}
__device__ __forceinline__ void merge_bitonic16(unsigned* a) {
#pragma unroll
    for (int j = 8; j > 0; j >>= 1)
#pragma unroll
        for (int i = 0; i < 16; ++i) { const int l = i ^ j; if (l > i) ce(a[i], a[l]); }
}
template <bool SORT> __device__ __forceinline__ void top16_merge(unsigned* a, const unsigned* b) {
#pragma unroll
    for (int i = 0; i < 16; ++i) a[i] = fmaxk(a[i], b[15 - i]);
    if (SORT) merge_bitonic16(a);
}
template <bool SORT> __device__ __forceinline__ void pair_merge(unsigned* a) {
    unsigned lo[16], hi[16];
#pragma unroll
    for (int i = 0; i < 16; ++i) { auto rr = __builtin_amdgcn_permlane32_swap(a[i], a[i], false, false); lo[i] = rr[0]; hi[i] = rr[1]; }
    top16_merge<SORT>(lo, hi);
#pragma unroll
    for (int i = 0; i < 16; ++i) a[i] = lo[i];
}
}
__device__ __forceinline__ void phase_route(Ctx& F) {
    const int lane = hw_lane(), r32 = lane & 31, hi = lane >> 5;
    float* lv = (float*)(F.lds + F.wave * 8192);
    int* li = (int*)(F.lds + F.wave * 8192 + 4096);
    constexpr int KOFF = 65536, KPITCH = 272, KHALF = 128 * KPITCH;
    const bool staged = (F.G & 7) == 0;
    if (staged) { const int head = F.bid & 7;
        for (int c = (F.wave * 64 + hw_lane()); c < 2 * 128 * 16; c += NTHR) { const int hf = c >> 11, row = (c >> 4) & 127, ch = c & 15;
            *(v4u*)(F.lds + KOFF + hf * KHALF + row * KPITCH + ch * 16) = *(const v4u*)((hf ? F.K2 : F.K1) + (size_t)head * 128 * 128 + row * 128 + ch * 8); }
        __syncthreads(); }
    for (int tau = F.bid * NWAVES + F.wave; tau < 4096; tau += F.G * NWAVES) {
        const int head = (tau >> 3) & 7, tg = (tau & 7) | ((tau >> 6) << 3);
        const size_t token = (size_t)tg * 32 + r32;
        const bf16* qb = F.PQ + ((size_t)tg * 8 + head) * (16 * 512) + (32 * hi + r32) * 8;
        rt::bf16x8 bqa[16];
#pragma unroll
        for (int s = 0; s < 16; ++s) bqa[s] = *(const rt::bf16x8*)(qb + 512 * s);
#pragma unroll 1
        for (int half = 0; half < 2; ++half) {
            const bf16* kb = (half ? F.K2 : F.K1) + (size_t)head * 128 * 128 + (size_t)r32 * 128 + 8 * hi;
            const unsigned char* kl = F.lds + KOFF + half * KHALF + r32 * KPITCH + 16 * hi;
            rt::f32x16 acc[4] = {};
#pragma unroll
            for (int s = 0; s < 8; ++s) { const rt::bf16x8 bq = half ? bqa[8 + s] : bqa[s];
#pragma unroll
                for (int tl = 0; tl < 4; ++tl) { const rt::bf16x8 ak = staged ? *(const rt::bf16x8*)(kl + tl * 32 * KPITCH + 32 * s) : *(const rt::bf16x8*)(kb + (size_t)tl * 32 * 128 + 16 * s);
                    acc[tl] = __builtin_amdgcn_mfma_f32_32x32x16_bf16(ak, bq, acc[tl], 0, 0, 0); } }
            unsigned key[64];
#pragma unroll
            for (int tl = 0; tl < 4; ++tl)
#pragma unroll
                for (int r = 0; r < 16; ++r) { const int idx0 = tl * 32 + (r & 3) + 8 * (r >> 2);
                    key[tl * 16 + r] = (__float_as_uint(acc[tl][r]) & ~127u) | (unsigned)(127 - idx0 - 4 * hi); }
            rt::sort_desc<16>(key); rt::sort_desc<16>(key + 16); rt::sort_desc<16>(key + 32); rt::sort_desc<16>(key + 48);
            rt::top16_merge<true>(key, key + 16); rt::top16_merge<true>(key + 32, key + 48); rt::top16_merge<true>(key, key + 32);
            rt::pair_merge<true>(key);
            if (hi == half) {
#pragma unroll
                for (int i = 0; i < 16; ++i) { lv[(r32 * 2 + half) * 16 + i] = __uint_as_float(key[i] & ~127u); li[(r32 * 2 + half) * 16 + i] = 127 - (int)(key[i] & 127u); } }
        }
        LDS_WAIT(); asm volatile("" ::: "memory");
        float A[16], B[16];
        { const float* pa = lv + (r32 * 2 + hi) * 16; const float* pb = lv + (r32 * 2 + (hi ^ 1)) * 16;
#pragma unroll
          for (int i = 0; i < 16; ++i) { A[i] = pa[i]; B[i] = pb[i]; } }
        unsigned ck[32]; int nc = 0;
#pragma unroll
        for (int i = 0; i < 4; ++i)
#pragma unroll
            for (int j = i; j < 16; ++j) if ((i + 1) * (j + 1) <= 16) {
                const unsigned code = hi ? (unsigned)(255 - (j * 16 + i)) : (unsigned)(255 - (i * 16 + j));
                unsigned k = (__float_as_uint(A[i] + B[j]) & ~255u) | code; if (i == j && hi) k = 0xff800000u; ck[nc++] = k; }
#pragma unroll
        for (int i = nc; i < 32; ++i) ck[i] = 0xff800000u;
        rt::sort_desc<16>(ck); rt::sort_desc<16>(ck + 16); rt::top16_merge<true>(ck, ck + 16);
        rt::pair_merge<false>(ck);
        float sv[16]; int ev[16]; float mx = -__builtin_inff();
#pragma unroll
        for (int i = 0; i < 16; ++i) { const int code = 255 - (int)(ck[i] & 255u), r1 = code >> 4, r2 = code & 15;
            sv[i] = lv[(r32 * 2) * 16 + r1] + lv[(r32 * 2 + 1) * 16 + r2]; ev[i] = li[(r32 * 2) * 16 + r1] * 128 + li[(r32 * 2 + 1) * 16 + r2]; mx = fmaxf(mx, sv[i]); }
        float sum = 0.f;
#pragma unroll
        for (int i = 0; i < 16; ++i) { sv[i] = __expf(sv[i] - mx); sum += sv[i]; }
        const float inv = 1.f / sum; const size_t ob = token * 128 + head * 16;
        if (hi == 0) {
#pragma unroll
            for (int i = 0; i < 4; ++i) *(int4*)(F.EIDX + ob + 4 * i) = make_int4(ev[4 * i], ev[4 * i + 1], ev[4 * i + 2], ev[4 * i + 3]);
        } else {
#pragma unroll
            for (int i = 0; i < 4; ++i) *(f32x4*)(F.GATE + ob + 4 * i) = (f32x4){sv[4 * i] * inv, sv[4 * i + 1] * inv, sv[4 * i + 2] * inv, sv[4 * i + 3] * inv};
        }
        LDS_WAIT(); asm volatile("" ::: "memory");
    }
}

__device__ __forceinline__ float gelu_exact(float v) {
    const float av = fabsf(v), t = __builtin_amdgcn_rcpf(av * 0.2316418882f + 1.0f);
    float q = t * 0.5307027145f + (-0.7265760135f); q = q * t + 0.7107068705f; q = q * t + (-0.142248368f); q = q * t + 0.127414796f; q = q * t;
    const float e = __builtin_amdgcn_exp2f((v * v) * (-0.72134752044f)), m = v * (q * e);
    return v < 0.f ? m : v - m;
}
typedef float f32x2v __attribute__((ext_vector_type(2)));
#define DEC16(W_, f) do { f32x2v t_; t_ = __builtin_amdgcn_cvt_pk_f32_fp8((int)(W_).x, false); f[0] = t_.x; f[1] = t_.y; t_ = __builtin_amdgcn_cvt_pk_f32_fp8((int)(W_).x, true); f[2] = t_.x; f[3] = t_.y; \
    t_ = __builtin_amdgcn_cvt_pk_f32_fp8((int)(W_).y, false); f[4] = t_.x; f[5] = t_.y; t_ = __builtin_amdgcn_cvt_pk_f32_fp8((int)(W_).y, true); f[6] = t_.x; f[7] = t_.y; \
    t_ = __builtin_amdgcn_cvt_pk_f32_fp8((int)(W_).z, false); f[8] = t_.x; f[9] = t_.y; t_ = __builtin_amdgcn_cvt_pk_f32_fp8((int)(W_).z, true); f[10] = t_.x; f[11] = t_.y; \
    t_ = __builtin_amdgcn_cvt_pk_f32_fp8((int)(W_).w, false); f[12] = t_.x; f[13] = t_.y; t_ = __builtin_amdgcn_cvt_pk_f32_fp8((int)(W_).w, true); f[14] = t_.x; f[15] = t_.y; } while (0)
__device__ __forceinline__ void ald16(v4u& d, unsigned off, const void* base) { asm volatile("global_load_dwordx4 %0, %1, %2" : "=&v"(d) : "v"(off), "s"(base) : "memory"); }
__device__ __forceinline__ void ald2(unsigned& d, unsigned off, const void* base) { asm volatile("global_load_ushort %0, %1, %2" : "=&v"(d) : "v"(off), "s"(base) : "memory"); }
__device__ __forceinline__ void ald8(v2u& d, unsigned off, const void* base) { asm volatile("global_load_dwordx2 %0, %1, %2" : "=&v"(d) : "v"(off), "s"(base) : "memory"); }
__device__ __forceinline__ void ald4(unsigned& d, unsigned off, const void* base) { asm volatile("global_load_dword %0, %1, %2" : "=&v"(d) : "v"(off), "s"(base) : "memory"); }
#define AWAIT(N) asm volatile("s_waitcnt vmcnt(" #N ")" ::: "memory")
__device__ __forceinline__ unsigned amov(unsigned s) { unsigned d; asm volatile("v_mov_b32 %0, %1" : "=v"(d) : "v"(s)); return d; }
__device__ __forceinline__ v4u amov4(const v4u& s) { v4u d; asm volatile("v_mov_b32 %0, %4\n\tv_mov_b32 %1, %5\n\tv_mov_b32 %2, %6\n\tv_mov_b32 %3, %7" : "=&v"(d.x), "=&v"(d.y), "=&v"(d.z), "=&v"(d.w) : "v"(s.x), "v"(s.y), "v"(s.z), "v"(s.w)); return d; }
__device__ __forceinline__ void adec16(const v4u& w, float (&f)[16]) {
    f32x2v a, b, c, d, e, g, h, i;
    asm volatile("v_cvt_pk_f32_fp8_e32 %0, %8\n\tv_cvt_pk_f32_fp8_sdwa %1, %8 src0_sel:WORD_1\n\tv_cvt_pk_f32_fp8_e32 %2, %9\n\tv_cvt_pk_f32_fp8_sdwa %3, %9 src0_sel:WORD_1\n\t"
                 "v_cvt_pk_f32_fp8_e32 %4, %10\n\tv_cvt_pk_f32_fp8_sdwa %5, %10 src0_sel:WORD_1\n\tv_cvt_pk_f32_fp8_e32 %6, %11\n\tv_cvt_pk_f32_fp8_sdwa %7, %11 src0_sel:WORD_1"
                 : "=&v"(a), "=&v"(b), "=&v"(c), "=&v"(d), "=&v"(e), "=&v"(g), "=&v"(h), "=&v"(i) : "v"(w.x), "v"(w.y), "v"(w.z), "v"(w.w));
    f[0] = a.x; f[1] = a.y; f[2] = b.x; f[3] = b.y; f[4] = c.x; f[5] = c.y; f[6] = d.x; f[7] = d.y; f[8] = e.x; f[9] = e.y; f[10] = g.x; f[11] = g.y; f[12] = h.x; f[13] = h.y; f[14] = i.x; f[15] = i.y;
}
__device__ __forceinline__ void adec16p(const v4u& w, f32x2v (&f)[8]) {
    asm volatile("v_cvt_pk_f32_fp8_e32 %0, %8\n\tv_cvt_pk_f32_fp8_sdwa %1, %8 src0_sel:WORD_1\n\tv_cvt_pk_f32_fp8_e32 %2, %9\n\tv_cvt_pk_f32_fp8_sdwa %3, %9 src0_sel:WORD_1\n\t"
                 "v_cvt_pk_f32_fp8_e32 %4, %10\n\tv_cvt_pk_f32_fp8_sdwa %5, %10 src0_sel:WORD_1\n\tv_cvt_pk_f32_fp8_e32 %6, %11\n\tv_cvt_pk_f32_fp8_sdwa %7, %11 src0_sel:WORD_1"
                 : "=&v"(f[0]), "=&v"(f[1]), "=&v"(f[2]), "=&v"(f[3]), "=&v"(f[4]), "=&v"(f[5]), "=&v"(f[6]), "=&v"(f[7]) : "v"(w.x), "v"(w.y), "v"(w.z), "v"(w.w));
}
#define GROWS(TBL, EV, XW) do { _Pragma("unroll") for (int i = 0; i < 8; ++i) { const unsigned e_ = (unsigned)__shfl((int)(EV), 8 * i + rg); ald16(XW[i], e_ * 128u + toff, TBL); } } while (0)
__device__ __forceinline__ void phase_gather_dots(Ctx& F) {
    typedef int v8i __attribute__((ext_vector_type(8)));
    const int lane = hw_lane(), c4 = F.cls & 3, par = F.cls >> 2, cw = F.crank * NWAVES + F.wave, ncw = F.cnb * NWAVES;
    const int jj = lane & 15, g = lane >> 4, sub = lane & 7, rg = lane >> 3;
    const unsigned hoff = (unsigned)(256 * c4 + 16 * g) * 2u, toff = (unsigned)c4 * (16384u * 128u) + 16u * (unsigned)sub;
    const void* U4 = F.UB; const void* EI = F.EIDX; const void* HN = HB_OF(F); const void* RS = RSTD_OF(F);
    const unsigned wbase = (unsigned)(size_t)(LAS unsigned char*)F.lds + (unsigned)F.wave * 16384u;
    const unsigned wofs0 = wbase + (unsigned)rg * 128u + 16u * (unsigned)(sub ^ (rg >> 1)), wofs1 = wbase + (unsigned)rg * 128u + 16u * (unsigned)(sub ^ (4 + (rg >> 1)));
    LAS unsigned char* rp0 = (LAS unsigned char*)F.lds + F.wave * 16384 + jj * 128 + 16 * (g ^ (jj >> 1));
    LAS unsigned char* rp1 = (LAS unsigned char*)F.lds + F.wave * 16384 + jj * 128 + 16 * ((4 + g) ^ (jj >> 1));
    if (cw >= T / 2) return;
    int u = cw;
    struct Raw { unsigned e0, e1, rs; v4u h0, h1, h2, h3, h4, h5, h6, h7; };
#define G1_OPS(uu, Q) do { const unsigned tt_ = 2u * (unsigned)(uu) + (unsigned)par, eo_ = (tt_ * 128u + (unsigned)lane) * 4u, ho_ = tt_ * 2048u + hoff; \
        ald4(Q.e0, eo_, EI); ald4(Q.e1, eo_ + 256u, EI); ald4(Q.rs, tt_ * 4u, RS); ald16(Q.h0, ho_, HN); ald16(Q.h1, ho_ + 16u, HN); ald16(Q.h2, ho_ + 128u, HN); ald16(Q.h3, ho_ + 144u, HN); \
        ald16(Q.h4, ho_ + 256u, HN); ald16(Q.h5, ho_ + 272u, HN); ald16(Q.h6, ho_ + 384u, HN); ald16(Q.h7, ho_ + 400u, HN); } while (0)
#define G1_F8(W, R_) ({ int p_ = 0; p_ = __builtin_amdgcn_cvt_pk_fp8_f32(bflo(W.x) * R_, bfhi(W.x) * R_, p_, false); p_ = __builtin_amdgcn_cvt_pk_fp8_f32(bflo(W.y) * R_, bfhi(W.y) * R_, p_, true); p_; })
#define G1_F8B(W, R_) ({ int p_ = 0; p_ = __builtin_amdgcn_cvt_pk_fp8_f32(bflo(W.z) * R_, bfhi(W.z) * R_, p_, false); p_ = __builtin_amdgcn_cvt_pk_fp8_f32(bflo(W.w) * R_, bfhi(W.w) * R_, p_, true); p_; })
#define G1_L2(HQ, H8, B_) do { const v4u w_ = amov4(HQ); H8[B_] = G1_F8(w_, rs_); H8[B_ + 1] = G1_F8B(w_, rs_); } while (0)
#define G1_LAND(Q, E0, E1, H8) do { E0 = amov(Q.e0); E1 = amov(Q.e1); const float rs_ = __uint_as_float(amov(Q.rs)); \
        G1_L2(Q.h0, H8, 0); G1_L2(Q.h1, H8, 2); G1_L2(Q.h2, H8, 4); G1_L2(Q.h3, H8, 6); G1_L2(Q.h4, H8, 8); G1_L2(Q.h5, H8, 10); G1_L2(Q.h6, H8, 12); G1_L2(Q.h7, H8, 14); } while (0)
#define G1_ROWS(EV, XW) do { _Pragma("unroll") for (int i = 0; i < 8; ++i) { const unsigned e_ = (unsigned)__shfl((int)(EV), 8 * i + rg); ald16(XW[i], e_ * 128u + toff, U4); } } while (0)
#define G1_STAGE(XW, HF) do { _Pragma("unroll") for (int i = 0; i < 8; ++i) asm volatile("ds_write_b128 %0, %1 offset:%2" :: "v"((i & 1) ? wofs1 : wofs0), "v"(XW[i]), "i"((HF) * 8192 + i * 1024) : "memory"); } while (0)
#define G1_MMA(HF, H8, D_) do { const v8i ha0_ = {H8[0], H8[1], H8[2], H8[3], H8[4], H8[5], H8[6], H8[7]}, ha1_ = {H8[8], H8[9], H8[10], H8[11], H8[12], H8[13], H8[14], H8[15]}; \
        _Pragma("unroll") for (int m = 0; m < 4; ++m) { const v4u b0_ = *(const LAS v4u*)(rp0 + (HF) * 8192 + m * 2048), b1_ = *(const LAS v4u*)(rp1 + (HF) * 8192 + m * 2048); \
            const v8i ub0_ = {(int)b0_.x, (int)b0_.y, (int)b0_.z, (int)b0_.w, 0, 0, 0, 0}, ub1_ = {(int)b1_.x, (int)b1_.y, (int)b1_.z, (int)b1_.w, 0, 0, 0, 0}; \
            f32x4 c_ = __builtin_amdgcn_mfma_scale_f32_16x16x128_f8f6f4(ha0_, ub0_, (f32x4){0.f, 0.f, 0.f, 0.f}, 0, 4, 0, 0x7F7F7F7F, 0, 0x7F7F7F7F); \
            c_ = __builtin_amdgcn_mfma_scale_f32_16x16x128_f8f6f4(ha1_, ub1_, c_, 0, 4, 0, 0x7F7F7F7F, 0, 0x7F7F7F7F); D_[m] = c_[0]; } } while (0)
    Raw raw; v4u xa[8], xb[8];
    unsigned ea, eb; int h8[16];
    const float mk0 = (g == 0) ? 1.f / U4_SCALE : 0.f, mk1 = (g == 1) ? 1.f / U4_SCALE : 0.f, mk2 = (g == 2) ? 1.f / U4_SCALE : 0.f, mk3 = (g == 3) ? 1.f / U4_SCALE : 0.f;
    G1_OPS(u, raw);
    AWAIT(0);
    G1_LAND(raw, ea, eb, h8);
    G1_ROWS(ea, xa);
    { const int u1 = (u + ncw < T / 2) ? u + ncw : u; G1_OPS(u1, raw); }
    for (;;) {
        const int un = u + ncw; const bool more = un < T / 2;
        float d[4];
        G1_ROWS(eb, xb);
        AWAIT(19);
        G1_STAGE(xa, 0);
        __builtin_amdgcn_sched_barrier(0);
        G1_MMA(0, h8, d);
        float s0 = d[0] * mk0 + d[2] * mk1, s1 = d[1] * mk0 + d[3] * mk1;
        asm volatile("" : "+v"(s0), "+v"(s1));
        __builtin_amdgcn_sched_barrier(0);
        AWAIT(8);
        unsigned nea, neb; int nh8[16];
        G1_LAND(raw, nea, neb, nh8);
        G1_ROWS(nea, xa);
        { const int u2 = (un + ncw < T / 2) ? un + ncw : u; G1_OPS(u2, raw); }
        AWAIT(19);
        G1_STAGE(xb, 1);
        __builtin_amdgcn_sched_barrier(0);
        G1_MMA(1, h8, d);
        s0 += d[0] * mk2 + d[2] * mk3; s1 += d[1] * mk2 + d[3] * mk3;
        { bf16* pd_ = (bf16*)F.PD + ((size_t)(2 * u + par) * 128 + 32 * g + jj) * 4 + c4; pd_[0] = (bf16)f2bf(s0); pd_[64] = (bf16)f2bf(s1); }
        __builtin_amdgcn_sched_barrier(0);
        if (!more) break;
        u = un; eb = neb;
#pragma unroll
        for (int q = 0; q < 16; ++q) h8[q] = nh8[q];
    }
    AWAIT(0);
#undef G1_OPS
#undef G1_F8
#undef G1_F8B
#undef G1_L2
#undef G1_LAND
#undef G1_ROWS
#undef G1_STAGE
#undef G1_MMA
}
__device__ __forceinline__ void phase_gather_axpy(Ctx& F) {
    typedef int v8i __attribute__((ext_vector_type(8)));
    const int lane = hw_lane(), c4 = F.cls & 3, par = F.cls >> 2, cw = F.crank * NWAVES + F.wave, ncw = F.cnb * NWAVES;
    const int sub = lane & 7, rg = lane >> 3, jj = lane & 15, g = lane >> 4;
    const unsigned toff = (unsigned)c4 * (16384u * 128u) + 16u * (unsigned)sub;
    const void* V4 = F.VB; const void* EI = F.EIDX; const void* GT = F.GATE; const void* PDp = F.PD; const void* OUTp = F.out; const void* H1p = HB_OF(F);
    const unsigned wbase = (unsigned)(size_t)(LAS unsigned char*)F.lds + (unsigned)F.wave * 16384u;
    const unsigned wofs0 = wbase + (unsigned)rg * 128u + 16u * (unsigned)(sub ^ (rg >> 1)), wofs1 = wbase + (unsigned)rg * 128u + 16u * (unsigned)(sub ^ (4 + (rg >> 1)));
    const unsigned wtab = (unsigned)(size_t)(LAS unsigned char*)F.lds + 131072u + (unsigned)F.wave * 128u;
    unsigned rc[8];
#pragma unroll
    for (int c = 0; c < 8; ++c) rc[c] = wbase + (unsigned)(32 * g + jj) * 128u + 16u * (unsigned)(c ^ (jj >> 1));
    const unsigned ocol4 = (unsigned)(256 * c4 + 4 * lane);
    const unsigned xofs = (unsigned)(size_t)(LAS unsigned char*)F.lds + 132096u + (unsigned)F.wave * 1024u;
    const float mk0 = (g == 0) ? 1.f : 0.f, mk1 = (g == 1) ? 1.f : 0.f, mk2 = (g == 2) ? 1.f : 0.f, mk3 = (g == 3) ? 1.f : 0.f;
    if (cw >= T / 2) return;
    int u = cw;
    struct Ops { unsigned e0, e1, g0, g1; v2u p0, p1, o; };
#define G2_OPS(uu, Q) do { const unsigned tt_ = 2u * (unsigned)(uu) + (unsigned)par, eo_ = (tt_ * 128u + (unsigned)lane) * 4u, po_ = (tt_ * 128u + (unsigned)lane) * 8u, oo_ = (tt_ * 1024u + ocol4) * 2u; \
        ald4(Q.e0, eo_, EI); ald4(Q.e1, eo_ + 256u, EI); ald4(Q.g0, eo_, GT); ald4(Q.g1, eo_ + 256u, GT); ald8(Q.p0, po_, PDp); ald8(Q.p1, po_ + 512u, PDp); \
        ald8(Q.o, oo_, H1p); } while (0)
#define G2_LAND(Q, E0, E1, WA, WB, O0, O1, O2, O3) do { E0 = amov(Q.e0); E1 = amov(Q.e1); const unsigned g0_ = amov(Q.g0), g1_ = amov(Q.g1); v2u a_, b_; a_.x = amov(Q.p0.x); a_.y = amov(Q.p0.y); b_.x = amov(Q.p1.x); b_.y = amov(Q.p1.y); \
        { const unsigned ox_ = amov(Q.o.x), oy_ = amov(Q.o.y); O0 = __uint_as_float(ox_ << 16); O1 = __uint_as_float(ox_ & 0xffff0000u); O2 = __uint_as_float(oy_ << 16); O3 = __uint_as_float(oy_ & 0xffff0000u); } WA = G2_W(g0_, a_); WB = G2_W(g1_, b_); } while (0)
#define G2_W(G, P) (__uint_as_float(G) * gelu_exact((bflo(P.x) + bfhi(P.x)) + (bflo(P.y) + bfhi(P.y))) * W8_SCALE)
#define G2_STAGE(XW, HF) do { _Pragma("unroll") for (int i = 0; i < 8; ++i) asm volatile("ds_write_b128 %0, %1 offset:%2" :: "v"((i & 1) ? wofs1 : wofs0), "v"(XW[i]), "i"((HF) * 8192 + i * 1024) : "memory"); } while (0)
#define G2_TR(dst, addr, off) asm volatile("ds_read_b64_tr_b4 %0, %1 offset:%2" : "=&v"(dst) : "v"(addr), "i"(off) : "memory")
    constexpr float W8_SCALE = 64.f;
    Ops raw; v4u xa[8], xb[8];
    unsigned ea, eb; float wa, wb, o0, o1, o2, o3;
    G2_OPS(u, raw);
    AWAIT(0);
    G2_LAND(raw, ea, eb, wa, wb, o0, o1, o2, o3);
    GROWS(V4, ea, xa); GROWS(V4, eb, xb);
    { const int u1 = (u + ncw < T / 2) ? u + ncw : u; G2_OPS(u1, raw); }
    for (;;) {
        const int un = u + ncw; const bool more = un < T / 2;
        AWAIT(15);
        G2_STAGE(xa, 0);
        AWAIT(7);
        G2_STAGE(xb, 1);
        { const unsigned w8 = (unsigned)__builtin_amdgcn_cvt_pk_fp8_f32(wa, wb, 0, false);
          asm volatile("ds_write_b8 %0, %1\n\tds_write_b8_d16_hi %0, %2 offset:64" :: "v"(wtab + (unsigned)lane), "v"(w8), "v"(w8 << 8) : "memory"); }
        LDS_WAIT();
        AWAIT(0);
        unsigned nea, neb; float nwa, nwb, no0, no1, no2, no3;
        G2_LAND(raw, nea, neb, nwa, nwb, no0, no1, no2, no3);
        GROWS(V4, nea, xa); GROWS(V4, neb, xb);
        { const int u2 = (un + ncw < T / 2) ? un + ncw : u; G2_OPS(u2, raw); }
        const v4u wlo = *(const LAS v4u*)((LAS unsigned char*)F.lds + 131072 + F.wave * 128 + 16 * g), whi = *(const LAS v4u*)((LAS unsigned char*)F.lds + 131072 + F.wave * 128 + 64 + 16 * g);
        const v8i wa8 = {(int)wlo.x, (int)wlo.y, (int)wlo.z, (int)wlo.w, (int)whi.x, (int)whi.y, (int)whi.z, (int)whi.w};
        float r0 = 0.f, r1 = 0.f, r2 = 0.f, r3 = 0.f;
#pragma unroll
        for (int gq = 0; gq < 4; ++gq) {
            v2u bl[4], bh[4];
#pragma unroll
            for (int j = 0; j < 4; ++j) { const int m = 4 * gq + j; G2_TR(bl[j], rc[m >> 1], 8 * (m & 1)); G2_TR(bh[j], rc[m >> 1], 8 * (m & 1) + 2048); }
            asm volatile("s_waitcnt lgkmcnt(0)" ::: "memory"); __builtin_amdgcn_sched_barrier(0);
            float d[4];
#pragma unroll
            for (int j = 0; j < 4; ++j) { const v8i vb = {(int)bl[j].x, (int)bl[j].y, (int)bh[j].x, (int)bh[j].y, 0, 0, 0, 0};
                const f32x4 c_ = __builtin_amdgcn_mfma_scale_f32_16x16x128_f8f6f4(wa8, vb, (f32x4){0.f, 0.f, 0.f, 0.f}, 0, 4, 0, 0x7F7F7F7F, 0, 0x7F7F7F7F); d[j] = c_[0]; }
            const float mk = (gq == 0) ? mk0 : (gq == 1) ? mk1 : (gq == 2) ? mk2 : mk3;
            r0 += d[0] * mk; r1 += d[1] * mk; r2 += d[2] * mk; r3 += d[3] * mk;
            asm volatile("" : "+v"(r0), "+v"(r1), "+v"(r2), "+v"(r3));
            __builtin_amdgcn_sched_barrier(0);
        }
        { constexpr float SC = 1.f / (V4_SCALE * W8_SCALE); const unsigned oo_ = ((2u * (unsigned)u + (unsigned)par) * 1024u + ocol4) * 4u;
          LAS float* xw_ = (LAS float*)(size_t)0 + ((xofs >> 2) + 64 * g + jj); xw_[0] = r0; xw_[16] = r1; xw_[32] = r2; xw_[48] = r3;
          const f32x4 rr = *(const LAS f32x4*)((LAS float*)(size_t)0 + ((xofs >> 2) + 4 * lane));
          v4u st; st.x = __float_as_uint(o0 + rr[0] * SC); st.y = __float_as_uint(o1 + rr[1] * SC); st.z = __float_as_uint(o2 + rr[2] * SC); st.w = __float_as_uint(o3 + rr[3] * SC);
          asm volatile("global_store_dwordx4 %0, %1, %2\n\ts_nop 3" :: "v"(oo_), "v"(st), "s"(OUTp) : "memory"); }
        if (!more) break;
        u = un; wa = nwa; wb = nwb; o0 = no0; o1 = no1; o2 = no2; o3 = no3;
    }
    AWAIT(0);
#undef G2_OPS
#undef G2_LAND
#undef G2_W
#undef G2_STAGE
#undef G2_TR
}
#undef GROWS

#define XB_TMO      128
#define XB_XCNT(j)  (256  + 64 * (j))
#define XB_XSUB(j)  (1280 + 64 * (j))
#define XB_XGEN(j)  (2304 + 64 * (j))
#define XB_TOP      3328
#define XB_TOPGEN   3392
#define XCD_BAR_WORDS 3456
#define XB_SPIN_CAP (1u << 18)

__device__ __forceinline__ unsigned xb_ld(unsigned* p)              { return __hip_atomic_load(p, __ATOMIC_RELAXED, __HIP_MEMORY_SCOPE_AGENT); }
__device__ __forceinline__ unsigned xb_add(unsigned* p, unsigned v) { return __hip_atomic_fetch_add(p, v, __ATOMIC_RELAXED, __HIP_MEMORY_SCOPE_AGENT); }
__device__ __forceinline__ unsigned xb_xcc_id() { return (unsigned)__builtin_amdgcn_s_getreg((3 << 11) | 20) & 0xFu; }
#define XB_SPIN(cond, bar) do { unsigned _sp = 0; while (cond) { __builtin_amdgcn_s_sleep(1); \
    if ((++_sp & 255u) == 0u) { if (xb_ld(&(bar)[XB_TMO])) break; if (_sp > XB_SPIN_CAP) { atomicAdd(&(bar)[XB_TMO], 1u); break; } } } } while (0)

struct XcdBarrier {
    unsigned* bar; unsigned x; int wave;
    volatile LAS unsigned* st;
};

__device__ __forceinline__ XcdBarrier xcd_barrier_post(unsigned* bar, volatile LAS unsigned* st, int wave) {
    XcdBarrier b; b.bar = bar; b.x = xb_xcc_id(); b.st = st; b.wave = wave;
    if (b.wave == 0 && hw_lane() == 0) (void)xb_add(&bar[XB_XCNT(b.x)], 1u);
    return b;
}
__device__ __forceinline__ void xcd_barrier_complete(unsigned* bar, unsigned x, unsigned& nloc, unsigned& nx) {
    const unsigned G = gridDim.x * gridDim.y * gridDim.z;
    unsigned sum, cnt, mine, sp = 0u;
    for (;;) {
        sum = 0u; cnt = 0u; mine = 0u;
#pragma unroll
        for (unsigned j = 0; j < 16; ++j) { const unsigned c = xb_ld(&bar[XB_XCNT(j)]); sum += c; cnt += (c > 0u) ? 1u : 0u; mine = (j == x) ? c : mine; }
        if (sum == G) break;
        __builtin_amdgcn_s_sleep(1);
        if ((++sp & 255u) == 0u) { if (xb_ld(&bar[XB_TMO])) break; if (sp > XB_SPIN_CAP) { atomicAdd(&bar[XB_TMO], 1u); break; } }
    }
    nloc = mine > 0u ? mine : 1u; nx = cnt > 0u ? cnt : 1u;
}

__device__ __forceinline__ void xcd_barrier(const XcdBarrier& b) {
    asm volatile("s_waitcnt vmcnt(0)" ::: "memory");
    __syncthreads();
    if (b.wave == 0 && hw_lane() == 0) {
        unsigned* bar = b.bar;
        __builtin_amdgcn_s_waitcnt(0);
        unsigned nloc = b.st[0], nx = b.st[1];
        if (nloc == 0u) { xcd_barrier_complete(bar, b.x, nloc, nx); b.st[0] = nloc; b.st[1] = nx; }
        const unsigned old = xb_add(&bar[XB_XSUB(b.x)], 1u);
        const unsigned gen = old / nloc;
        if (old + 1u == (gen + 1u) * nloc) {
            __builtin_amdgcn_fence(__ATOMIC_RELEASE, "agent");
            asm volatile("s_waitcnt vmcnt(0)" ::: "memory");
            const unsigned og = xb_add(&bar[XB_TOP], 1u);
            const unsigned tg = og / nx;
            if (og + 1u == (tg + 1u) * nx) xb_add(&bar[XB_TOPGEN], 1u);
            else XB_SPIN(xb_ld(&bar[XB_TOPGEN]) == tg, bar);
            __builtin_amdgcn_fence(__ATOMIC_ACQUIRE, "agent");
            xb_add(&bar[XB_XGEN(b.x)], 1u);
            asm volatile("s_waitcnt vmcnt(0)" ::: "memory");
        } else {
            XB_SPIN(xb_ld(&bar[XB_XGEN(b.x)]) == gen, bar);
            __builtin_amdgcn_fence(__ATOMIC_ACQUIRE, "agent");
            asm volatile("s_waitcnt vmcnt(0)" ::: "memory");
        }
    }
    __syncthreads();
}

constexpr int NPHASE = 11;
__global__ void __launch_bounds__(NTHR, 2) mk_fwd(Args args) {
    extern __shared__ __attribute__((aligned(16))) unsigned char lds[];
    Ctx F;
    F.lds = lds; F.wave = __builtin_amdgcn_readfirstlane((int)threadIdx.x >> 6); F.G = gridDim.x; F.bid = blockIdx.x;
    F.x = args.in[0]; F.g1 = args.in[1]; F.w_in = args.in[2]; F.conv_w = args.in[3]; F.qg = args.in[4]; F.kg = args.in[5]; F.w_o = args.in[6]; F.g2 = args.in[7];
    F.pwq = args.in[8]; F.pk1 = args.in[9]; F.pk2 = args.in[10]; F.pu = args.in[11]; F.pv = args.in[12]; F.out = args.out;
    unsigned char* ws = args.ws;
    F.WIN = (bf16*)(ws + WS_WIN); F.WO = (bf16*)(ws + WS_WO); F.WQ = (bf16*)(ws + WS_WQ); F.K1 = (bf16*)(ws + WS_K1); F.K2 = (bf16*)(ws + WS_K2);
    F.UB = (bf16*)(ws + WS_UB); F.VB = (bf16*)(ws + WS_VB); F.XN = (bf16*)(ws + WS_XN); F.P1 = (bf16*)(ws + WS_P1); F.U = (bf16*)(ws + WS_U);
    F.Q = (bf16*)(ws + WS_Q); F.K = (bf16*)(ws + WS_K); F.V = (bf16*)(ws + WS_V); F.QI = (bf16*)(ws + WS_QI); F.KI = (bf16*)(ws + WS_KI);
    F.SGB = (bf16*)args.out; F.PQ = (bf16*)(ws + WS_PQ); F.WI = (float*)(ws + WS_WI); F.GATE = (float*)(ws + WS_GATE); F.MASK = (unsigned*)(ws + WS_MASK); F.EIDX = (int*)(ws + WS_EIDX); F.PD = (float*)(ws + WS_PQ);
    volatile LAS unsigned* MISC = (volatile LAS unsigned*)((LAS unsigned char*)lds + MISC_OFF);
    if ((F.wave * 64 + hw_lane()) < 64) MISC[(F.wave * 64 + hw_lane())] = 0u;
    __syncthreads();
    XcdBarrier xbar = xcd_barrier_post((unsigned*)(ws + WS_CTL) + CW_BAR, MISC + 8, F.wave);
    if ((F.wave * 64 + hw_lane()) == 0) MISC[16] = xb_add((unsigned*)(ws + WS_CTL) + CW_RANK + 64 * xbar.x, 1u);
    F.cls = F.bid & 7; F.crank = F.bid >> 3; F.cnb = (F.G - F.cls + 7) >> 3;
    const int lo = args.ph_lo, hi = args.ph_hi;
    F.late_jobs = (lo == 0 && hi == NPHASE);
#define IN(k) (lo <= (k) && (k) < hi)
#define SEAM(k) do { if (IN(k) && IN((k) + 1)) { if (hi > NPHASE) cg::this_grid().sync();   else xcd_barrier(xbar); } } while (0)
    PG8_LAS unsigned char* lds3 = (PG8_LAS unsigned char*)lds;
    if (IN(0)) { phase_prologue(F); } SEAM(0);
    if (IN(1)) { pg8::Gemm g{F.XN, F.WIN, T, NPROJ, D}; pg8::StaticOrder S; S.init(T, NPROJ, F.G, F.bid);
        pg8::EpiProj E{F.U, F.P1, F.Q, F.K, F.V, F.QI, F.SGB};
        pg8::gemm_phase<pg8::EpiProj, pg8::StaticOrder, true, true>(lds3, g, S, E, F.wave);
        phase_ki(F); } SEAM(1);
    if (IN(2) && IN(3)) { const int gw_ = F.bid * NWAVES + F.wave, NGW_ = F.G * NWAVES; const size_t gt_ = (size_t)F.bid * NTHR + (F.wave * 64 + hw_lane()), NGT_ = (size_t)F.G * NTHR;
        float* scr_ = (float*)(F.lds + 16384 + F.wave * 8704);
        if (F.wave < 4) { phase_post(F); if (F.late_jobs) { late_weights_job(F, scr_, gw_, NGW_, gt_, NGT_); tables_job(F, gt_, NGT_); } phase_indexer(F); }
        else { phase_indexer(F); phase_post(F); if (F.late_jobs) { late_weights_job(F, scr_, gw_, NGW_, gt_, NGT_); tables_job(F, gt_, NGT_); } } }
    else { if (IN(2)) phase_post(F); if (IN(3)) phase_indexer(F); }
    SEAM(3);
    if (IN(4)) { phase_attn(F); } SEAM(4);
    if (IN(5)) { pg8::Gemm g{F.XN, F.WO, T, D, D}; pg8::StaticOrder S; S.init(T, D, F.G, F.bid);
        pg8::EpiResNorm E{F.x, HB_OF(F), SSQ_OF(F), D};
        pg8::gemm_phase<pg8::EpiResNorm, pg8::StaticOrder, true, true>(lds3, g, S, E, F.wave); } SEAM(5);
    if (IN(7)) { pg8::Gemm g{HB_OF(F), F.WQ, T, 2048, D}; pg8::StaticOrder S; S.init(T, 2048, F.G, F.bid);
        pg8::Unit u0, u1, u2; const bool h0 = S.next(0, u0), h1 = S.next(1, u1), h2 = S.next(2, u2); const bool use_tab = h0 && !h2;
        PG8_LAS float* rtab = (PG8_LAS float*)(lds3 + 140288);
        if (use_tab) { const int slot = (F.wave * 64 + hw_lane()) >> 8, rr = (F.wave * 64 + hw_lane()) & 255; const int upm = slot ? u1.pm : u0.pm, upn = slot ? u1.pn : u0.pn;
            if (slot == 0 || h1) { const int row = upm * 256 + rr; const f32x4* sp = (const f32x4*)(SSQ_OF(F) + (size_t)row * 16); const f32x4 s4 = (sp[0] + sp[1]) + (sp[2] + sp[3]);
                const float r = __builtin_amdgcn_rsqf(((s4[0] + s4[1]) + (s4[2] + s4[3])) * (1.f / 1024.f) + 1e-6f); rtab[slot * 256 + rr] = r; if (upn == 0) RSTD_OF(F)[row] = r; }
            __syncthreads(); }
        pg8::EpiBf16Scale E{F.PQ, 2048, SSQ_OF(F), RSTD_OF(F), rtab, u0.pm, u0.pn, use_tab};
        pg8::gemm_phase<pg8::EpiBf16Scale, pg8::StaticOrder, true, true>(lds3, g, S, E, F.wave); } SEAM(7);
    if (IN(8)) { phase_route(F); } SEAM(8);
    if (IN(9) || IN(10)) {
        unsigned* bw = (unsigned*)(ws + WS_CTL) + CW_BAR; bool ok = (lo == 0);
        for (int j = 0; j < 16; ++j) { const unsigned c = xb_ld(&bw[XB_XCNT(j)]); ok = ok && ((j < 8) ? (c > 0u) : (c == 0u)); }
        if (ok) { F.cls = (int)xbar.x; F.crank = (int)MISC[16]; F.cnb = (int)xb_ld(&bw[XB_XCNT(xbar.x)]); }
    }
    if (IN(9)) { phase_gather_dots(F); } SEAM(9);
    if (IN(10)) { phase_gather_axpy(F); }
#undef IN
#undef SEAM
}

#ifndef MK_ONE_LAUNCH
#define MK_ONE_LAUNCH 1
#endif
extern "C" void kernel_launch(void* const* d_in, const int* in_sizes, int n_in, void* d_out, int out_size, void* d_ws, size_t ws_size, hipStream_t stream) {
    static int grid = 0;
    if (grid == 0) {
        if (n_in != 13 || in_sizes[0] != T * D || out_size != T * D || ws_size < WS_END) { fprintf(stderr, "kernel_launch: unexpected shapes (n_in %d, in0 %d, out %d, ws %zu); nothing launched\n", n_in, n_in > 0 ? in_sizes[0] : -1, out_size, ws_size); grid = -1; return; }
        int dev = 0, cus = 0, per_cu = 0;
        if (hipGetDevice(&dev) != hipSuccess || hipDeviceGetAttribute(&cus, hipDeviceAttributeMultiprocessorCount, dev) != hipSuccess) { fprintf(stderr, "kernel_launch: device query failed\n"); grid = -1; return; }
        if (hipFuncSetAttribute((const void*)mk_fwd, hipFuncAttributeMaxDynamicSharedMemorySize, LDS_BYTES) != hipSuccess) { fprintf(stderr, "kernel_launch: hipFuncSetAttribute failed\n"); grid = -1; return; }
        if (hipOccupancyMaxActiveBlocksPerMultiprocessor(&per_cu, (const void*)mk_fwd, NTHR, LDS_BYTES) != hipSuccess || per_cu < 1) { fprintf(stderr, "kernel_launch: occupancy query says %d blocks per CU\n", per_cu); per_cu = 1; }
        (void)hipGetLastError();
        grid = cus * (per_cu < 1 ? 1 : 1);
    }
    if (grid < 0) return;
    if (hipMemsetAsync((char*)d_ws + WS_CTL, 0, CTL_ZERO_BYTES, stream) != hipSuccess) { fprintf(stderr, "kernel_launch: memset of control words failed\n"); return; }
    Args a{};
    for (int i = 0; i < 13; ++i) a.in[i] = (const float*)d_in[i];
    a.out = (float*)d_out; a.ws = (unsigned char*)d_ws;
#if MK_ONE_LAUNCH
    a.ph_lo = 0; a.ph_hi = NPHASE;
    void* kargs[] = {&a};
    hipError_t e = hipLaunchCooperativeKernel((const void*)mk_fwd, dim3(grid), dim3(NTHR), kargs, LDS_BYTES, stream);
    if (e != hipSuccess) fprintf(stderr, "kernel_launch: cooperative launch failed: %s (grid %d)\n", hipGetErrorString(e), grid);
#else
    for (int p = 0; p < NPHASE; ++p) { a.ph_lo = p; a.ph_hi = p + 1; hipLaunchKernelGGL(mk_fwd, dim3(grid), dim3(NTHR), LDS_BYTES, stream, a); }
#endif
}
```

```cpp
#include <hip/hip_runtime.h>
#include <hip/hip_cooperative_groups.h>
#include <cstdio>
#include <cstdint>
namespace cg = cooperative_groups;

__device__ __forceinline__ int hw_lane() { int l; asm volatile("v_mbcnt_lo_u32_b32 %0, -1, 0\n\tv_mbcnt_hi_u32_b32 %0, -1, %0" : "=v"(l)); return l; }
namespace pg8 {
#define PG8_LAS __attribute__((address_space(3)))
typedef unsigned short bf16_t;
typedef short bf16x8 __attribute__((ext_vector_type(8)));
typedef float f32x4 __attribute__((ext_vector_type(4)));
typedef unsigned u32x4 __attribute__((ext_vector_type(4)));
constexpr int BM = 256, BK = 64, HALF = 128, HTB = HALF * BK * 2  , STAGE_BYTES = 8 * HTB, NXCD = 8, WGM = 8;

__host__ __device__ __forceinline__ int lds_byte(int r, int c) { const int st = (r >> 4) * 2 + (c >> 5), rr = r & 15, cc = c & 31, ob = rr * 64 + cc * 2; return st * 1024 + (ob ^ (((ob >> 9) & 1) << 5)); }
__host__ __device__ __forceinline__ void stage_rc(int b, int& R, int& C) { const int st = b / 1024, sb = b % 1024, swz = sb ^ (((sb >> 9) & 1) << 5); R = (st >> 1) * 16 + swz / 64; C = (st & 1) * 32 + (swz % 64) / 2; }
__host__ __device__ __forceinline__ int perm32(int rho) { const int n = rho >> 4, i = rho & 15; return 8 * (i >> 2) + 4 * n + (i & 3); }

struct Unit { int pm, pn; };
struct Gemm { const bf16_t* A; const bf16_t* Bt; int M, N, K; };

struct StaticOrder {
    int nM, nN, nwg, G, c;
    __host__ __device__ void init(int M, int N, int G_, int c_) { nM = M / BM; nN = N / BM; nwg = nM * nN; G = G_; c = c_; }
    __host__ __device__ __forceinline__ bool next(int i, Unit& u) const {
        const long L = (long)i * G + c; if (L >= nwg) return false;
        int wgid = (int)L; { const int q = nwg / NXCD, r = nwg % NXCD, xcd = wgid % NXCD, off = wgid / NXCD; wgid = (xcd < r ? xcd * (q + 1) : r * (q + 1) + (xcd - r) * q) + off; }
        const int nig = WGM * nN, gid = wgid / nig, fm = gid * WGM, gsz = (nM - fm) < WGM ? (nM - fm) : WGM;
        u.pm = fm + ((wgid % nig) % gsz); u.pn = (wgid % nig) / gsz; return true;
    }
    __device__ __forceinline__ void a_ready(const Unit&) const {}
    __device__ __forceinline__ void done(const Unit&) const {}
};

__device__ __forceinline__ unsigned cvt_pk_bf16(float lo, float hi) { unsigned r; asm volatile("v_cvt_pk_bf16_f32 %0, %1, %2" : "=v"(r) : "v"(lo), "v"(hi)); return r; }
typedef float f32x2 __attribute__((ext_vector_type(2)));
__device__ __forceinline__ float sigm(float x) { return __builtin_amdgcn_rcpf(1.0f + __expf(-x)); }
__device__ __forceinline__ void st8(bf16_t* p, const f32x4& v0, const f32x4& v1) {
    u32x4 w; w.x = cvt_pk_bf16(v0[0], v0[1]); w.y = cvt_pk_bf16(v0[2], v0[3]); w.z = cvt_pk_bf16(v1[0], v1[1]); w.w = cvt_pk_bf16(v1[2], v1[3]); *(u32x4*)p = w; }
__device__ __forceinline__ f32x4 sigm4(const f32x4& v) { return (f32x4){sigm(v[0]), sigm(v[1]), sigm(v[2]), sigm(v[3])}; }
struct EpiProj {
    static constexpr bool PERM = true, AFTER_DRAIN = false;
    bf16_t *U, *P1, *Q, *K, *V, *QI, *SGB;
    __device__ __forceinline__ void operator()(const f32x4 (&acc)[2][2][4][2], const Unit& u, int wr, int wc, int fr, int fq) const {
        const int row0 = u.pm * BM + wr * 64 + fr, pn = u.pn, cw = wc * 32 + 8 * fq;
        if (pn < 16) {
            bf16_t* base = (pn < 8 ? U : P1) + (size_t)(pn & 7) * 128 + cw;
#pragma unroll
            for (int ai = 0; ai < 2; ++ai)
#pragma unroll
                for (int m = 0; m < 4; ++m) {
                    f32x4 a0 = acc[ai][0][m][0], a1 = acc[ai][0][m][1], b0 = acc[ai][1][m][0], b1 = acc[ai][1][m][1];
                    if (pn >= 8) { b0 = sigm4(b0); b1 = sigm4(b1); }
                    st8(base + (size_t)(row0 + ai * HALF + m * 16) * 1024, a0 * b0, a1 * b1); }
        } else if (pn < 22 || (pn >= 24 && pn < 28)) {
            bf16_t* base; int ld; bool sg = false;
            if (pn < 20) { base = Q + (pn - 16) * 256; ld = 1024; }
            else if (pn == 20) { base = K; ld = 256; }
            else if (pn == 21) { base = V; ld = 256; }
            else { base = SGB + (pn - 24) * 256; ld = 1024; sg = true; }
#pragma unroll
            for (int ai = 0; ai < 2; ++ai)
#pragma unroll
                for (int m = 0; m < 4; ++m) { bf16_t* rowp = base + (size_t)(row0 + ai * HALF + m * 16) * ld + cw;
#pragma unroll
                    for (int bj = 0; bj < 2; ++bj) { f32x4 v0 = acc[ai][bj][m][0], v1 = acc[ai][bj][m][1];
                        if (sg) { v0 = sigm4(v0); v1 = sigm4(v1); }
                        st8(rowp + bj * HALF, v0, v1); } }
        } else {
            const bool isx1 = (fq == 0), roped = (((32 * wc + 8 * fq) & 63) < 16);
#pragma unroll
            for (int ai = 0; ai < 2; ++ai)
#pragma unroll
                for (int m = 0; m < 4; ++m) { const int row = row0 + ai * HALF + m * 16; const float pos = (float)(row & 2047);
                    float cs[8], sn[8];
#pragma unroll
                    for (int i = 0; i < 8; ++i) { const float inv = exp2f(-(float)i * (18.931568569324174f / 8.f)), ang = pos * inv; float rev = ang * 0.15915494309189535f; rev -= floorf(rev);
                        sn[i] = __builtin_amdgcn_sinf(rev); cs[i] = __builtin_amdgcn_cosf(rev); }
#pragma unroll
                    for (int bj = 0; bj < 2; ++bj) {
                        f32x4 v0 = acc[ai][bj][m][0], v1 = acc[ai][bj][m][1]; f32x4 o0, o1;
#pragma unroll
                        for (int i = 0; i < 4; ++i) { o0[i] = __shfl_xor(v0[i], 16); o1[i] = __shfl_xor(v1[i], 16); }
                        if (roped) {
#pragma unroll
                            for (int i = 0; i < 4; ++i) { v0[i] = isx1 ? v0[i] * cs[i] - o0[i] * sn[i] : v0[i] * cs[i] + o0[i] * sn[i]; v1[i] = isx1 ? v1[i] * cs[4 + i] - o1[i] * sn[4 + i] : v1[i] * cs[4 + i] + o1[i] * sn[4 + i]; } }
                        st8(QI + (size_t)row * 512 + (pn - 22) * 256 + bj * HALF + cw, v0, v1); } }
        }
    }
};
struct EpiBf16 {
    static constexpr bool PERM = true, AFTER_DRAIN = false;
    bf16_t* O; int ldc;
    __device__ __forceinline__ void operator()(const f32x4 (&acc)[2][2][4][2], const Unit& u, int wr, int wc, int fr, int fq) const {
        const int row0 = u.pm * BM + wr * 64 + fr, col0 = u.pn * BM + wc * 32 + 8 * fq;
#pragma unroll
        for (int ai = 0; ai < 2; ++ai)
#pragma unroll
            for (int m = 0; m < 4; ++m) { bf16_t* rowp = O + (size_t)(row0 + ai * HALF + m * 16) * ldc + col0;
#pragma unroll
                for (int bj = 0; bj < 2; ++bj) st8(rowp + bj * HALF, acc[ai][bj][m][0], acc[ai][bj][m][1]); }
    }
};
struct EpiResF32 {
    static constexpr bool PERM = false, AFTER_DRAIN = false;
    const float* base; float* out; int ldc;
    __device__ __forceinline__ void operator()(const f32x4 (&acc)[2][2][4][2], const Unit& u, int wr, int wc, int fr, int fq) const {
        const int row0 = u.pm * BM + wr * 64 + fr, col0 = u.pn * BM + wc * 32 + 4 * fq;
#pragma unroll
        for (int ai = 0; ai < 2; ++ai)
#pragma unroll
            for (int m = 0; m < 4; ++m) { const size_t off = (size_t)(row0 + ai * HALF + m * 16) * ldc + col0;
#pragma unroll
                for (int bj = 0; bj < 2; ++bj)
#pragma unroll
                    for (int n = 0; n < 2; ++n) { const size_t o = off + bj * HALF + n * 16; *(f32x4*)(out + o) = *(const f32x4*)(base + o) + acc[ai][bj][m][n]; } }
    }
};

__device__ __forceinline__ void epi_ld16(u32x4& d, unsigned off, const void* base) { asm volatile("global_load_dwordx4 %0, %1, %2" : "=&v"(d) : "v"(off), "s"(base) : "memory"); }
__device__ __forceinline__ u32x4 epi_mov4(const u32x4& s) { u32x4 d; asm volatile("v_mov_b32 %0, %4\n\tv_mov_b32 %1, %5\n\tv_mov_b32 %2, %6\n\tv_mov_b32 %3, %7" : "=&v"(d.x), "=&v"(d.y), "=&v"(d.z), "=&v"(d.w) : "v"(s.x), "v"(s.y), "v"(s.z), "v"(s.w)); return d; }
struct EpiResNorm {
    static constexpr bool PERM = false, AFTER_DRAIN = false;
    const float* base; bf16_t* HB; float* SSQ; int ldc;
    __device__ __forceinline__ void operator()(const f32x4 (&acc)[2][2][4][2], const Unit& u, int wr, int wc, int fr, int fq) const {
        const int row0 = u.pm * BM + wr * 64 + fr, col0 = u.pn * BM + wc * 32 + 4 * fq;
        const void* xb = base;
        u32x4 bufA[8], bufB[8];
#define EPI_ISSUE(BUF, G) do { _Pragma("unroll") for (int q_ = 0; q_ < 2; ++q_) { const int rg_ = 2 * (G) + q_, row_ = row0 + (rg_ >> 2) * HALF + (rg_ & 3) * 16; \
            _Pragma("unroll") for (int bj = 0; bj < 2; ++bj) _Pragma("unroll") for (int n = 0; n < 2; ++n) epi_ld16(BUF[q_ * 4 + bj * 2 + n], (unsigned)(row_ * ldc + col0 + bj * HALF + n * 16) * 4u, xb); } } while (0)
#define EPI_PROC(BUF, G) do { _Pragma("unroll") for (int q_ = 0; q_ < 2; ++q_) { const int rg_ = 2 * (G) + q_, ai = rg_ >> 2, m = rg_ & 3, row = row0 + ai * HALF + m * 16; const size_t off = (size_t)row * ldc + col0; float ss = 0.f; \
            _Pragma("unroll") for (int bj = 0; bj < 2; ++bj) _Pragma("unroll") for (int n = 0; n < 2; ++n) { const size_t o = off + bj * HALF + n * 16; const u32x4 xw_ = epi_mov4(BUF[q_ * 4 + bj * 2 + n]); \
                const f32x4 v = __builtin_bit_cast(f32x4, xw_) + acc[ai][bj][m][n]; \
                ss += (v[0] * v[0] + v[1] * v[1]) + (v[2] * v[2] + v[3] * v[3]); \
                f32x2 w; w.x = __builtin_bit_cast(float, cvt_pk_bf16(v[0], v[1])); w.y = __builtin_bit_cast(float, cvt_pk_bf16(v[2], v[3])); *(f32x2*)(HB + o) = w; } \
            ss += __shfl_xor(ss, 16); ss += __shfl_xor(ss, 32); \
            if (fq == 0) SSQ[(size_t)row * 16 + u.pn * 4 + wc] = ss; } } while (0)
#define EPI_WAIT(N) asm volatile("s_waitcnt vmcnt(" #N ")" ::: "memory")
        EPI_ISSUE(bufA, 0); EPI_ISSUE(bufB, 1);
        EPI_WAIT(8); EPI_PROC(bufA, 0); EPI_ISSUE(bufA, 2);
        EPI_WAIT(8); EPI_PROC(bufB, 1); EPI_ISSUE(bufB, 3);
        EPI_WAIT(8); EPI_PROC(bufA, 2);
        EPI_WAIT(0); EPI_PROC(bufB, 3);
#undef EPI_ISSUE
#undef EPI_PROC
#undef EPI_WAIT
    }
};
struct EpiBf16Scale {
    static constexpr bool PERM = true, AFTER_DRAIN = false;
    bf16_t* O; int ldc; const float* SSQ; float* RSTD; const PG8_LAS float* tab; int pm0, pn0; bool use_tab;
    __device__ __forceinline__ void operator()(const f32x4 (&acc)[2][2][4][2], const Unit& u, int wr, int wc, int fr, int fq) const {
        const int row0 = u.pm * BM + wr * 64 + fr, col0 = u.pn * BM + wc * 32 + 8 * fq;
        const PG8_LAS float* tb = tab + ((u.pm == pm0 && u.pn == pn0) ? 0 : 256) + wr * 64 + fr;
#pragma unroll
        for (int ai = 0; ai < 2; ++ai)
#pragma unroll
            for (int m = 0; m < 4; ++m) { const int row = row0 + ai * HALF + m * 16; float r;
                if (use_tab) r = tb[ai * HALF + m * 16];
                else { const f32x4* sp = (const f32x4*)(SSQ + (size_t)row * 16); const f32x4 s4 = (sp[0] + sp[1]) + (sp[2] + sp[3]); r = __builtin_amdgcn_rsqf(((s4[0] + s4[1]) + (s4[2] + s4[3])) * (1.f / 1024.f) + 1e-6f);
                    if (u.pn == 0 && wc == 0 && fq == 0) RSTD[row] = r; }
#pragma unroll
                for (int bj = 0; bj < 2; ++bj) { const int dim = wc * 32 + 8 * fq + bj * HALF;
                    st8(O + (((((size_t)(row >> 5) * 8 + u.pn) * 16 + (dim >> 4)) * 64 + ((dim >> 3) & 1) * 32 + (row & 31)) * 8), acc[ai][bj][m][0] * r, acc[ai][bj][m][1] * r); } }
    }
};

template <class Epi, class Sched, bool ALIGN_EPI = false, bool SP2 = false>
__device__ __forceinline__ void gemm_phase(PG8_LAS unsigned char* lds, const Gemm g, const Sched& S, const Epi& E, const int wid) {
    const int lane = hw_lane(), tid = wid * 64 + lane, wr = wid >> 2, wc = wid & 3, fr = lane & 15, fq = lane >> 4;
    const int K = g.K, nt = K / BK;
    unsigned voffA[2], voffB[2];
#pragma unroll
    for (int i = 0; i < 2; ++i) { int R, C; stage_rc(tid * 16 + i * 8192, R, C); const int Rb = Epi::PERM ? ((R & ~31) + perm32(R & 31)) : R;
        voffA[i] = (unsigned)(R * K + C) * 2u; voffB[i] = (unsigned)(Rb * K + C) * 2u; }
    const size_t kstep = (size_t)(BK * 2);
    const size_t hstep = (size_t)HALF * K * 2;
    const size_t tstep = 2 * hstep;
    const unsigned ldsw = (unsigned)wid * 1024u;
    const int aoff = lds_byte(wr * 64 + fr, fq * 8), boff = lds_byte(wc * 32 + fr, fq * 8);
#define PG8_SA(b, h) (((b) * 2 + (h)) * HTB)
#define PG8_SB(b, h) ((4 + (b) * 2 + (h)) * HTB)
#define PG8_STAGE(bufoff, gbase, voff) do { _Pragma("unroll") for (int _i = 0; _i < 2; ++_i) \
        __builtin_amdgcn_global_load_lds((const unsigned*)((const char*)(gbase) + (voff)[_i]), (PG8_LAS unsigned*)(lds + (bufoff) + ldsw + _i * 8192), 16, 0, 0); } while (0)
#define PG8_LDA(dst, b, h) do { _Pragma("unroll") for (int m = 0; m < 4; ++m) _Pragma("unroll") for (int k = 0; k < 2; ++k) dst[m][k] = *(const PG8_LAS bf16x8*)(lds + PG8_SA(b, h) + aoff + m * 2048 + k * 1024); } while (0)
#define PG8_LDB(dst, b, h) do { _Pragma("unroll") for (int n = 0; n < 2; ++n) _Pragma("unroll") for (int k = 0; k < 2; ++k) dst[n][k] = *(const PG8_LAS bf16x8*)(lds + PG8_SB(b, h) + boff + n * 2048 + k * 1024); } while (0)
#define PG8_MMA(ai, bj, At, Bt) do { __builtin_amdgcn_s_setprio(1); _Pragma("unroll") for (int m = 0; m < 4; ++m) _Pragma("unroll") for (int n = 0; n < 2; ++n) _Pragma("unroll") for (int k = 0; k < 2; ++k) \
        acc[ai][bj][m][n] = __builtin_amdgcn_mfma_f32_16x16x32_bf16(Bt[n][k], At[m][k], acc[ai][bj][m][n], 0, 0, 0); __builtin_amdgcn_s_setprio(0); } while (0)
#define PG8_WAIT_V(n) asm volatile("s_waitcnt vmcnt(" #n ")" ::: "memory")
#define PG8_WAIT_L(n) asm volatile("s_waitcnt lgkmcnt(" #n ")" ::: "memory")
#define PG8_BAR __builtin_amdgcn_s_barrier()
#define PG8_SCHED __builtin_amdgcn_sched_barrier(0)
    Unit cur, nxt; int ui = 0;
    if (!S.next(0, cur)) return;
    f32x4 acc[2][2][4][2];
#pragma unroll
    for (int a = 0; a < 2; ++a)
#pragma unroll
        for (int b = 0; b < 2; ++b)
#pragma unroll
            for (int m = 0; m < 4; ++m)
#pragma unroll
                for (int n = 0; n < 2; ++n) acc[a][b][m][n] = (f32x4){0.f, 0.f, 0.f, 0.f};
    bf16x8 At[4][2], B0[2][2], B1[2][2];
    const char* cA = (const char*)g.A + (size_t)cur.pm * tstep; const char* cB = (const char*)g.Bt + (size_t)cur.pn * tstep;
    S.a_ready(cur);
    if constexpr (SP2) {
        PG8_STAGE(PG8_SB(0, 0), cB, voffB); PG8_STAGE(PG8_SB(0, 1), cB + hstep, voffB); PG8_STAGE(PG8_SA(0, 0), cA, voffA); PG8_STAGE(PG8_SA(0, 1), cA + hstep, voffA);
        if (wr == 1) PG8_BAR;
        PG8_WAIT_V(2); PG8_BAR;
        PG8_STAGE(PG8_SB(1, 0), cB + kstep, voffB); PG8_STAGE(PG8_SA(1, 0), cA + kstep, voffA); PG8_STAGE(PG8_SB(1, 1), cB + hstep + kstep, voffB);
        PG8_WAIT_V(6); PG8_BAR;
    } else {
        PG8_STAGE(PG8_SB(0, 0), cB, voffB); PG8_STAGE(PG8_SA(0, 0), cA, voffA); PG8_STAGE(PG8_SB(0, 1), cB + hstep, voffB); PG8_STAGE(PG8_SA(0, 1), cA + hstep, voffA);
        if (wr == 1) PG8_BAR;
        PG8_WAIT_V(4); PG8_BAR;
        PG8_STAGE(PG8_SB(1, 0), cB + kstep, voffB); PG8_STAGE(PG8_SA(1, 0), cA + kstep, voffA); PG8_STAGE(PG8_SB(1, 1), cB + hstep + kstep, voffB);
        PG8_WAIT_V(6); PG8_BAR;
    }
    for (;;) {
        const bool has_next = S.next(ui + 1, nxt);
        const char* nA = has_next ? (const char*)g.A + (size_t)nxt.pm * tstep : cA; const char* nB = has_next ? (const char*)g.Bt + (size_t)nxt.pn * tstep : cB;
        for (int t = 0; t < nt; t += 2) {
            const bool last = (t == nt - 2);
            const char* a1 = cA + (size_t)(t + 1) * kstep;
            const char* a2 = last ? nA : cA + (size_t)(t + 2) * kstep; const char* b2 = last ? nB : cB + (size_t)(t + 2) * kstep;
            const char* a3 = a2 + kstep; const char* b3 = b2 + kstep;
            if (last && has_next) S.a_ready(nxt);
            if constexpr (SP2) {
            PG8_LDB(B0, 0, 0); PG8_LDB(B1, 0, 1); PG8_SCHED; PG8_LDA(At, 0, 0); PG8_STAGE(PG8_SA(1, 1), a1 + hstep, voffA);
            PG8_WAIT_V(8); PG8_WAIT_L(0); PG8_BAR; PG8_MMA(0, 0, At, B0); PG8_MMA(0, 1, At, B1); PG8_BAR; PG8_SCHED;
            PG8_LDA(At, 0, 1); PG8_STAGE(PG8_SB(0, 0), b2, voffB); PG8_STAGE(PG8_SB(0, 1), b2 + hstep, voffB); PG8_STAGE(PG8_SA(0, 0), a2, voffA);
            PG8_WAIT_V(8); PG8_WAIT_L(0); PG8_BAR; PG8_MMA(1, 0, At, B0); PG8_MMA(1, 1, At, B1); PG8_BAR; PG8_SCHED;
            PG8_LDB(B0, 1, 0); PG8_LDB(B1, 1, 1); PG8_SCHED; PG8_LDA(At, 1, 0); PG8_STAGE(PG8_SA(0, 1), a2 + hstep, voffA);
            PG8_WAIT_V(8); PG8_WAIT_L(0); PG8_BAR; PG8_MMA(0, 0, At, B0); PG8_MMA(0, 1, At, B1); PG8_BAR; PG8_SCHED;
            PG8_LDA(At, 1, 1); PG8_STAGE(PG8_SB(1, 0), b3, voffB); PG8_STAGE(PG8_SB(1, 1), b3 + hstep, voffB); PG8_STAGE(PG8_SA(1, 0), a3, voffA);
            PG8_WAIT_V(8); PG8_WAIT_L(0); PG8_BAR; PG8_MMA(1, 0, At, B0); PG8_MMA(1, 1, At, B1); PG8_BAR; PG8_SCHED;
            } else {
            PG8_LDB(B0, 0, 0); PG8_SCHED; PG8_LDA(At, 0, 0); PG8_STAGE(PG8_SA(1, 1), a1 + hstep, voffA);
            PG8_WAIT_L(8); PG8_BAR; PG8_WAIT_L(0); PG8_MMA(0, 0, At, B0); PG8_BAR; PG8_SCHED;
            PG8_LDB(B1, 0, 1); PG8_STAGE(PG8_SB(0, 0), b2, voffB);
            PG8_BAR; PG8_WAIT_L(0); PG8_MMA(0, 1, At, B1); PG8_BAR;
            PG8_LDA(At, 0, 1); PG8_STAGE(PG8_SA(0, 0), a2, voffA);
            PG8_BAR; PG8_WAIT_L(0); PG8_MMA(1, 0, At, B0); PG8_BAR; PG8_SCHED;
            PG8_STAGE(PG8_SB(0, 1), b2 + hstep, voffB);
            PG8_WAIT_V(6); PG8_BAR; PG8_MMA(1, 1, At, B1); PG8_BAR;
            PG8_LDB(B0, 1, 0); PG8_SCHED; PG8_LDA(At, 1, 0); PG8_STAGE(PG8_SA(0, 1), a2 + hstep, voffA);
            PG8_WAIT_L(8); PG8_BAR; PG8_WAIT_L(0); PG8_MMA(0, 0, At, B0); PG8_BAR; PG8_SCHED;
            PG8_LDB(B1, 1, 1); PG8_STAGE(PG8_SB(1, 0), b3, voffB);
            PG8_BAR; PG8_WAIT_L(0); PG8_MMA(0, 1, At, B1); PG8_BAR;
            PG8_LDA(At, 1, 1); PG8_STAGE(PG8_SA(1, 0), a3, voffA);
            PG8_BAR; PG8_WAIT_L(0); PG8_MMA(1, 0, At, B0); PG8_BAR; PG8_SCHED;
            PG8_STAGE(PG8_SB(1, 1), b3 + hstep, voffB);
            PG8_WAIT_V(6); PG8_BAR; PG8_MMA(1, 1, At, B1); PG8_BAR;
            }
        }
        if constexpr (ALIGN_EPI) { if (wr == 0) PG8_BAR; }
        if constexpr (!Epi::AFTER_DRAIN) { E(acc, cur, wr, wc, fr, fq); S.done(cur); }
        if (!has_next) break;
#pragma unroll
        for (int a = 0; a < 2; ++a)
#pragma unroll
            for (int b = 0; b < 2; ++b)
#pragma unroll
                for (int m = 0; m < 4; ++m)
#pragma unroll
                    for (int n = 0; n < 2; ++n) acc[a][b][m][n] = (f32x4){0.f, 0.f, 0.f, 0.f};
        cur = nxt; cA = nA; cB = nB; ++ui;
        if constexpr (ALIGN_EPI) { if (wr == 1) PG8_BAR; }
    }
    PG8_WAIT_V(0);
    if constexpr (!ALIGN_EPI) { if (wr == 0) PG8_BAR; }
    PG8_BAR;
    if constexpr (Epi::AFTER_DRAIN) { E.fused(acc, cur, wr, wc, fr, fq, lds, wid, lane); S.done(cur); }
#undef PG8_SA
#undef PG8_SB
#undef PG8_STAGE
#undef PG8_LDA
#undef PG8_LDB
#undef PG8_MMA
#undef PG8_WAIT_V
#undef PG8_WAIT_L
#undef PG8_BAR
#undef PG8_SCHED
}
}
constexpr int T = 16384, D = 1024, SEQ = 2048, NBATCH = 8;
constexpr int NPROJ = 7168;
constexpr int NPROJ_T = 7264;
constexpr float EPS = 1e-6f;
constexpr float ATTN_SCALE = 0.08838834764831845f, IDX_SCALE = 0.125f, IDX_W_SCALE = 0.35355339059327373f;
constexpr float LOG2_THETA = 18.931568569324174f;
constexpr int NWAVES = 8, NTHR = 512;

constexpr size_t MiB = 1u << 20;
constexpr size_t WS_CTL = 0, CTL_ZERO_BYTES = 64 * 1024;
constexpr size_t WS_WIN = 1 * MiB;
constexpr size_t WS_WO = 16 * MiB;
constexpr size_t WS_WQ = 18 * MiB;
constexpr size_t WS_K1 = 22 * MiB, WS_K2 = WS_K1 + 256 * 1024;
constexpr size_t WS_UB = 24 * MiB, WS_VB = 56 * MiB;
constexpr size_t WS_XN = 88 * MiB;
constexpr size_t WS_P1 = 120 * MiB;
constexpr size_t WS_U = 152 * MiB;
constexpr size_t WS_Q = 184 * MiB;
constexpr size_t WS_K = 216 * MiB, WS_V = 224 * MiB;
constexpr size_t WS_QI = 232 * MiB;
constexpr size_t WS_KI = 248 * MiB;
constexpr size_t WS_WI = 250 * MiB;
constexpr size_t WS_MASK = 251 * MiB;
constexpr size_t WS_END = 256 * MiB;
constexpr size_t WS_PQ = 120 * MiB;
constexpr size_t WS_EIDX = 184 * MiB, WS_GATE = 192 * MiB;

constexpr int LDS_BYTES = 147456;
constexpr int MISC_OFF = 147456 - 256;
constexpr int CW_RANK = 8192;
constexpr int CW_BAR = 1024;

#define LAS __attribute__((address_space(3)))
typedef unsigned short bf16;
typedef unsigned v4u __attribute__((ext_vector_type(4)));
typedef unsigned v2u __attribute__((ext_vector_type(2)));
typedef float f32x4 __attribute__((ext_vector_type(4)));
typedef __bf16 bf16x2_t __attribute__((ext_vector_type(2)));

__device__ __forceinline__ unsigned f2bf(float f) { unsigned u = __builtin_bit_cast(unsigned, f); return (u + 0x7fffu + ((u >> 16) & 1u)) >> 16; }
__device__ __forceinline__ unsigned pk2(float lo, float hi) { return f2bf(lo) | (f2bf(hi) << 16); }
__device__ __forceinline__ float bflo(unsigned w) { return __builtin_bit_cast(float, w << 16); }
__device__ __forceinline__ float bfhi(unsigned w) { return __builtin_bit_cast(float, w & 0xffff0000u); }
__device__ __forceinline__ float bf1(bf16 h) { return __builtin_bit_cast(float, (unsigned)h << 16); }
__device__ __forceinline__ float dot2bf(unsigned a, unsigned b, float acc) { return __builtin_amdgcn_fdot2_f32_bf16(__builtin_bit_cast(bf16x2_t, a), __builtin_bit_cast(bf16x2_t, b), acc, false); }
#define DPP_XOR1 0xB1
#define DPP_XOR2 0x4E
#define DPP_ROR(n) (0x120 + (n))
__device__ __forceinline__ float wave_sum(float v) {
#pragma unroll
    for (int o = 1; o < 64; o <<= 1) v += __shfl_xor(v, o);
    return v; }
__device__ __forceinline__ float wave_max(float v) {
#pragma unroll
    for (int o = 1; o < 64; o <<= 1) v = fmaxf(v, __shfl_xor(v, o));
    return v; }
__device__ __forceinline__ int wave_sumi(int v) {
#pragma unroll
    for (int o = 1; o < 64; o <<= 1) v += __shfl_xor(v, o);
    return v; }
__device__ __forceinline__ int wave_mini(int v) {
#pragma unroll
    for (int o = 1; o < 64; o <<= 1) v = min(v, __shfl_xor(v, o));
    return v; }
__device__ __forceinline__ int wave_incl_scan(int v, int lane) {
#pragma unroll
    for (int o = 1; o < 64; o <<= 1) { const int x = __shfl_up(v, o); if (lane >= o) v += x; }
    return v; }
#define LDS_WAIT() asm volatile("s_waitcnt lgkmcnt(0)" ::: "memory")

struct Args { const float* in[13]; float* out; unsigned char* ws; int ph_lo, ph_hi; };

struct Ctx {
    unsigned char* lds; int wave, G, bid;
    const float *x, *g1, *w_in, *conv_w, *qg, *kg, *w_o, *g2, *pwq, *pk1, *pk2, *pu, *pv; float* out;
    bf16 *WIN, *WO, *WQ, *K1, *K2, *UB, *VB, *XN, *P1, *U, *Q, *K, *V, *QI, *KI, *SGB, *PQ;
    float *WI, *GATE, *PD; unsigned* MASK; int* EIDX;
    bool late_jobs;
    int cls, crank, cnb;
};

#define HB_OF(F) ((bf16*)((unsigned char*)(F).Q + 16 * MiB))
#define SSQ_OF(F) ((float*)((unsigned char*)(F).MASK + 4 * MiB))
#define RSTD_OF(F) ((float*)((unsigned char*)(F).K1 + 512 * 1024))
__device__ __forceinline__ int win_src_col(int n) {
    if (n < 2048) { const int ch = ((n >> 8) << 7) + (n & 127); return ((n >> 7) & 1) ? 2048 + ch : 1024 + ch; }
    if (n < 4096) { const int m = n - 2048, ch = ((m >> 8) << 7) + (m & 127); return ((m >> 7) & 1) ? 5192 + ch : ch; }
    if (n < 5120) return 3072 + (n - 4096);
    if (n < 5376) return 4096 + (n - 5120);
    if (n < 5632) return 4352 + (n - 5376);
    if (n < 6144) return 4608 + (n - 5632);
    if (n < 7168) return 6216 + (n - 6144);
    if (n < 7232) return 5120 + (n - 7168);
    if (n < 7240) return 5184 + (n - 7232);
    return -1;
}

template <bool MAPPED, bool GAIN = false>
__device__ __forceinline__ void transpose_item(const float* W, int K, int N, bf16* WT, float* scr, int item, int nblk, int lane, const float* gain = nullptr) {
    const int kb = item / nblk, nb = item % nblk, k0 = 64 * kb, n0 = 32 * nb;
    int src = n0 + (lane & 31); if (MAPPED) src = win_src_col(src);
    float tv[32];
#pragma unroll
    for (int i = 0; i < 32; ++i) { const int kk = 2 * i + (lane >> 5); tv[i] = (src >= 0) ? W[(size_t)(k0 + kk) * N + src] : 0.f; }
#pragma unroll
    for (int i = 0; i < 32; ++i) { const int kk = 2 * i + (lane >> 5); scr[kk * 33 + (lane & 31)] = tv[i]; }
    LDS_WAIT(); asm volatile("" ::: "memory");
    const int c = lane & 7;
    f32x4 ga = {1.f, 1.f, 1.f, 1.f}, gb = ga; if (GAIN) { ga = *(const f32x4*)(gain + k0 + 8 * c); gb = *(const f32x4*)(gain + k0 + 8 * c + 4); }
#pragma unroll
    for (int j = 0; j < 4; ++j) { const int n = (lane >> 3) + 8 * j; const float* s = scr + (8 * c) * 33 + n;
        v4u o; o.x = pk2(s[0 * 33] * ga[0], s[1 * 33] * ga[1]); o.y = pk2(s[2 * 33] * ga[2], s[3 * 33] * ga[3]); o.z = pk2(s[4 * 33] * gb[0], s[5 * 33] * gb[1]); o.w = pk2(s[6 * 33] * gb[2], s[7 * 33] * gb[3]);
        size_t wo = (size_t)(n0 + n) * K + k0 + 8 * c;
        if (MAPPED && n0 >= NPROJ) { const int nr = n0 + n - NPROJ, kc = (k0 >> 3) + c;
            wo = (size_t)NPROJ * K + ((((size_t)(nr >> 4) * 32 + (kc >> 2)) * 64 + (kc & 3) * 16 + (nr & 15)) * 8); }
        *(v4u*)(WT + wo) = o; }
    LDS_WAIT(); asm volatile("" ::: "memory");
}
__device__ __forceinline__ void cvt8(const float* src, bf16* dst, size_t i) {
    const f32x4 a = *(const f32x4*)(src + i), b = *(const f32x4*)(src + i + 4);
    v4u o; o.x = pk2(a[0], a[1]); o.y = pk2(a[2], a[3]); o.z = pk2(b[0], b[1]); o.w = pk2(b[2], b[3]); *(v4u*)(dst + i) = o;
}
constexpr float U8_SCALE = 64.f, V8_SCALE = 8.f;
__device__ __forceinline__ size_t tbl8_off(size_t c16) { const size_t e = c16 >> 6, q = c16 & 63; return (q >> 3) * (size_t)(16384 * 128) + e * 128 + (q & 7) * 16; }
__device__ __forceinline__ unsigned pk4_fp8(const f32x4& a, float s) { int p = 0; p = __builtin_amdgcn_cvt_pk_fp8_f32(a[0] * s, a[1] * s, p, false); p = __builtin_amdgcn_cvt_pk_fp8_f32(a[2] * s, a[3] * s, p, true); return (unsigned)p; }
__device__ __forceinline__ void cvt16_fp8(const float* src, unsigned char* dst, size_t i, float s) {
    const f32x4 a = *(const f32x4*)(src + i), b = *(const f32x4*)(src + i + 4), c = *(const f32x4*)(src + i + 8), d = *(const f32x4*)(src + i + 12);
    v4u o; o.x = pk4_fp8(a, s); o.y = pk4_fp8(b, s); o.z = pk4_fp8(c, s); o.w = pk4_fp8(d, s); *(v4u*)(dst + i) = o;
}
__device__ __forceinline__ void rms_row2_to_bf16(const float* xrow0, const float* xrow1, const float* g, bf16* orow0, bf16* orow1, int lane) {
    const f32x4* xa = (const f32x4*)xrow0 + lane; const f32x4* xb = (const f32x4*)xrow1 + lane; f32x4 va[4], vb[4]; float sa = 0.f, sb = 0.f;
#pragma unroll
    for (int j = 0; j < 4; ++j) { va[j] = xa[64 * j]; vb[j] = xb[64 * j]; }
#pragma unroll
    for (int j = 0; j < 4; ++j) { sa += (va[j].x * va[j].x + va[j].y * va[j].y) + (va[j].z * va[j].z + va[j].w * va[j].w); sb += (vb[j].x * vb[j].x + vb[j].y * vb[j].y) + (vb[j].z * vb[j].z + vb[j].w * vb[j].w); }
#pragma unroll
    for (int o = 1; o < 64; o <<= 1) { sa += __shfl_xor(sa, o); sb += __shfl_xor(sb, o); }
    const float ra = rsqrtf(sa * (1.f / 1024.f) + EPS), rb = rsqrtf(sb * (1.f / 1024.f) + EPS);
    v2u* oa = (v2u*)orow0 + lane; v2u* ob = (v2u*)orow1 + lane;
#pragma unroll
    for (int j = 0; j < 4; ++j) { const f32x4 gv = ((const f32x4*)g)[lane + 64 * j]; v2u w;
        w.x = pk2(va[j].x * ra * gv.x, va[j].y * ra * gv.y); w.y = pk2(va[j].z * ra * gv.z, va[j].w * ra * gv.w); oa[64 * j] = w;
        w.x = pk2(vb[j].x * rb * gv.x, vb[j].y * rb * gv.y); w.y = pk2(vb[j].z * rb * gv.z, vb[j].w * rb * gv.w); ob[64 * j] = w; }
}
__device__ __forceinline__ void rms_rows(const float* X, const float* g, bf16* O, int gw, int NGW, int lane) {
    f32x4 gq[4];
#pragma unroll
    for (int q = 0; q < 4; ++q) gq[q] = ((const f32x4*)g)[lane + 64 * q];
    for (int m0 = gw; m0 < T; m0 += 4 * NGW) {
        int mr[4]; f32x4 v[4][4]; float ss[4];
#pragma unroll
        for (int j = 0; j < 4; ++j) { mr[j] = (m0 + j * NGW < T) ? m0 + j * NGW : m0; const f32x4* xr = (const f32x4*)(X + (size_t)mr[j] * D) + lane;
#pragma unroll
            for (int q = 0; q < 4; ++q) v[j][q] = xr[64 * q]; }
#pragma unroll
        for (int j = 0; j < 4; ++j) { float s = 0.f;
#pragma unroll
            for (int q = 0; q < 4; ++q) s += (v[j][q].x * v[j][q].x + v[j][q].y * v[j][q].y) + (v[j][q].z * v[j][q].z + v[j][q].w * v[j][q].w);
            ss[j] = s; }
#pragma unroll
        for (int o = 1; o < 64; o <<= 1) {
#pragma unroll
            for (int j = 0; j < 4; ++j) ss[j] += __shfl_xor(ss[j], o); }
#pragma unroll
        for (int j = 0; j < 4; ++j) { const float r = rsqrtf(ss[j] * (1.f / 1024.f) + EPS); v2u* op = (v2u*)(O + (size_t)mr[j] * D) + lane;
#pragma unroll
            for (int q = 0; q < 4; ++q) { const f32x4 gv = gq[q]; v2u w;
                w.x = pk2(v[j][q].x * r * gv.x, v[j][q].y * r * gv.y); w.y = pk2(v[j][q].z * r * gv.z, v[j][q].w * r * gv.w); op[64 * q] = w; } }
    }
}
__device__ __forceinline__ void rms_row_to_bf16(const float* xrow, const float* g, bf16* orow, int lane) {
    const f32x4* xr = (const f32x4*)xrow + lane; f32x4 v[4]; float s = 0.f;
#pragma unroll
    for (int j = 0; j < 4; ++j) { v[j] = xr[64 * j]; s += (v[j].x * v[j].x + v[j].y * v[j].y) + (v[j].z * v[j].z + v[j].w * v[j].w); }
    const float rstd = rsqrtf(wave_sum(s) * (1.f / 1024.f) + EPS);
    v2u* o8 = (v2u*)orow + lane;
#pragma unroll
    for (int j = 0; j < 4; ++j) { const f32x4 gv = ((const f32x4*)g)[lane + 64 * j]; v2u w; w.x = pk2(v[j].x * rstd * gv.x, v[j].y * rstd * gv.y); w.y = pk2(v[j].z * rstd * gv.z, v[j].w * rstd * gv.w); o8[64 * j] = w; }
}
constexpr float U4_SCALE = 64.f, V4_SCALE = 5.656854249f;
__device__ __forceinline__ size_t tbl4_off(size_t c32) { const size_t e = c32 >> 5, q = c32 & 31; return (q >> 3) * (size_t)(16384 * 128) + e * 128 + (q & 7) * 16; }
__device__ __forceinline__ unsigned pk8_fp4(const f32x4& a, const f32x4& b, float s) { unsigned p = 0;
    p = __builtin_amdgcn_cvt_scalef32_pk_fp4_f32(p, a[0] * s, a[1] * s, 1.0f, 0); p = __builtin_amdgcn_cvt_scalef32_pk_fp4_f32(p, a[2] * s, a[3] * s, 1.0f, 1);
    p = __builtin_amdgcn_cvt_scalef32_pk_fp4_f32(p, b[0] * s, b[1] * s, 1.0f, 2); p = __builtin_amdgcn_cvt_scalef32_pk_fp4_f32(p, b[2] * s, b[3] * s, 1.0f, 3); return p; }
template <bool DO_U = true, bool DO_V = true> __device__ __forceinline__ void tables_job(Ctx& F, size_t gt, size_t NGT) {
    const int lane = (int)(gt & 63); const size_t wv = gt >> 6, NWV = NGT >> 6;
    constexpr size_t NIT = (size_t)16384 * 4;
    f32x4 gc[4];
#pragma unroll
    for (int c = 0; c < 4; ++c) gc[c] = *(const f32x4*)(F.g2 + c * 256 + lane * 4);
    for (size_t i0 = wv; i0 < NIT; i0 += 8 * NWV) {
        size_t it[8]; f32x4 a[8] = {}, b[8] = {};
#pragma unroll
        for (int j = 0; j < 8; ++j) { it[j] = (i0 + j * NWV < NIT) ? i0 + j * NWV : i0; const size_t src = it[j] * 256 + lane * 4;
            if (DO_U) a[j] = *(const f32x4*)(F.pu + src); if (DO_V) b[j] = *(const f32x4*)(F.pv + src); }
#pragma unroll
        for (int j = 0; j < 8; ++j) { const size_t e = it[j] >> 2, c = it[j] & 3; const size_t dst = c * (size_t)(16384 * 128) + e * 128 + lane * 2;
            const f32x4 gq = (c == 0) ? gc[0] : (c == 1) ? gc[1] : (c == 2) ? gc[2] : gc[3]; f32x4 au = {}; if (DO_U) au = a[j] * gq;
            unsigned pu4 = 0, pv4 = 0;
            if (DO_U) { pu4 = __builtin_amdgcn_cvt_scalef32_pk_fp4_f32(pu4, au[0] * U4_SCALE, au[1] * U4_SCALE, 1.0f, 0); pu4 = __builtin_amdgcn_cvt_scalef32_pk_fp4_f32(pu4, au[2] * U4_SCALE, au[3] * U4_SCALE, 1.0f, 1); }
            if (DO_V) { pv4 = __builtin_amdgcn_cvt_scalef32_pk_fp4_f32(pv4, b[j][0] * V4_SCALE, b[j][1] * V4_SCALE, 1.0f, 0); pv4 = __builtin_amdgcn_cvt_scalef32_pk_fp4_f32(pv4, b[j][2] * V4_SCALE, b[j][3] * V4_SCALE, 1.0f, 1); }
            if (DO_U) *(unsigned short*)((unsigned char*)F.UB + dst) = (unsigned short)pu4; if (DO_V) *(unsigned short*)((unsigned char*)F.VB + dst) = (unsigned short)pv4; }
    }
}
__device__ __forceinline__ void late_weights_job(Ctx& F, float* scr, int gw, int NGW, size_t gt, size_t NGT) {
    constexpr int I_O = 16 * 32, I_Q = 16 * 64;
    for (int it = gw; it < I_O + I_Q; it += NGW) {
        if (it < I_O) transpose_item<false>(F.w_o, 1024, 1024, F.WO, scr, it, 32, hw_lane());
        else transpose_item<false, true>(F.pwq, 1024, 2048, F.WQ, scr, it - I_O, 64, hw_lane(), F.g2); }
    for (size_t i = gt; i < (size_t)(8 * 128 * 128) / 8; i += NGT) { cvt8(F.pk1, F.K1, i * 8); cvt8(F.pk2, F.K2, i * 8); }
}
__device__ __forceinline__ void phase_prologue(Ctx& F) {
    float* scr = (float*)(F.lds + F.wave * 16384);
    const int gw = F.bid * NWAVES + F.wave, NGW = F.G * NWAVES;
    constexpr int I_IN = 16 * (NPROJ_T / 32);
    const size_t gt = (size_t)F.bid * NTHR + (F.wave * 64 + hw_lane()), NGT = (size_t)F.G * NTHR;
    for (int st = 0; st < 2; ++st) { const int which = (st + F.wave) & 1;
    if (which == 0) {
    for (int it = gw; it < I_IN; it += NGW) transpose_item<true>(F.w_in, 1024, 7240, F.WIN, scr, it, NPROJ_T / 32, hw_lane());
    } else {
    rms_rows(F.x, F.g1, F.XN, gw, NGW, hw_lane());
    } }
    if (!F.late_jobs) { late_weights_job(F, scr, gw, NGW, gt, NGT); tables_job(F, gt, NGT); }
}

__device__ __forceinline__ void rope_cs(float pos, int i, float inv_half, float& c, float& s) {
    const float inv = exp2f(-(float)i * inv_half * LOG2_THETA), ang = pos * inv;
    float rev = ang * 0.15915494309189535f; rev -= floorf(rev);
    s = __builtin_amdgcn_sinf(rev); c = __builtin_amdgcn_cosf(rev);
}
__device__ __forceinline__ void phase_ki(Ctx& F) {
    typedef short bf16x8 __attribute__((ext_vector_type(8)));
    int lane = hw_lane(); asm volatile("" : "+v"(lane));
    const int w = F.wave, fr = lane & 15, fq = lane >> 4;
    LAS f32x4* red = (LAS f32x4*)F.lds;
    for (int tb = F.bid; tb < T / 64; tb += F.G) {
        const char* Ab = (const char*)F.XN + ((size_t)(tb * 64 + fr) * 1024 + w * 128 + fq * 8) * 2;
        const char* Bb = (const char*)F.WIN + ((size_t)NPROJ * 1024 + ((size_t)(4 * w) * 64 + lane) * 8) * 2;
        bf16x8 a[4][4], b[5][4];
#pragma unroll
        for (int kk = 0; kk < 4; ++kk) {
#pragma unroll
            for (int m = 0; m < 4; ++m) a[m][kk] = *(const bf16x8*)(Ab + m * (16 * 2048) + kk * 64);
#pragma unroll
            for (int n = 0; n < 5; ++n) b[n][kk] = *(const bf16x8*)(Bb + (n * 32 + kk) * 1024); }
        __builtin_amdgcn_sched_barrier(0);
        f32x4 acc[4][5];
#pragma unroll
        for (int m = 0; m < 4; ++m)
#pragma unroll
            for (int n = 0; n < 5; ++n) acc[m][n] = (f32x4){0.f, 0.f, 0.f, 0.f};
#pragma unroll
        for (int kk = 0; kk < 4; ++kk)
#pragma unroll
            for (int m = 0; m < 4; ++m)
#pragma unroll
                for (int n = 0; n < 5; ++n) acc[m][n] = __builtin_amdgcn_mfma_f32_16x16x32_bf16(b[n][kk], a[m][kk], acc[m][n], 0, 0, 0);
        LAS f32x4* mine = red + (w & 3) * (20 * 64) + lane;
        if (w >= 4) {
#pragma unroll
            for (int m = 0; m < 4; ++m)
#pragma unroll
                for (int n = 0; n < 5; ++n) mine[(m * 5 + n) * 64] = acc[m][n]; }
        __syncthreads();
        if (w < 4) {
#pragma unroll
            for (int m = 0; m < 4; ++m)
#pragma unroll
                for (int n = 0; n < 5; ++n) mine[(m * 5 + n) * 64] = acc[m][n] + mine[(m * 5 + n) * 64]; }
        __syncthreads();
        const int mf = w & 3, token = tb * 64 + mf * 16 + fr, nf0 = (w < 4) ? 0 : 3, nfn = (w < 4) ? 3 : 2;
        for (int q = 0; q < nfn; ++q) { const int nf = nf0 + q; LAS f32x4* rp = red + (mf * 5 + nf) * 64 + lane;
            f32x4 v = (rp[0] + rp[20 * 64]) + (rp[40 * 64] + rp[60 * 64]);
            if (nf == 0) { const float pos = (float)(token & 2047);
#pragma unroll
                for (int r = 0; r < 4; ++r) { const float o = __shfl_xor(v[r], 32); float c, s; rope_cs(pos, 4 * (fq & 1) + r, 1.f / 8.f, c, s); v[r] = (fq < 2) ? v[r] * c - o * s : v[r] * c + o * s; } }
            if (nf < 4) { v2u o; o.x = pk2(v[0], v[1]); o.y = pk2(v[2], v[3]);
                *(v2u*)(F.KI + ((((size_t)(token >> 5) * 4 + nf) * 64 + ((fq >> 1) & 1) * 32 + (token & 31)) * 8 + (fq & 1) * 4)) = o; }
            else if (fq < 2) *(f32x4*)(F.WI + (size_t)token * 8 + fq * 4) = v * IDX_W_SCALE; }
        __syncthreads();
    }
}

__device__ __forceinline__ void phase_post(Ctx& F) {
    const int gw = F.bid * NWAVES + F.wave, NGW = F.G * NWAVES, lane = hw_lane();
    const int gt = F.bid * NTHR + (F.wave * 64 + hw_lane()), NGT = F.G * NTHR;
    for (int st = 0; st < 2; ++st) { const int which = (st + F.wave) & 1;
    if (which == 0) {
    { constexpr int NWI = T * 2 / 8; const int sub = lane & 7;
      for (int wi0 = gw; wi0 < NWI; wi0 += 4 * NGW) {
        bf16* p[4]; const float* g[4]; v4u a[4], b[4]; float pos[4];
#pragma unroll
        for (int j = 0; j < 4; ++j) { const int wi = (wi0 + j * NGW < NWI) ? wi0 + j * NGW : wi0; const int unit = wi * 8 + (lane >> 3), t = unit >> 1, hh = unit & 1;
            p[j] = F.K + (size_t)t * 256 + hh * 128 + sub * 16;
            g[j] = F.kg + sub * 16; pos[j] = (float)(t & (SEQ - 1));
            a[j] = *(const v4u*)p[j]; b[j] = *(const v4u*)(p[j] + 8); }
#pragma unroll
        for (int j = 0; j < 4; ++j) {
            float v[16];
            v[0] = bflo(a[j].x); v[1] = bfhi(a[j].x); v[2] = bflo(a[j].y); v[3] = bfhi(a[j].y); v[4] = bflo(a[j].z); v[5] = bfhi(a[j].z); v[6] = bflo(a[j].w); v[7] = bfhi(a[j].w);
            v[8] = bflo(b[j].x); v[9] = bfhi(b[j].x); v[10] = bflo(b[j].y); v[11] = bfhi(b[j].y); v[12] = bflo(b[j].z); v[13] = bfhi(b[j].z); v[14] = bflo(b[j].w); v[15] = bfhi(b[j].w);
            float ss = 0.f;
#pragma unroll
            for (int i = 0; i < 16; ++i) ss += v[i] * v[i];
            ss += __int_as_float(__builtin_amdgcn_mov_dpp(__float_as_int(ss), DPP_XOR1, 0xF, 0xF, true)); ss += __int_as_float(__builtin_amdgcn_mov_dpp(__float_as_int(ss), DPP_XOR2, 0xF, 0xF, true)); ss += __shfl_xor(ss, 4);
            const float rstd = rsqrtf(ss * (1.f / 128.f) + EPS);
#pragma unroll
            for (int i = 0; i < 16; ++i) v[i] = v[i] * rstd * g[j][i];
#pragma unroll
            for (int i = 0; i < 16; ++i) { const float o = __int_as_float(__builtin_amdgcn_mov_dpp(__float_as_int(v[i]), DPP_XOR1, 0xF, 0xF, true)); float c, s; rope_cs(pos[j], i, 1.f / 16.f, c, s);
                if (sub == 0) v[i] = v[i] * c - o * s; else if (sub == 1) v[i] = v[i] * c + o * s; }
            v4u oa, ob;
            oa.x = pk2(v[0], v[1]); oa.y = pk2(v[2], v[3]); oa.z = pk2(v[4], v[5]); oa.w = pk2(v[6], v[7]);
            ob.x = pk2(v[8], v[9]); ob.y = pk2(v[10], v[11]); ob.z = pk2(v[12], v[13]); ob.w = pk2(v[14], v[15]);
            if (j == 0 || wi0 + j * NGW < NWI) { *(v4u*)p[j] = oa; *(v4u*)(p[j] + 8) = ob; }
        }
      } }
    } else {
    } }
}

__device__ __forceinline__ unsigned f2key(float f) { const unsigned u = __builtin_bit_cast(unsigned, f); return (u >> 31) ? ~u : (u | 0x80000000u); }
__device__ __forceinline__ unsigned causal_word(int j, int s) { const int lo = 32 * j; return (lo + 31 <= s) ? 0xffffffffu : (lo > s ? 0u : ((1u << (s - lo + 1)) - 1u)); }
__device__ __forceinline__ void phase_indexer_simple(Ctx& F) {
    float* qf = (float*)F.lds; float* wsc = qf + 512; int* cnts = (int*)(wsc + 8); unsigned* gew = (unsigned*)(cnts + 16); unsigned* gtw = gew + 64;
    const int tid = (F.wave * 64 + hw_lane()), lane = hw_lane(), wave = F.wave;
    for (int t = F.bid; t < T; t += F.G) {
        const int s = t & (SEQ - 1), b = t >> 11;
        unsigned* mrow = F.MASK + (size_t)t * 64;
        if (s < 256) { if (tid < 64) mrow[tid] = causal_word(tid, s); continue; }
        qf[tid] = bf1(F.QI[(size_t)t * 512 + tid]); if (tid < 8) wsc[tid] = F.WI[(size_t)t * 8 + tid] * IDX_SCALE;
        __syncthreads();
        unsigned key[4];
#pragma unroll 1
        for (int j = 0; j < 4; ++j) {
            const int sk = tid + 512 * j; key[j] = 0u;
            if (sk <= s) {
                const v4u* kr = (const v4u*)(F.KI + ((size_t)b * SEQ + sk) * 64);
                float kf[64];
#pragma unroll
                for (int c = 0; c < 8; ++c) { const v4u w = kr[c]; kf[8 * c] = bflo(w.x); kf[8 * c + 1] = bfhi(w.x); kf[8 * c + 2] = bflo(w.y); kf[8 * c + 3] = bfhi(w.y); kf[8 * c + 4] = bflo(w.z); kf[8 * c + 5] = bfhi(w.z); kf[8 * c + 6] = bflo(w.w); kf[8 * c + 7] = bfhi(w.w); }
                float sc = 0.f;
#pragma unroll
                for (int h = 0; h < 8; ++h) { float d = 0.f;
#pragma unroll
                    for (int e = 0; e < 64; ++e) d += qf[h * 64 + e] * kf[e];
                    sc += wsc[h] * fmaxf(d, 0.f); }
                key[j] = f2key(sc);
            }
        }
        unsigned thr = 0u;
        for (int bit = 31; bit >= 0; --bit) {
            const unsigned cand = thr | (1u << bit);
            int c = (key[0] >= cand) + (key[1] >= cand) + (key[2] >= cand) + (key[3] >= cand);
            c = wave_sumi(c);
            if (lane == 0) cnts[(bit & 1) * 8 + wave] = c;
            __syncthreads();
            int tot = 0;
#pragma unroll
            for (int w = 0; w < 8; ++w) tot += cnts[(bit & 1) * 8 + w];
            if (tot >= 256) thr = cand;
        }
#pragma unroll
        for (int j = 0; j < 4; ++j) { const unsigned long long ge = __ballot(key[j] >= thr), gt = __ballot(key[j] > thr);
            if (lane == 0) { const int w = 16 * j + 2 * wave; gew[w] = (unsigned)ge; gew[w + 1] = (unsigned)(ge >> 32); gtw[w] = (unsigned)gt; gtw[w + 1] = (unsigned)(gt >> 32); } }
        __syncthreads();
        if (wave == 0) {
            const unsigned ge = gew[lane], gt = gtw[lane], eq = ge & ~gt;
            const int need = 256 - wave_sumi(__popc(gt)), pe = __popc(eq), excl = wave_incl_scan(pe, lane) - pe;
            const int keep = min(max(need - excl, 0), pe);
            unsigned kept = 0u, e = eq;
            for (int i = 0; i < keep; ++i) { const unsigned bb = e & (0u - e); kept |= bb; e ^= bb; }
            mrow[lane] = (gt | kept) & causal_word(lane, s);
        }
        __syncthreads();
    }
}

__device__ __forceinline__ unsigned idx_fixup(unsigned ge, unsigned gt, int lane) {
    const unsigned eq = ge & ~gt;
    const int need = 256 - wave_sumi(__popc(gt)), pe = __popc(eq), excl = wave_incl_scan(pe, lane) - pe;
    const int keep = min(max(need - excl, 0), pe);
    unsigned kept = 0u, e = eq;
    for (int i = 0; i < keep; ++i) { const unsigned bb = e & (0u - e); kept |= bb; e ^= bb; }
    return gt | kept;
}
__device__ __forceinline__ void phase_indexer(Ctx& F) {
    typedef short bf16x8 __attribute__((ext_vector_type(8)));
    typedef float f32x16 __attribute__((ext_vector_type(16)));
    for (int vw = F.bid * NWAVES + F.wave; vw < 2048; vw += F.G * NWAVES) {
        const int vb = vw >> 3, batch = vb & 7, p = (vb >> 3) * 8 + (vw & 7);
#pragma unroll 1
        for (int pass = 0; pass < 2; ++pass) {
            int lane = hw_lane(); asm volatile("" : "+v"(lane));
            const int r32 = lane & 31, hi = lane >> 5;
            const int gi = ((pass != 0) != (F.wave >= 4)) ? 511 - p : p, s0 = gi * 4; const size_t tok0 = (size_t)batch * SEQ + s0;
            unsigned* mrow = F.MASK + tok0 * 64;
            if (s0 + 3 < 256) {
#pragma unroll
                for (int tk = 0; tk < 4; ++tk) mrow[tk * 64 + lane] = causal_word(lane, s0 + tk);
                continue;
            }
            bf16x8 aq[4];
            { const size_t trow = tok0 + 2 * ((r32 >> 2) & 1) + (r32 >> 4); const int hrow = (r32 & 3) + 4 * ((r32 >> 3) & 1);
              const bf16* qp = F.QI + trow * 512 + hrow * 64 + 8 * hi;
#pragma unroll
              for (int s = 0; s < 4; ++s) aq[s] = *(const bf16x8*)(qp + 16 * s); }
            float w0[8], w1[8];
            { const f32x4* wp = (const f32x4*)(F.WI + (tok0 + 2 * hi) * 8); const f32x4 a = wp[0], b = wp[1], c = wp[2], d = wp[3];
              w0[0] = a[0] * IDX_SCALE; w0[1] = a[1] * IDX_SCALE; w0[2] = a[2] * IDX_SCALE; w0[3] = a[3] * IDX_SCALE; w0[4] = b[0] * IDX_SCALE; w0[5] = b[1] * IDX_SCALE; w0[6] = b[2] * IDX_SCALE; w0[7] = b[3] * IDX_SCALE;
              w1[0] = c[0] * IDX_SCALE; w1[1] = c[1] * IDX_SCALE; w1[2] = c[2] * IDX_SCALE; w1[3] = c[3] * IDX_SCALE; w1[4] = d[0] * IDX_SCALE; w1[5] = d[1] * IDX_SCALE; w1[6] = d[2] * IDX_SCALE; w1[7] = d[3] * IDX_SCALE; }
            const int jmax = (s0 + 3) >> 5;
            const bf16* kp = F.KI + (size_t)batch * SEQ * 64 + lane * 8;
            unsigned ka[64], kb[64];
            bf16x8 bq[2][4];
#pragma unroll
            for (int s = 0; s < 4; ++s) bq[0][s] = *(const bf16x8*)(kp + 512 * s);
            if (1 <= jmax) {
#pragma unroll
                for (int s = 0; s < 4; ++s) bq[1][s] = *(const bf16x8*)(kp + 2048 + 512 * s); }
#pragma unroll
            for (int j = 0; j < 64; ++j) {
                unsigned k0 = 0u, k1 = 0u;
                if (j <= jmax) {
                    f32x16 acc = {};
#pragma unroll
                    for (int s = 0; s < 4; ++s) acc = __builtin_amdgcn_mfma_f32_32x32x16_bf16(aq[s], bq[j & 1][s], acc, 0, 0, 0);
                    __builtin_amdgcn_sched_barrier(0);
                    if (j + 2 <= jmax) {
#pragma unroll
                        for (int s = 0; s < 4; ++s) bq[j & 1][s] = *(const bf16x8*)(kp + (size_t)(j + 2) * 2048 + 512 * s); }
                    __builtin_amdgcn_sched_barrier(0);
                    typedef float f32x2_ __attribute__((ext_vector_type(2)));
                    typedef int i32x16_ __attribute__((ext_vector_type(16)));
                    const i32x16_ ai = __builtin_bit_cast(i32x16_, acc);
                    f32x2_ ps0 = {0.f, 0.f}, ps1 = {0.f, 0.f};
#pragma unroll
                    for (int h = 0; h < 8; h += 2) {
                        const f32x2_ r0 = {__int_as_float(max(ai[h], 0)), __int_as_float(max(ai[h + 1], 0))};
                        const f32x2_ r1 = {__int_as_float(max(ai[8 + h], 0)), __int_as_float(max(ai[9 + h], 0))};
                        ps0 = __builtin_elementwise_fma((f32x2_){w0[h], w0[h + 1]}, r0, ps0); ps1 = __builtin_elementwise_fma((f32x2_){w1[h], w1[h + 1]}, r1, ps1); }
                    const float sc0 = ps0.x + ps0.y, sc1 = ps1.x + ps1.y;
                    k0 = f2key(sc0); k1 = f2key(sc1);
                    if (j == jmax) { const int kpos = 32 * j + r32; if (kpos > s0 + 2 * hi) k0 = 0u; if (kpos > s0 + 2 * hi + 1) k1 = 0u; }
                }
                asm volatile("" : "+v"(k0), "+v"(k1));
                ka[j] = k0; kb[j] = k1;
            }
            unsigned t0 = 0u, t1 = 0u; int n0 = 2048, n1 = 2048; bool done = false;
            constexpr int PBMIN = 10, RMAX = 8, WMAX = 40; int pb = PBMIN; int u0 = 0, u1 = 0; int na0 = 64, na1 = 64, ua0 = 0, ua1 = 0;
#define BIT_HI 31
#define BIT_LO PBMIN
#pragma unroll 1
            for (int bit = BIT_HI; bit >= BIT_LO; --bit) {
                const unsigned c0 = t0 | (1u << bit), c1 = t1 | (1u << bit);
                int a0 = 0, a1 = 0;
#pragma unroll
                for (int j8 = 0; j8 < 64; j8 += 8) if (j8 <= jmax) {
#define IDX_P(KA0, KB0, KA1, KB1) "v_cmp_ge_u32_e64 %2, %" #KA0 ", %22\n\tv_cmp_ge_u32_e64 %3, %" #KB0 ", %23\n\tv_cmp_ge_u32_e64 %4, %" #KA1 ", %22\n\tv_cmp_ge_u32_e64 %5, %" #KB1 ", %23\n\t" \
                      "v_addc_co_u32_e64 %0, %2, 0, %0, %2\n\tv_addc_co_u32_e64 %1, %3, 0, %1, %3\n\tv_addc_co_u32_e64 %0, %4, 0, %0, %4\n\tv_addc_co_u32_e64 %1, %5, 0, %1, %5\n\t"
                    { unsigned long long q0_, q1_, q2_, q3_;
                    asm(IDX_P(6, 14, 7, 15) IDX_P(8, 16, 9, 17) IDX_P(10, 18, 11, 19) IDX_P(12, 20, 13, 21)
                        : "+v"(a0), "+v"(a1), "=&s"(q0_), "=&s"(q1_), "=&s"(q2_), "=&s"(q3_)
                        : "v"(ka[j8]), "v"(ka[j8 + 1]), "v"(ka[j8 + 2]), "v"(ka[j8 + 3]), "v"(ka[j8 + 4]), "v"(ka[j8 + 5]), "v"(ka[j8 + 6]), "v"(ka[j8 + 7]),
                          "v"(kb[j8]), "v"(kb[j8 + 1]), "v"(kb[j8 + 2]), "v"(kb[j8 + 3]), "v"(kb[j8 + 4]), "v"(kb[j8 + 5]), "v"(kb[j8 + 6]), "v"(kb[j8 + 7]), "v"(c0), "v"(c1)); }
#undef IDX_P
                }
                int c = a0 | (a1 << 16);
                c += __builtin_amdgcn_mov_dpp(c, DPP_XOR1, 0xF, 0xF, true); c += __builtin_amdgcn_mov_dpp(c, DPP_XOR2, 0xF, 0xF, true);
                c += __builtin_amdgcn_mov_dpp(c, DPP_ROR(4), 0xF, 0xF, true) + __builtin_amdgcn_mov_dpp(c, DPP_ROR(8), 0xF, 0xF, true) + __builtin_amdgcn_mov_dpp(c, DPP_ROR(12), 0xF, 0xF, true);
                c += __shfl_xor(c, 16);
                const int tot0 = c & 0xffff, tot1 = c >> 16;
                if (tot0 >= 256) { t0 = c0; n0 = tot0; na0 = a0; } else { u0 = tot0; ua0 = a0; }
                if (tot1 >= 256) { t1 = c1; n1 = tot1; na1 = a1; } else { u1 = tot1; ua1 = a1; }
                if (__all(n0 == 256 && n1 == 256)) { done = true; break; }
                if (__all(n0 - u0 <= 96 && n1 - u1 <= 96 && na0 - ua0 <= RMAX && na1 - ua1 <= RMAX)) { pb = bit; break; }
            }
#undef BIT_HI
#undef BIT_LO
            if (!done) {
              LAS unsigned* wl = (LAS unsigned*)((LAS unsigned char*)F.lds + 90112 + F.wave * (2 * (RMAX + 1) * 256));
              int ca = 0, cb = 0; int jm2 = jmax; asm volatile("" : "+s"(jm2));
#pragma unroll
              for (int j = 0; j < 64; ++j) if (j <= jm2) {
                  const unsigned da = ka[j] - t0, db = kb[j] - t1;
                  const bool xa = da < (1u << pb), xb = db < (1u << pb);
                  wl[(xa ? min(ca, RMAX) : RMAX) * 64 + lane] = da; ca += xa ? 1 : 0;
                  wl[(RMAX + 1 + (xb ? min(cb, RMAX) : RMAX)) * 64 + lane] = db; cb += xb ? 1 : 0;
                  __builtin_amdgcn_sched_barrier(0); }
              int R = max(ca, cb);
#pragma unroll
              for (int o = 1; o < 64; o <<= 1) R = max(R, __shfl_xor(R, o));
              R = __builtin_amdgcn_readfirstlane(R);
              if (R <= RMAX && __all(t0 != 0u && t1 != 0u)) {
                  int c = ca | (cb << 16);
                  c += __builtin_amdgcn_mov_dpp(c, DPP_XOR1, 0xF, 0xF, true); c += __builtin_amdgcn_mov_dpp(c, DPP_XOR2, 0xF, 0xF, true);
                  c += __builtin_amdgcn_mov_dpp(c, DPP_ROR(4), 0xF, 0xF, true) + __builtin_amdgcn_mov_dpp(c, DPP_ROR(8), 0xF, 0xF, true) + __builtin_amdgcn_mov_dpp(c, DPP_ROR(12), 0xF, 0xF, true);
                  c += __shfl_xor(c, 16);
                  const int hi0 = n0 - (c & 0xffff), hi1 = n1 - (c >> 16);
                  LDS_WAIT(); asm volatile("" ::: "memory");
                  unsigned la[RMAX], lb[RMAX];
#pragma unroll
                  for (int r = 0; r < RMAX; ++r) { la[r] = (r < ca) ? wl[r * 64 + lane] : 0u; lb[r] = (r < cb) ? wl[(RMAX + 1 + r) * 64 + lane] : 0u; }
                  unsigned d0 = 0u, d1 = 0u;
#pragma unroll 1
                  for (int bit = pb - 1; bit >= 0; --bit) {
                      const unsigned e0 = d0 | (1u << bit), e1 = d1 | (1u << bit);
                      int a0 = 0, a1 = 0;
#pragma unroll
                      for (int r4 = 0; r4 < RMAX; r4 += 4) if (r4 < R) {
                          unsigned long long q0_, q1_, q2_, q3_;
                          asm("v_cmp_ge_u32_e64 %2, %6, %14\n\tv_cmp_ge_u32_e64 %3, %10, %15\n\tv_cmp_ge_u32_e64 %4, %7, %14\n\tv_cmp_ge_u32_e64 %5, %11, %15\n\t"
                              "v_addc_co_u32_e64 %0, %2, 0, %0, %2\n\tv_addc_co_u32_e64 %1, %3, 0, %1, %3\n\tv_addc_co_u32_e64 %0, %4, 0, %0, %4\n\tv_addc_co_u32_e64 %1, %5, 0, %1, %5\n\t"
                              "v_cmp_ge_u32_e64 %2, %8, %14\n\tv_cmp_ge_u32_e64 %3, %12, %15\n\tv_cmp_ge_u32_e64 %4, %9, %14\n\tv_cmp_ge_u32_e64 %5, %13, %15\n\t"
                              "v_addc_co_u32_e64 %0, %2, 0, %0, %2\n\tv_addc_co_u32_e64 %1, %3, 0, %1, %3\n\tv_addc_co_u32_e64 %0, %4, 0, %0, %4\n\tv_addc_co_u32_e64 %1, %5, 0, %1, %5"
                              : "+v"(a0), "+v"(a1), "=&s"(q0_), "=&s"(q1_), "=&s"(q2_), "=&s"(q3_)
                              : "v"(la[r4]), "v"(la[r4 + 1]), "v"(la[r4 + 2]), "v"(la[r4 + 3]), "v"(lb[r4]), "v"(lb[r4 + 1]), "v"(lb[r4 + 2]), "v"(lb[r4 + 3]), "v"(e0), "v"(e1)); }
                      int cc = a0 | (a1 << 16);
                      cc += __builtin_amdgcn_mov_dpp(cc, DPP_XOR1, 0xF, 0xF, true); cc += __builtin_amdgcn_mov_dpp(cc, DPP_XOR2, 0xF, 0xF, true);
                      cc += __builtin_amdgcn_mov_dpp(cc, DPP_ROR(4), 0xF, 0xF, true) + __builtin_amdgcn_mov_dpp(cc, DPP_ROR(8), 0xF, 0xF, true) + __builtin_amdgcn_mov_dpp(cc, DPP_ROR(12), 0xF, 0xF, true);
                      cc += __shfl_xor(cc, 16);
                      const int tot0 = hi0 + (cc & 0xffff), tot1 = hi1 + (cc >> 16);
                      if (tot0 >= 256) { d0 = e0; n0 = tot0; }
                      if (tot1 >= 256) { d1 = e1; n1 = tot1; }
                      if (__all(n0 == 256 && n1 == 256)) break;
                  }
                  t0 += d0; t1 += d1;
              } else {
#define BIT_HI (pb - 1)
#define BIT_LO 0
#pragma unroll 1
            for (int bit = BIT_HI; bit >= BIT_LO; --bit) {
                const unsigned c0 = t0 | (1u << bit), c1 = t1 | (1u << bit);
                int a0 = 0, a1 = 0;
#pragma unroll
                for (int j8 = 0; j8 < 64; j8 += 8) if (j8 <= jmax) {
#define IDX_P(KA0, KB0, KA1, KB1) "v_cmp_ge_u32_e64 %2, %" #KA0 ", %22\n\tv_cmp_ge_u32_e64 %3, %" #KB0 ", %23\n\tv_cmp_ge_u32_e64 %4, %" #KA1 ", %22\n\tv_cmp_ge_u32_e64 %5, %" #KB1 ", %23\n\t" \
                      "v_addc_co_u32_e64 %0, %2, 0, %0, %2\n\tv_addc_co_u32_e64 %1, %3, 0, %1, %3\n\tv_addc_co_u32_e64 %0, %4, 0, %0, %4\n\tv_addc_co_u32_e64 %1, %5, 0, %1, %5\n\t"
                    { unsigned long long q0_, q1_, q2_, q3_;
                    asm(IDX_P(6, 14, 7, 15) IDX_P(8, 16, 9, 17) IDX_P(10, 18, 11, 19) IDX_P(12, 20, 13, 21)
                        : "+v"(a0), "+v"(a1), "=&s"(q0_), "=&s"(q1_), "=&s"(q2_), "=&s"(q3_)
                        : "v"(ka[j8]), "v"(ka[j8 + 1]), "v"(ka[j8 + 2]), "v"(ka[j8 + 3]), "v"(ka[j8 + 4]), "v"(ka[j8 + 5]), "v"(ka[j8 + 6]), "v"(ka[j8 + 7]),
                          "v"(kb[j8]), "v"(kb[j8 + 1]), "v"(kb[j8 + 2]), "v"(kb[j8 + 3]), "v"(kb[j8 + 4]), "v"(kb[j8 + 5]), "v"(kb[j8 + 6]), "v"(kb[j8 + 7]), "v"(c0), "v"(c1)); }
#undef IDX_P
                }
                int c = a0 | (a1 << 16);
                c += __builtin_amdgcn_mov_dpp(c, DPP_XOR1, 0xF, 0xF, true); c += __builtin_amdgcn_mov_dpp(c, DPP_XOR2, 0xF, 0xF, true);
                c += __builtin_amdgcn_mov_dpp(c, DPP_ROR(4), 0xF, 0xF, true) + __builtin_amdgcn_mov_dpp(c, DPP_ROR(8), 0xF, 0xF, true) + __builtin_amdgcn_mov_dpp(c, DPP_ROR(12), 0xF, 0xF, true);
                c += __shfl_xor(c, 16);
                const int tot0 = c & 0xffff, tot1 = c >> 16;
                if (tot0 >= 256) { t0 = c0; n0 = tot0; }
                if (tot1 >= 256) { t1 = c1; n1 = tot1; }
                if (__all(n0 == 256 && n1 == 256)) { done = true; break; }
            }
#undef BIT_HI
#undef BIT_LO
              }
            }
            unsigned* mt = (unsigned*)(F.lds + F.wave * 2048);
#pragma unroll
            for (int j = 0; j < 64; ++j) { const unsigned long long g0 = __ballot(ka[j] >= t0), g1 = __ballot(kb[j] >= t1);
                if (lane == 0) *(v4u*)(mt + 4 * j) = (v4u){(unsigned)g0, (unsigned)g1, (unsigned)(g0 >> 32), (unsigned)(g1 >> 32)};
                __builtin_amdgcn_sched_barrier(0); }
            LDS_WAIT(); asm volatile("" ::: "memory");
            unsigned mA = mt[4 * lane], mB = mt[4 * lane + 1], mC = mt[4 * lane + 2], mD = mt[4 * lane + 3];
            LDS_WAIT(); asm volatile("" ::: "memory");
            if (!__all(n0 == 256 && n1 == 256)) {
#pragma unroll
                for (int j = 0; j < 64; ++j) { const unsigned long long g0 = __ballot(ka[j] > t0), g1 = __ballot(kb[j] > t1);
                    if (lane == 0) *(v4u*)(mt + 4 * j) = (v4u){(unsigned)g0, (unsigned)g1, (unsigned)(g0 >> 32), (unsigned)(g1 >> 32)};
                    __builtin_amdgcn_sched_barrier(0); }
                LDS_WAIT(); asm volatile("" ::: "memory");
                const unsigned gA = mt[4 * lane], gB = mt[4 * lane + 1], gC = mt[4 * lane + 2], gD = mt[4 * lane + 3];
                LDS_WAIT(); asm volatile("" ::: "memory");
                mA = idx_fixup(mA, gA, lane); mB = idx_fixup(mB, gB, lane); mC = idx_fixup(mC, gC, lane); mD = idx_fixup(mD, gD, lane);
            }
            mrow[lane] = mA & causal_word(lane, s0); mrow[64 + lane] = mB & causal_word(lane, s0 + 1);
            mrow[128 + lane] = mC & causal_word(lane, s0 + 2); mrow[192 + lane] = mD & causal_word(lane, s0 + 3);
        }
    }
}

__device__ __forceinline__ void phase_attn_simple(Ctx& F) {
    int* list = (int*)F.lds; int* nselp = list + 256; float* qf = (float*)(F.lds + 2048); float* pbuf = (float*)(F.lds + 8192);
    const int lane = hw_lane(), h = F.wave;
    for (int t = F.bid; t < T; t += F.G) {
        const int b = t >> 11;
        if (h == 0) { unsigned w = F.MASK[(size_t)t * 64 + lane]; const int pc = __popc(w), incl = wave_incl_scan(pc, lane); int o = incl - pc;
            while (w) { const int bp = __ffs((int)w) - 1; list[o++] = 32 * lane + bp; w &= w - 1u; }
            if (lane == 63) *nselp = incl; }
        { const unsigned qq = *(const unsigned*)(F.Q + (size_t)t * 1024 + h * 128 + 2 * lane); qf[h * 128 + 2 * lane] = bflo(qq) * ATTN_SCALE; qf[h * 128 + 2 * lane + 1] = bfhi(qq) * ATTN_SCALE; }
        __syncthreads();
        const int nsel = *nselp;
        const bf16* Kb = F.K + (size_t)b * SEQ * 256 + (h >> 2) * 128; const bf16* Vb = F.V + (size_t)b * SEQ * 256 + (h >> 2) * 128;
        float sc[4]; float mx = -__builtin_inff();
#pragma unroll 1
        for (int r = 0; r < 4; ++r) { const int idx = lane + 64 * r; sc[r] = -__builtin_inff();
            if (idx < nsel) { const v4u* kr = (const v4u*)(Kb + (size_t)list[idx] * 256); float d = 0.f;
#pragma unroll
                for (int c = 0; c < 16; ++c) { const v4u w = kr[c]; const float* q = qf + h * 128 + 8 * c;
                    d += q[0] * bflo(w.x) + q[1] * bfhi(w.x) + q[2] * bflo(w.y) + q[3] * bfhi(w.y) + q[4] * bflo(w.z) + q[5] * bfhi(w.z) + q[6] * bflo(w.w) + q[7] * bfhi(w.w); }
                sc[r] = d; }
            mx = fmaxf(mx, sc[r]); }
        mx = wave_max(mx);
        float ls = 0.f;
#pragma unroll
        for (int r = 0; r < 4; ++r) { const int idx = lane + 64 * r; const float p = (idx < nsel) ? __expf(sc[r] - mx) : 0.f; pbuf[h * 256 + idx] = p; ls += p; }
        ls = wave_sum(ls);
        __syncthreads();
        float a0 = 0.f, a1 = 0.f;
        for (int i = 0; i < nsel; ++i) { const float p = pbuf[h * 256 + i]; const unsigned vv = *(const unsigned*)(Vb + (size_t)list[i] * 256 + 2 * lane); a0 += p * bflo(vv); a1 += p * bfhi(vv); }
        const float inv = 1.f / ls; const size_t o = (size_t)t * 1024 + h * 128 + 2 * lane;
        const unsigned ya = *(const unsigned*)(F.P1 + o), sg = *(const unsigned*)(F.SGB + o);
        *(unsigned*)(F.XN + o) = pk2(bflo(ya) + bflo(sg) * a0 * inv, bfhi(ya) + bfhi(sg) * a1 * inv);
        __syncthreads();
    }
}

namespace att {
typedef short bf16x8 __attribute__((ext_vector_type(8)));
typedef short s16x4 __attribute__((ext_vector_type(4)));
typedef float f32x16 __attribute__((ext_vector_type(16)));
typedef unsigned u32x4 __attribute__((ext_vector_type(4)));
typedef unsigned u32x2 __attribute__((ext_vector_type(2)));
constexpr int DH = 128, QS = 1024, KVS = 256;
constexpr float SCALE = 0.08838834764831845f, THR = 8.f;
constexpr int NW = 8, QBLK = 32, KVBLK = 64, QB = NW * QBLK;
constexpr int SHM_V = KVBLK * DH * 2, SHM_K = KVBLK * DH * 2;
constexpr int OST_OFF = 2 * SHM_V + 2 * SHM_K + NW * 64 * 4, OST_PITCH = 272, OST_WAVE = 32 * OST_PITCH;
constexpr int LDS_BYTES = OST_OFF + NW * OST_WAVE;
#define KSWZ(row, colB) ((row) * 256 + ((colB) ^ (((row) & 7) << 4)))
#define SBAR() __builtin_amdgcn_sched_barrier(0)
__device__ __forceinline__ int v_st(int k, int c) { const int kk = (k & ~0xC) | ((k & 4) << 1) | ((k & 8) >> 1); return ((kk >> 3) * 4 + (c >> 5)) * 512 + ((kk & 7) * 32 + (c & 31)) * 2; }
__device__ __forceinline__ int v_rd_base(int lane) { return ((lane & 3) << 3) | (((lane >> 2) & 3) << 6) | (((lane >> 4) & 1) << 5) | (((lane >> 5) & 1) << 8); }
constexpr int v_rd_off(int d0, int ks, int half) { return d0 * 512 + ks * 4096 + half * 2048; }
__device__ __forceinline__ int crow(int r, int hi) { return (r & 3) + 8 * (r >> 2) + 4 * hi; }
__device__ __forceinline__ unsigned cvtpk(float lo, float hi) { unsigned r; asm volatile("v_cvt_pk_bf16_f32 %0, %1, %2" : "=v"(r) : "v"(lo), "v"(hi)); return r; }
__device__ __forceinline__ bf16x8 load8(const unsigned short* p) { return *reinterpret_cast<const bf16x8*>(p); }
__device__ __forceinline__ void partialSM(f32x16& p0, f32x16& p1, float& m_reg, float& mn, float& alpha) {
    float pmax = p0[0];
#pragma unroll
    for (int r = 1; r < 16; ++r) pmax = fmaxf(pmax, p0[r]);
#pragma unroll
    for (int r = 0; r < 16; ++r) pmax = fmaxf(pmax, p1[r]);
    { auto rr = __builtin_amdgcn_permlane32_swap(__float_as_uint(pmax), __float_as_uint(pmax), false, false);
      pmax = fmaxf(__uint_as_float(rr[0]), __uint_as_float(rr[1])); }
    constexpr float C2 = 1.4426950408889634f * SCALE;
    if (__builtin_expect(__all((pmax - m_reg) * SCALE <= THR), 1)) { mn = m_reg; alpha = 1.f; }
    else { mn = fmaxf(m_reg, pmax); alpha = __builtin_amdgcn_exp2f((m_reg - mn) * C2); m_reg = mn; }
    const float mnL = -mn * C2;
#pragma unroll
    for (int r = 0; r < 16; ++r) p0[r] = fmaf(p0[r], C2, mnL);
#pragma unroll
    for (int r = 0; r < 16; ++r) p1[r] = fmaf(p1[r], C2, mnL);
#pragma unroll
    for (int r = 0; r < 16; ++r) p0[r] = __builtin_amdgcn_exp2f(p0[r]);
}
__device__ __forceinline__ void finishSM(f32x16& p0, f32x16& p1, u32x2 mw, float alpha, float& l_reg, bf16x8& pa0, bf16x8& pa1, bf16x8& pa2, bf16x8& pa3) {
#pragma unroll
    for (int r = 0; r < 16; ++r) p1[r] = __builtin_amdgcn_exp2f(p1[r]);
#pragma unroll
    for (int r = 0; r < 16; ++r) { const int c = (r & 3) + 8 * (r >> 2);
        float t0, t1;
        asm("v_bfe_i32 %0, %1, %2, 1\n\tv_and_b32 %0, %3, %0" : "=&v"(t0) : "v"(mw.x), "n"(c), "v"(p0[r]));
        asm("v_bfe_i32 %0, %1, %2, 1\n\tv_and_b32 %0, %3, %0" : "=&v"(t1) : "v"(mw.y), "n"(c), "v"(p1[r]));
        p0[r] = t0; p1[r] = t1; }
    float ps = 0;
#pragma unroll
    for (int r = 0; r < 16; ++r) ps += p0[r];
#pragma unroll
    for (int r = 0; r < 16; ++r) ps += p1[r];
    { auto rr = __builtin_amdgcn_permlane32_swap(__float_as_uint(ps), __float_as_uint(ps), false, false);
      ps = __uint_as_float(rr[0]) + __uint_as_float(rr[1]); }
    l_reg = l_reg * alpha + ps;
#define PK4(P, B_, OUT) do { unsigned a0 = cvtpk(P[B_+0], P[B_+1]), a1 = cvtpk(P[B_+2], P[B_+3]);                          \
        unsigned b0 = cvtpk(P[B_+4], P[B_+5]), b1 = cvtpk(P[B_+6], P[B_+7]);                                             \
        auto r0 = __builtin_amdgcn_permlane32_swap(a0, b0, false, false); auto r1 = __builtin_amdgcn_permlane32_swap(a1, b1, false, false); \
        u32x4 w = {r0[0], r1[0], r0[1], r1[1]}; OUT = *reinterpret_cast<bf16x8*>(&w); } while (0)
    PK4(p0, 0, pa0); PK4(p0, 8, pa1); PK4(p1, 0, pa2); PK4(p1, 8, pa3);
#undef PK4
}
template <int KB>
__device__ __forceinline__ void qkt(f32x16& p0, f32x16& p1, const char* K_lds, int r32, int hi, const bf16x8* qr) {
    p0 = f32x16{}; p1 = f32x16{};
    const char* kb[4];
#pragma unroll
    for (int dd = 0; dd < 4; ++dd) kb[dd] = K_lds + KB * SHM_K + KSWZ(r32, (dd * 16 + hi * 8) * 2);
#pragma unroll
    for (int d0 = 0; d0 < 8; ++d0) { const char* a = kb[d0 & 3] + (d0 >> 2) * 128;
        bf16x8 b0 = *reinterpret_cast<const bf16x8*>(a);
        bf16x8 b1 = *reinterpret_cast<const bf16x8*>(a + 32 * 256);
        p0 = __builtin_amdgcn_mfma_f32_32x32x16_bf16(b0, qr[d0], p0, 0, 0, 0);
        p1 = __builtin_amdgcn_mfma_f32_32x32x16_bf16(b1, qr[d0], p1, 0, 0, 0); }
}
template <int VB>
__device__ __forceinline__ void pv_tile(f32x16* o, int vb0, bf16x8 pa0, bf16x8 pa1, bf16x8 pa2, bf16x8 pa3) {
#define TRRD(dst, off) asm volatile("ds_read_b64_tr_b16 %0, %1 offset:%2" : "=&v"(dst) : "v"(vb0), "i"(off) : "memory")
#define PV_D0(d0) do { s16x4 l0, l1, l2, l3, h0, h1, h2, h3; constexpr int b_ = VB * SHM_V + v_rd_off(d0, 0, 0); \
        TRRD(l0, b_); TRRD(h0, b_ + 2048); TRRD(l1, b_ + 4096); TRRD(h1, b_ + 6144); TRRD(l2, b_ + 8192); TRRD(h2, b_ + 10240); TRRD(l3, b_ + 12288); TRRD(h3, b_ + 14336); \
        asm volatile("s_waitcnt lgkmcnt(0)" ::: "memory"); SBAR();   \
        o[d0] = __builtin_amdgcn_mfma_f32_32x32x16_bf16(pa0, (bf16x8){l0[0], l0[1], l0[2], l0[3], h0[0], h0[1], h0[2], h0[3]}, o[d0], 0, 0, 0);   \
        o[d0] = __builtin_amdgcn_mfma_f32_32x32x16_bf16(pa1, (bf16x8){l1[0], l1[1], l1[2], l1[3], h1[0], h1[1], h1[2], h1[3]}, o[d0], 0, 0, 0);   \
        o[d0] = __builtin_amdgcn_mfma_f32_32x32x16_bf16(pa2, (bf16x8){l2[0], l2[1], l2[2], l2[3], h2[0], h2[1], h2[2], h2[3]}, o[d0], 0, 0, 0);   \
        o[d0] = __builtin_amdgcn_mfma_f32_32x32x16_bf16(pa3, (bf16x8){l3[0], l3[1], l3[2], l3[3], h3[0], h3[1], h3[2], h3[3]}, o[d0], 0, 0, 0); } while (0)
    PV_D0(0); PV_D0(1); PV_D0(2); PV_D0(3);
#undef PV_D0
#undef TRRD
}
struct BlockRef { const unsigned short* Q; const unsigned short* K; const unsigned short* V; const unsigned* M; const unsigned short* YA; const unsigned short* SG; unsigned short* OUT; int P0; const float* QG; const float* CW; };
struct Seam { bf16x8 qr[8]; bf16x8 st_v0, st_v1, st_k0, st_k1; };
#define ROWKV(p, k0, rr) ((p) + (size_t)((k0) + (rr)) * KVS + sc)
#define VMW() asm volatile("s_waitcnt vmcnt(0)" ::: "memory")
#define VMWN(n) asm volatile("s_waitcnt vmcnt(%0)" :: "i"(n) : "memory")
#define SLOAD_H(Kp, Vp, k0) do { S.st_v0 = load8(ROWKV(Vp, k0, sr)); S.st_v1 = load8(ROWKV(Vp, k0, 32 + sr)); S.st_k0 = load8(ROWKV(Kp, k0, sr)); S.st_k1 = load8(ROWKV(Kp, k0, 32 + sr)); } while (0)
#define SWRITE_HK(bf) do { *(bf16x8*)(K_lds + (bf) * SHM_K + kws) = S.st_k0; *(bf16x8*)(K_lds + (bf) * SHM_K + kws + 32 * 256) = S.st_k1; } while (0)
#define SWRITE_HV(bf) do { *(bf16x8*)(V_lds + (bf) * SHM_V + vst0) = S.st_v0; *(bf16x8*)(V_lds + (bf) * SHM_V + vst1) = S.st_v1; } while (0)
#define SWRITE_H(bf) do { SWRITE_HV(bf); SWRITE_HK(bf); } while (0)
__device__ __forceinline__ void qnorm(bf16x8 (&qr)[8], const float* qg, float pos, int hi) {
    float ss = 0.f;
#pragma unroll
    for (int d0 = 0; d0 < 8; ++d0) { const u32x4 w = *reinterpret_cast<const u32x4*>(&qr[d0]);
#pragma unroll
        for (int k = 0; k < 4; ++k) { const float lo = __uint_as_float(w[k] << 16), hf = __uint_as_float(w[k] & 0xffff0000u); ss += lo * lo + hf * hf; } }
    { auto rr = __builtin_amdgcn_permlane32_swap(__float_as_uint(ss), __float_as_uint(ss), false, false); ss = __uint_as_float(rr[0]) + __uint_as_float(rr[1]); }
    const float rstd = rsqrtf(ss * (1.f / 128.f) + EPS);
    float x1[8], x2[8];
#pragma unroll
    for (int d0 = 0; d0 < 8; ++d0) { const u32x4 w = *reinterpret_cast<const u32x4*>(&qr[d0]); const f32x4 g0 = *(const f32x4*)(qg + d0 * 16 + hi * 8), g1 = *(const f32x4*)(qg + d0 * 16 + hi * 8 + 4);
        float v[8];
#pragma unroll
        for (int k = 0; k < 4; ++k) { v[2 * k] = __uint_as_float(w[k] << 16); v[2 * k + 1] = __uint_as_float(w[k] & 0xffff0000u); }
#pragma unroll
        for (int j = 0; j < 4; ++j) { v[j] = v[j] * rstd * g0[j]; v[4 + j] = v[4 + j] * rstd * g1[j]; }
        if (d0 == 0) {
#pragma unroll
            for (int j = 0; j < 8; ++j) x1[j] = v[j];
        } else if (d0 == 1) {
#pragma unroll
            for (int j = 0; j < 8; ++j) { x2[j] = v[j]; float c, sn; rope_cs(pos, hi * 8 + j, 1.f / 16.f, c, sn); const float a = x1[j] * c - x2[j] * sn, b = x2[j] * c + x1[j] * sn; x1[j] = a; v[j] = b; }
            u32x4 o0; o0[0] = cvtpk(x1[0], x1[1]); o0[1] = cvtpk(x1[2], x1[3]); o0[2] = cvtpk(x1[4], x1[5]); o0[3] = cvtpk(x1[6], x1[7]); qr[0] = *reinterpret_cast<bf16x8*>(&o0);
        }
        if (d0 >= 1) { u32x4 o; o[0] = cvtpk(v[0], v[1]); o[1] = cvtpk(v[2], v[3]); o[2] = cvtpk(v[4], v[5]); o[3] = cvtpk(v[6], v[7]); qr[d0] = *reinterpret_cast<bf16x8*>(&o); } }
}
__device__ __forceinline__ void prime(const BlockRef& cur, char* lds, Seam& S, const int wid) {
    const int lane = hw_lane(), tid = wid * 64 + lane, r32 = lane & 31, hi = lane >> 5;
    const int sr = tid >> 4, sc = (tid & 15) * 8, kws = KSWZ(sr, sc * 2); char* K_lds = lds + 2 * SHM_V;
#pragma unroll
    for (int d0 = 0; d0 < 8; ++d0) S.qr[d0] = load8(cur.Q + (size_t)(wid * QBLK + r32) * QS + d0 * 16 + hi * 8);
    SLOAD_H(cur.K, cur.V, 0); VMW(); SWRITE_HK(0);
    __syncthreads();
}
__device__ __forceinline__ void block(const BlockRef& cur, const BlockRef& nxt, char* lds, Seam& S, const int wid) {
    const int lane = hw_lane(), tid = wid * 64 + lane, r32 = lane & 31, hi = lane >> 5;
    const int NT = (cur.P0 + QB) / KVBLK;
    char* V_lds = lds; char* K_lds = lds + 2 * SHM_V;
    float* ws = (float*)(lds + 2 * SHM_V + 2 * SHM_K) + wid * 64; float* li_l = ws, * al_l = ws + 32;
    { int hiq = hi; asm volatile("" : "+v"(hiq));
      qnorm(S.qr, cur.QG, (float)(cur.P0 + wid * QBLK + r32), hiq); }
    float m_reg = -1e30f, l_reg = 0; f32x16 o[4] = {};
    const int sr = tid >> 4, sc = (tid & 15) * 8, vst0 = v_st(sr, sc), vst1 = v_st(32 + sr, sc), kws = KSWZ(sr, sc * 2);
    const int vb0 = (int)(uintptr_t)V_lds + v_rd_base(lane);
    const unsigned short* Kh = cur.K; const unsigned short* Vh = cur.V;
    char* mlds = lds + OST_OFF + wid * OST_WAVE;
    u32x4 mrow_[8];
#pragma unroll
    for (int i = 0; i < 8; ++i) mrow_[i] = *(const u32x4*)(cur.M + (size_t)(wid * QBLK) * 64 + (size_t)(i * 64 + lane) * 4);
#define RESC(a) do { if (__any((a) < 1.f)) { if (hi == 0) al_l[r32] = (a); asm volatile("s_waitcnt lgkmcnt(0)" ::: "memory");              \
                     for (int d_ = 0; d_ < 4; ++d_) for (int r = 0; r < 16; ++r) o[d_][r] *= al_l[crow(r, hi)]; } } while (0)
#define KBASE(t) ((t) * KVBLK)
#define MLOAD(t) ({ u32x2 w_ = *(const u32x2*)(mlds + (lane & 31) * 272 + (t) * 8); w_.x >>= 4 * (lane >> 5); w_.y >>= 4 * (lane >> 5); w_; })
#define SEAM_K0() do { VMWN(8); SWRITE_HK(0); SBAR(); } while (0)
    f32x16 pA0, pA1, pB0, pB1; float mnA, mnB, alA, alB; bf16x8 pa0, pa1, pa2, pa3; u32x2 mw;
    SWRITE_HV(0); SBAR();
    if (NT > 1) { SLOAD_H(Kh, Vh, KBASE(1)); }
    SBAR(); qkt<0>(pA0, pA1, K_lds, r32, hi, S.qr);
    partialSM(pA0, pA1, m_reg, mnA, alA);
    if (NT > 1) { VMW(); SWRITE_H(1); }
#pragma unroll
    for (int i = 0; i < 8; ++i) *(u32x4*)(mlds + (i * 4 + (lane >> 4)) * 272 + (lane & 15) * 16) = mrow_[i];
    __syncthreads();
#define HALF_STEP(PX0, PX1, mnX, alX, PY0, PY1, alY, t, KB, VB, SB) do {                                              \
        mw = MLOAD((t) - 1);                                                                                                  \
        SBAR(); qkt<KB>(PX0, PX1, K_lds, r32, hi, S.qr);                                                                     \
        finishSM(PY0, PY1, mw, alY, l_reg, pa0, pa1, pa2, pa3); SBAR();                                                       \
        if ((t) + 1 < NT) { SLOAD_H(Kh, Vh, KBASE((t) + 1)); SBAR(); }                                                        \
        pv_tile<VB>(o, vb0, pa0, pa1, pa2, pa3); partialSM(PX0, PX1, m_reg, mnX, alX);                                        \
        __syncthreads();                                                                                                      \
        if ((t) + 1 < NT) { VMW(); SWRITE_H(SB); }                                                                            \
        RESC(alX); __syncthreads(); } while (0)
    for (int t = 1; t + 1 < NT; t += 2) {
        HALF_STEP(pB0, pB1, mnB, alB, pA0, pA1, alA, t, 1, 0, 0);
        HALF_STEP(pA0, pA1, mnA, alA, pB0, pB1, alB, t + 1, 0, 1, 1);
    }
    mw = MLOAD(NT - 2);
    SBAR(); qkt<1>(pB0, pB1, K_lds, r32, hi, S.qr); SBAR();
    SLOAD_H(nxt.K, nxt.V, 0); SBAR();
#pragma unroll
    for (int d0 = 0; d0 < 8; ++d0) S.qr[d0] = load8(nxt.Q + (size_t)(wid * QBLK + r32) * QS + d0 * 16 + hi * 8);
    SBAR();
    finishSM(pA0, pA1, mw, alA, l_reg, pa0, pa1, pa2, pa3); SBAR();
    mw = MLOAD(NT - 1);
    pv_tile<0>(o, vb0, pa0, pa1, pa2, pa3);
    partialSM(pB0, pB1, m_reg, mnB, alB); __syncthreads(); RESC(alB);
    finishSM(pB0, pB1, mw, alB, l_reg, pa0, pa1, pa2, pa3); SBAR(); pv_tile<1>(o, vb0, pa0, pa1, pa2, pa3);
    SBAR(); SEAM_K0();
    if (hi == 0) li_l[r32] = l_reg; asm volatile("s_waitcnt lgkmcnt(0)" ::: "memory");
    { int sbo = OST_OFF + wid * OST_WAVE + 4 * hi * OST_PITCH + r32 * 2; asm volatile("" : "+v"(sbo));
      char* sb = lds + sbo; const float* lih = li_l + 4 * hi;
#pragma unroll
      for (int r = 0; r < 16; ++r) { constexpr int dummy = 0; const int ro = (r & 3) + 8 * (r >> 2); const float rl = __builtin_amdgcn_rcpf(lih[ro]);
#pragma unroll
          for (int d0 = 0; d0 < 4; ++d0) { const unsigned pk = cvtpk(o[d0][r] * rl, 0.f); *(unsigned short*)(sb + ro * OST_PITCH + d0 * 64) = (unsigned short)pk; } }
      asm volatile("s_waitcnt lgkmcnt(0)" ::: "memory");
      int rdo = OST_OFF + wid * OST_WAVE + (lane >> 4) * OST_PITCH + (lane & 15) * 16; asm volatile("" : "+v"(rdo));
      unsigned goff = (unsigned)((wid * QBLK + (lane >> 4)) * QS + (lane & 15) * 8) * 2u; asm volatile("" : "+v"(goff));
      constexpr unsigned UOFF = 32u << 20;
      f32x4 cw[6];
#pragma unroll
      for (int r = 0; r < 3; ++r) { cw[2 * r] = *(const f32x4*)(cur.CW + r * 1024 + (lane & 15) * 8); cw[2 * r + 1] = *(const f32x4*)(cur.CW + r * 1024 + (lane & 15) * 8 + 4); }
      const int srow = cur.P0 + wid * QBLK + (lane >> 4);
#pragma unroll
      for (int hb = 0; hb < 2; ++hb) {
          u32x4 yav[4], sgv[4], u0v[4], u1v[4], u2v[4];
#pragma unroll
          for (int k = 0; k < 4; ++k) { const unsigned off = goff + (hb * 4 + k) * 4 * QS * 2;
              yav[k] = *(const u32x4*)((const char*)cur.YA + off); sgv[k] = *(const u32x4*)((const char*)cur.SG + off);
              u0v[k] = *(const u32x4*)((const char*)cur.YA + UOFF + off); u1v[k] = *(const u32x4*)((const char*)cur.YA + UOFF + off - QS * 2); u2v[k] = *(const u32x4*)((const char*)cur.YA + UOFF + off - 2 * QS * 2); }
          SBAR();
#pragma unroll
          for (int k = 0; k < 4; ++k) { const int i = hb * 4 + k, sp = srow + 4 * i;
              const u32x4 ov = *(const u32x4*)(lds + rdo + i * 4 * OST_PITCH);
              const u32x4 ya = yav[k], sg = sgv[k], a0 = u0v[k]; u32x4 a1 = u1v[k], a2 = u2v[k]; u32x4 res;
              if (sp < 1) a1 = (u32x4){0u, 0u, 0u, 0u};
              if (sp < 2) a2 = (u32x4){0u, 0u, 0u, 0u};
#define LO(w_) __uint_as_float((w_) << 16)
#define HI(w_) __uint_as_float((w_) & 0xffff0000u)
#define MG(kk, W0, W1, W2, i0, i1) res.kk = cvtpk(LO(ya.kk) * (W0[i0] * LO(a2.kk) + W1[i0] * LO(a1.kk) + W2[i0] * LO(a0.kk)) + LO(sg.kk) * LO(ov.kk), HI(ya.kk) * (W0[i1] * HI(a2.kk) + W1[i1] * HI(a1.kk) + W2[i1] * HI(a0.kk)) + HI(sg.kk) * HI(ov.kk))
              MG(x, cw[0], cw[2], cw[4], 0, 1); MG(y, cw[0], cw[2], cw[4], 2, 3); MG(z, cw[1], cw[3], cw[5], 0, 1); MG(w, cw[1], cw[3], cw[5], 2, 3);
#undef MG
#undef LO
#undef HI
              *(u32x4*)((char*)cur.OUT + goff + i * 4 * QS * 2) = res; } } }
    __syncthreads();
#undef RESC
#undef KBASE
#undef MLOAD
#undef SEAM_K0
#undef HALF_STEP
}
#undef ROWKV
#undef VMW
#undef VMWN
#undef SLOAD_H
#undef SWRITE_HK
#undef SWRITE_HV
#undef SWRITE_H
#undef KSWZ
#undef SBAR
}
__device__ __forceinline__ att::BlockRef attn_ref(const Ctx& F, int bh, int qb) {
    const int b = bh >> 3, h = bh & 7; const size_t tok0 = (size_t)b * SEQ + (size_t)qb * 256;
    att::BlockRef r;
    r.Q = F.Q + tok0 * 1024 + h * 128; r.K = F.K + (size_t)b * SEQ * 256 + (h >> 2) * 128; r.V = F.V + (size_t)b * SEQ * 256 + (h >> 2) * 128;
    r.M = F.MASK + tok0 * 64; r.YA = F.P1 + tok0 * 1024 + h * 128; r.SG = F.SGB + tok0 * 1024 + h * 128; r.OUT = F.XN + tok0 * 1024 + h * 128; r.P0 = qb * 256; r.QG = F.qg; r.CW = F.conv_w + h * 128;
    return r;
}
__device__ __forceinline__ void attn_decode(int l, int& bh, int& q0, int& q1) { const int xcd = l & 7, k = l >> 3, gi = k >> 4, r = k & 15, g = gi * 8 + xcd; bh = (g >> 1) * 8 + (g & 1) * 4 + (r >> 2); q0 = r & 3; q1 = 7 - q0; }
__device__ __forceinline__ void phase_attn(Ctx& F) {
    constexpr int NITEMS = 256;
    att::Seam S;
    int L = F.bid; if (L >= NITEMS) return;
    int bh, q0, q1; attn_decode(L, bh, q0, q1); int pass = 0;
    att::BlockRef cur = attn_ref(F, bh, q0);
    att::prime(cur, (char*)F.lds, S, F.wave);
    for (;;) {
        const bool more_pass = pass == 0, more_item = L + F.G < NITEMS, last = !more_pass && !more_item;
        int bhn = bh, q0n = q0, q1n = q1, passn = pass + 1, Ln = L;
        if (!more_pass) { passn = 0; Ln = more_item ? L + F.G : L; attn_decode(Ln, bhn, q0n, q1n); }
        const att::BlockRef nxt = last ? cur : attn_ref(F, bhn, passn ? q1n : q0n);
        att::block(cur, nxt, (char*)F.lds, S, F.wave);
        if (last) break;
        cur = nxt; bh = bhn; q0 = q0n; q1 = q1n; pass = passn; L = Ln;
    }
}

template <int NV, int MODE> __device__ __forceinline__ void top16(float (&v)[NV], int lane, float& outv, int& outi) {
    outv = 0.f; outi = 0;
    for (int r = 0; r < 16; ++r) {
        float m = v[0];
#pragma unroll
        for (int k = 1; k < NV; ++k) m = fmaxf(m, v[k]);
        const float M = wave_max(m);
        int ci = 0x7fffffff;
#pragma unroll
        for (int k = NV - 1; k >= 0; --k) if (v[k] == M) ci = MODE ? NV * lane + k : lane + 64 * k;
        const int I = wave_mini(ci);
#pragma unroll
        for (int k = 0; k < NV; ++k) if ((MODE ? NV * lane + k : lane + 64 * k) == I) v[k] = -__builtin_inff();
        if (lane == r) { outv = M; outi = I; }
    }
}
__device__ __forceinline__ void phase_route_simple(Ctx& F) {
    float* qf = (float*)F.lds; const int lane = hw_lane(), h = F.wave;
    for (int t = F.bid; t < T; t += F.G) {
        { const v2u qq = *(const v2u*)(F.PQ + (size_t)t * 2048 + h * 256 + 4 * lane); float* q = qf + h * 256 + 4 * lane; q[0] = bflo(qq.x); q[1] = bfhi(qq.x); q[2] = bflo(qq.y); q[3] = bfhi(qq.y); }
        __syncthreads();
        float s1[2], s2[2];
#pragma unroll 1
        for (int hf = 0; hf < 2; ++hf) { const bf16* kb = (hf ? F.K2 : F.K1) + (size_t)h * 128 * 128;
#pragma unroll 1
            for (int r = 0; r < 2; ++r) { const v4u* kr = (const v4u*)(kb + (size_t)(lane + 64 * r) * 128); float d = 0.f;
#pragma unroll
                for (int c = 0; c < 16; ++c) { const v4u w = kr[c]; const float* q = qf + h * 256 + hf * 128 + 8 * c;
                    d += q[0] * bflo(w.x) + q[1] * bfhi(w.x) + q[2] * bflo(w.y) + q[3] * bfhi(w.y) + q[4] * bflo(w.z) + q[5] * bfhi(w.z) + q[6] * bflo(w.w) + q[7] * bfhi(w.w); }
                if (hf) s2[r] = d; else s1[r] = d; } }
        float v1, v2; int i1, i2;
        top16<2, 0>(s1, lane, v1, i1); top16<2, 0>(s2, lane, v2, i2);
        float cand[4]; const float a = __shfl(v1, lane >> 2);
#pragma unroll
        for (int k = 0; k < 4; ++k) cand[k] = a + __shfl(v2, (lane & 3) * 4 + k);
        float ts; int pos; top16<4, 1>(cand, lane, ts, pos);
        const int e1 = __shfl(i1, (pos >> 4) & 15), e2 = __shfl(i2, pos & 15);
        const float m0 = __shfl(ts, 0); const float ex = (lane < 16) ? __expf(ts - m0) : 0.f; const float sum = wave_sum(ex);
        if (lane < 16) { F.EIDX[(size_t)t * 128 + h * 16 + lane] = e1 * 128 + e2; F.GATE[(size_t)t * 128 + h * 16 + lane] = ex / sum; }
        __syncthreads();
    }
}

namespace rt {
typedef short bf16x8 __attribute__((ext_vector_type(8)));
typedef float f32x16 __attribute__((ext_vector_type(16)));
__device__ __forceinline__ unsigned skey(float f) { const unsigned u = __float_as_uint(f); return u ^ ((unsigned)((int)u >> 31) | 0x80000000u); }
__device__ __forceinline__ float unkey(unsigned k) { return __uint_as_float((k & 0x80000000u) ? (k ^ 0x80000000u) : ~k); }
__device__ __forceinline__ void ce(unsigned& a, unsigned& b) { unsigned mx, mn; asm("v_max_f32 %0, %2, %3\n\tv_min_f32 %1, %2, %3" : "=&v"(mx), "=&v"(mn) : "v"(a), "v"(b)); a = mx; b = mn; }
__device__ __forceinline__ unsigned fmaxk(unsigned a, unsigned b) { unsigned r; asm("v_max_f32 %0, %1, %2" : "=v"(r) : "v"(a), "v"(b)); return r; }
template <int N> __device__ __forceinline__ void sort_desc(unsigned* a) {
#pragma unroll
    for (int k = 2; k <= N; k <<= 1)
#pragma unroll
        for (int j = k >> 1; j > 0; j >>= 1)
#pragma unroll
            for (int i = 0; i < N; ++i) { const int l = i ^ j; if (l > i) { if ((i & k) == 0) ce(a[i], a[l]); else ce(a[l], a[i]); } }
}
__device__ __forceinline__ void merge_bitonic16(unsigned* a) {
#pragma unroll
    for (int j = 8; j > 0; j >>= 1)
#pragma unroll
        for (int i = 0; i < 16; ++i) { const int l = i ^ j; if (l > i) ce(a[i], a[l]); }
}
template <bool SORT> __device__ __forceinline__ void top16_merge(unsigned* a, const unsigned* b) {
#pragma unroll
    for (int i = 0; i < 16; ++i) a[i] = fmaxk(a[i], b[15 - i]);
    if (SORT) merge_bitonic16(a);
}
template <bool SORT> __device__ __forceinline__ void pair_merge(unsigned* a) {
    unsigned lo[16], hi[16];
#pragma unroll
    for (int i = 0; i < 16; ++i) { auto rr = __builtin_amdgcn_permlane32_swap(a[i], a[i], false, false); lo[i] = rr[0]; hi[i] = rr[1]; }
    top16_merge<SORT>(lo, hi);
#pragma unroll
    for (int i = 0; i < 16; ++i) a[i] = lo[i];
}
}
__device__ __forceinline__ void phase_route(Ctx& F) {
    const int lane = hw_lane(), r32 = lane & 31, hi = lane >> 5;
    float* lv = (float*)(F.lds + F.wave * 8192);
    int* li = (int*)(F.lds + F.wave * 8192 + 4096);
    constexpr int KOFF = 65536, KPITCH = 272, KHALF = 128 * KPITCH;
    const bool staged = (F.G & 7) == 0;
    if (staged) { const int head = F.bid & 7;
        for (int c = (F.wave * 64 + hw_lane()); c < 2 * 128 * 16; c += NTHR) { const int hf = c >> 11, row = (c >> 4) & 127, ch = c & 15;
            *(v4u*)(F.lds + KOFF + hf * KHALF + row * KPITCH + ch * 16) = *(const v4u*)((hf ? F.K2 : F.K1) + (size_t)head * 128 * 128 + row * 128 + ch * 8); }
        __syncthreads(); }
    if (F.late_jobs && F.wave < 4) tables_job<true, false>(F, (size_t)F.bid * NTHR + (F.wave * 64 + hw_lane()), (size_t)F.G * NTHR);
    for (int tau = F.bid * NWAVES + F.wave; tau < 4096; tau += F.G * NWAVES) {
        const int head = (tau >> 3) & 7, tg = (tau & 7) | ((tau >> 6) << 3);
        const size_t token = (size_t)tg * 32 + r32;
        const bf16* qb = F.PQ + ((size_t)tg * 8 + head) * (16 * 512) + (32 * hi + r32) * 8;
        rt::bf16x8 bqa[16];
#pragma unroll
        for (int s = 0; s < 16; ++s) bqa[s] = *(const rt::bf16x8*)(qb + 512 * s);
#pragma unroll 1
        for (int half = 0; half < 2; ++half) {
            const bf16* kb = (half ? F.K2 : F.K1) + (size_t)head * 128 * 128 + (size_t)r32 * 128 + 8 * hi;
            const unsigned char* kl = F.lds + KOFF + half * KHALF + r32 * KPITCH + 16 * hi;
            rt::f32x16 acc[4] = {};
#pragma unroll
            for (int s = 0; s < 8; ++s) { const rt::bf16x8 bq = half ? bqa[8 + s] : bqa[s];
#pragma unroll
                for (int tl = 0; tl < 4; ++tl) { const rt::bf16x8 ak = staged ? *(const rt::bf16x8*)(kl + tl * 32 * KPITCH + 32 * s) : *(const rt::bf16x8*)(kb + (size_t)tl * 32 * 128 + 16 * s);
                    acc[tl] = __builtin_amdgcn_mfma_f32_32x32x16_bf16(ak, bq, acc[tl], 0, 0, 0); } }
            unsigned key[64];
#pragma unroll
            for (int tl = 0; tl < 4; ++tl)
#pragma unroll
                for (int r = 0; r < 16; ++r) { const int idx0 = tl * 32 + (r & 3) + 8 * (r >> 2);
                    key[tl * 16 + r] = (__float_as_uint(acc[tl][r]) & ~127u) | (unsigned)(127 - idx0 - 4 * hi); }
            rt::sort_desc<16>(key); rt::sort_desc<16>(key + 16); rt::sort_desc<16>(key + 32); rt::sort_desc<16>(key + 48);
            rt::top16_merge<true>(key, key + 16); rt::top16_merge<true>(key + 32, key + 48); rt::top16_merge<true>(key, key + 32);
            rt::pair_merge<true>(key);
            if (hi == half) {
#pragma unroll
                for (int i = 0; i < 16; ++i) { lv[(r32 * 2 + half) * 16 + i] = __uint_as_float(key[i] & ~127u); li[(r32 * 2 + half) * 16 + i] = 127 - (int)(key[i] & 127u); } }
        }
        LDS_WAIT(); asm volatile("" ::: "memory");
        float A[16], B[16];
        { const float* pa = lv + (r32 * 2 + hi) * 16; const float* pb = lv + (r32 * 2 + (hi ^ 1)) * 16;
#pragma unroll
          for (int i = 0; i < 16; ++i) { A[i] = pa[i]; B[i] = pb[i]; } }
        unsigned ck[32]; int nc = 0;
#pragma unroll
        for (int i = 0; i < 4; ++i)
#pragma unroll
            for (int j = i; j < 16; ++j) if ((i + 1) * (j + 1) <= 16) {
                const unsigned code = hi ? (unsigned)(255 - (j * 16 + i)) : (unsigned)(255 - (i * 16 + j));
                unsigned k = (__float_as_uint(A[i] + B[j]) & ~255u) | code; if (i == j && hi) k = 0xff800000u; ck[nc++] = k; }
#pragma unroll
        for (int i = nc; i < 32; ++i) ck[i] = 0xff800000u;
        rt::sort_desc<16>(ck); rt::sort_desc<16>(ck + 16); rt::top16_merge<true>(ck, ck + 16);
        rt::pair_merge<false>(ck);
        float sv[16]; int ev[16]; float mx = -__builtin_inff();
#pragma unroll
        for (int i = 0; i < 16; ++i) { const int code = 255 - (int)(ck[i] & 255u), r1 = code >> 4, r2 = code & 15;
            sv[i] = lv[(r32 * 2) * 16 + r1] + lv[(r32 * 2 + 1) * 16 + r2]; ev[i] = li[(r32 * 2) * 16 + r1] * 128 + li[(r32 * 2 + 1) * 16 + r2]; mx = fmaxf(mx, sv[i]); }
        float sum = 0.f;
#pragma unroll
        for (int i = 0; i < 16; ++i) { sv[i] = __expf(sv[i] - mx); sum += sv[i]; }
        const float inv = 1.f / sum; const size_t ob = token * 128 + head * 16;
        if (hi == 0) {
#pragma unroll
            for (int i = 0; i < 4; ++i) *(int4*)(F.EIDX + ob + 4 * i) = make_int4(ev[4 * i], ev[4 * i + 1], ev[4 * i + 2], ev[4 * i + 3]);
        } else {
#pragma unroll
            for (int i = 0; i < 4; ++i) *(f32x4*)(F.GATE + ob + 4 * i) = (f32x4){sv[4 * i] * inv, sv[4 * i + 1] * inv, sv[4 * i + 2] * inv, sv[4 * i + 3] * inv};
        }
        LDS_WAIT(); asm volatile("" ::: "memory");
    }
}

__device__ __forceinline__ float gelu_exact(float v) {
    const float av = fabsf(v), t = __builtin_amdgcn_rcpf(av * 0.2316418882f + 1.0f);
    float q = t * 0.5307027145f + (-0.7265760135f); q = q * t + 0.7107068705f; q = q * t + (-0.142248368f); q = q * t + 0.127414796f; q = q * t;
    const float e = __builtin_amdgcn_exp2f((v * v) * (-0.72134752044f)), m = v * (q * e);
    return v < 0.f ? m : v - m;
}
typedef float f32x2v __attribute__((ext_vector_type(2)));
#define DEC16(W_, f) do { f32x2v t_; t_ = __builtin_amdgcn_cvt_pk_f32_fp8((int)(W_).x, false); f[0] = t_.x; f[1] = t_.y; t_ = __builtin_amdgcn_cvt_pk_f32_fp8((int)(W_).x, true); f[2] = t_.x; f[3] = t_.y; \
    t_ = __builtin_amdgcn_cvt_pk_f32_fp8((int)(W_).y, false); f[4] = t_.x; f[5] = t_.y; t_ = __builtin_amdgcn_cvt_pk_f32_fp8((int)(W_).y, true); f[6] = t_.x; f[7] = t_.y; \
    t_ = __builtin_amdgcn_cvt_pk_f32_fp8((int)(W_).z, false); f[8] = t_.x; f[9] = t_.y; t_ = __builtin_amdgcn_cvt_pk_f32_fp8((int)(W_).z, true); f[10] = t_.x; f[11] = t_.y; \
    t_ = __builtin_amdgcn_cvt_pk_f32_fp8((int)(W_).w, false); f[12] = t_.x; f[13] = t_.y; t_ = __builtin_amdgcn_cvt_pk_f32_fp8((int)(W_).w, true); f[14] = t_.x; f[15] = t_.y; } while (0)
__device__ __forceinline__ void ald16(v4u& d, unsigned off, const void* base) { asm volatile("global_load_dwordx4 %0, %1, %2" : "=&v"(d) : "v"(off), "s"(base) : "memory"); }
__device__ __forceinline__ void ald2(unsigned& d, unsigned off, const void* base) { asm volatile("global_load_ushort %0, %1, %2" : "=&v"(d) : "v"(off), "s"(base) : "memory"); }
__device__ __forceinline__ void ald8(v2u& d, unsigned off, const void* base) { asm volatile("global_load_dwordx2 %0, %1, %2" : "=&v"(d) : "v"(off), "s"(base) : "memory"); }
__device__ __forceinline__ void ald4(unsigned& d, unsigned off, const void* base) { asm volatile("global_load_dword %0, %1, %2" : "=&v"(d) : "v"(off), "s"(base) : "memory"); }
#define AWAIT(N) asm volatile("s_waitcnt vmcnt(" #N ")" ::: "memory")
__device__ __forceinline__ unsigned amov(unsigned s) { unsigned d; asm volatile("v_mov_b32 %0, %1" : "=v"(d) : "v"(s)); return d; }
__device__ __forceinline__ v4u amov4(const v4u& s) { v4u d; asm volatile("v_mov_b32 %0, %4\n\tv_mov_b32 %1, %5\n\tv_mov_b32 %2, %6\n\tv_mov_b32 %3, %7" : "=&v"(d.x), "=&v"(d.y), "=&v"(d.z), "=&v"(d.w) : "v"(s.x), "v"(s.y), "v"(s.z), "v"(s.w)); return d; }
__device__ __forceinline__ void adec16(const v4u& w, float (&f)[16]) {
    f32x2v a, b, c, d, e, g, h, i;
    asm volatile("v_cvt_pk_f32_fp8_e32 %0, %8\n\tv_cvt_pk_f32_fp8_sdwa %1, %8 src0_sel:WORD_1\n\tv_cvt_pk_f32_fp8_e32 %2, %9\n\tv_cvt_pk_f32_fp8_sdwa %3, %9 src0_sel:WORD_1\n\t"
                 "v_cvt_pk_f32_fp8_e32 %4, %10\n\tv_cvt_pk_f32_fp8_sdwa %5, %10 src0_sel:WORD_1\n\tv_cvt_pk_f32_fp8_e32 %6, %11\n\tv_cvt_pk_f32_fp8_sdwa %7, %11 src0_sel:WORD_1"
                 : "=&v"(a), "=&v"(b), "=&v"(c), "=&v"(d), "=&v"(e), "=&v"(g), "=&v"(h), "=&v"(i) : "v"(w.x), "v"(w.y), "v"(w.z), "v"(w.w));
    f[0] = a.x; f[1] = a.y; f[2] = b.x; f[3] = b.y; f[4] = c.x; f[5] = c.y; f[6] = d.x; f[7] = d.y; f[8] = e.x; f[9] = e.y; f[10] = g.x; f[11] = g.y; f[12] = h.x; f[13] = h.y; f[14] = i.x; f[15] = i.y;
}
__device__ __forceinline__ void adec16p(const v4u& w, f32x2v (&f)[8]) {
    asm volatile("v_cvt_pk_f32_fp8_e32 %0, %8\n\tv_cvt_pk_f32_fp8_sdwa %1, %8 src0_sel:WORD_1\n\tv_cvt_pk_f32_fp8_e32 %2, %9\n\tv_cvt_pk_f32_fp8_sdwa %3, %9 src0_sel:WORD_1\n\t"
                 "v_cvt_pk_f32_fp8_e32 %4, %10\n\tv_cvt_pk_f32_fp8_sdwa %5, %10 src0_sel:WORD_1\n\tv_cvt_pk_f32_fp8_e32 %6, %11\n\tv_cvt_pk_f32_fp8_sdwa %7, %11 src0_sel:WORD_1"
                 : "=&v"(f[0]), "=&v"(f[1]), "=&v"(f[2]), "=&v"(f[3]), "=&v"(f[4]), "=&v"(f[5]), "=&v"(f[6]), "=&v"(f[7]) : "v"(w.x), "v"(w.y), "v"(w.z), "v"(w.w));
}
#define GROWS(TBL, EV, XW) do { _Pragma("unroll") for (int i = 0; i < 8; ++i) { const unsigned e_ = (unsigned)__shfl((int)(EV), 8 * i + rg); ald16(XW[i], e_ * 128u + toff, TBL); } } while (0)
__device__ __forceinline__ void phase_gather_dots(Ctx& F) {
    typedef int v8i __attribute__((ext_vector_type(8)));
    const int lane = hw_lane(), c4 = F.cls & 3, par = F.cls >> 2, cw = F.crank * NWAVES + F.wave, ncw = F.cnb * NWAVES;
    const int jj = lane & 15, g = lane >> 4, sub = lane & 7, rg = lane >> 3;
    const unsigned hoff = (unsigned)(256 * c4 + 16 * g) * 2u, toff = (unsigned)c4 * (16384u * 128u) + 16u * (unsigned)sub;
    const void* U4 = F.UB; const void* EI = F.EIDX; const void* HN = HB_OF(F); const void* RS = RSTD_OF(F);
    const unsigned wbase = (unsigned)(size_t)(LAS unsigned char*)F.lds + (unsigned)F.wave * 16384u;
    const unsigned wofs0 = wbase + (unsigned)rg * 128u + 16u * (unsigned)(sub ^ (rg >> 1)), wofs1 = wbase + (unsigned)rg * 128u + 16u * (unsigned)(sub ^ (4 + (rg >> 1)));
    LAS unsigned char* rp0 = (LAS unsigned char*)F.lds + F.wave * 16384 + jj * 128 + 16 * (g ^ (jj >> 1));
    LAS unsigned char* rp1 = (LAS unsigned char*)F.lds + F.wave * 16384 + jj * 128 + 16 * ((4 + g) ^ (jj >> 1));
    if (cw >= T / 2) return;
    int u = cw;
    struct Raw { unsigned e0, e1, rs; v4u h0, h1, h2, h3, h4, h5, h6, h7; };
#define G1_OPS(uu, Q) do { const unsigned tt_ = 2u * (unsigned)(uu) + (unsigned)par, eo_ = (tt_ * 128u + (unsigned)lane) * 4u, ho_ = tt_ * 2048u + hoff; \
        ald4(Q.e0, eo_, EI); ald4(Q.e1, eo_ + 256u, EI); ald4(Q.rs, tt_ * 4u, RS); ald16(Q.h0, ho_, HN); ald16(Q.h1, ho_ + 16u, HN); ald16(Q.h2, ho_ + 128u, HN); ald16(Q.h3, ho_ + 144u, HN); \
        ald16(Q.h4, ho_ + 256u, HN); ald16(Q.h5, ho_ + 272u, HN); ald16(Q.h6, ho_ + 384u, HN); ald16(Q.h7, ho_ + 400u, HN); } while (0)
#define G1_F8(W, R_) ({ int p_ = 0; p_ = __builtin_amdgcn_cvt_pk_fp8_f32(bflo(W.x) * R_, bfhi(W.x) * R_, p_, false); p_ = __builtin_amdgcn_cvt_pk_fp8_f32(bflo(W.y) * R_, bfhi(W.y) * R_, p_, true); p_; })
#define G1_F8B(W, R_) ({ int p_ = 0; p_ = __builtin_amdgcn_cvt_pk_fp8_f32(bflo(W.z) * R_, bfhi(W.z) * R_, p_, false); p_ = __builtin_amdgcn_cvt_pk_fp8_f32(bflo(W.w) * R_, bfhi(W.w) * R_, p_, true); p_; })
#define G1_L2(HQ, H8, B_) do { const v4u w_ = amov4(HQ); H8[B_] = G1_F8(w_, rs_); H8[B_ + 1] = G1_F8B(w_, rs_); } while (0)
#define G1_LAND(Q, E0, E1, H8) do { E0 = amov(Q.e0); E1 = amov(Q.e1); const float rs_ = __uint_as_float(amov(Q.rs)); \
        G1_L2(Q.h0, H8, 0); G1_L2(Q.h1, H8, 2); G1_L2(Q.h2, H8, 4); G1_L2(Q.h3, H8, 6); G1_L2(Q.h4, H8, 8); G1_L2(Q.h5, H8, 10); G1_L2(Q.h6, H8, 12); G1_L2(Q.h7, H8, 14); } while (0)
#define G1_ROWS(EV, XW) do { _Pragma("unroll") for (int i = 0; i < 8; ++i) { const unsigned e_ = (unsigned)__shfl((int)(EV), 8 * i + rg); ald16(XW[i], e_ * 128u + toff, U4); } } while (0)
#define G1_STAGE(XW, HF) do { _Pragma("unroll") for (int i = 0; i < 8; ++i) asm volatile("ds_write_b128 %0, %1 offset:%2" :: "v"((i & 1) ? wofs1 : wofs0), "v"(XW[i]), "i"((HF) * 8192 + i * 1024) : "memory"); } while (0)
#define G1_MMA(HF, H8, D_) do { const v8i ha0_ = {H8[0], H8[1], H8[2], H8[3], H8[4], H8[5], H8[6], H8[7]}, ha1_ = {H8[8], H8[9], H8[10], H8[11], H8[12], H8[13], H8[14], H8[15]}; \
        _Pragma("unroll") for (int m = 0; m < 4; ++m) { const v4u b0_ = *(const LAS v4u*)(rp0 + (HF) * 8192 + m * 2048), b1_ = *(const LAS v4u*)(rp1 + (HF) * 8192 + m * 2048); \
            const v8i ub0_ = {(int)b0_.x, (int)b0_.y, (int)b0_.z, (int)b0_.w, 0, 0, 0, 0}, ub1_ = {(int)b1_.x, (int)b1_.y, (int)b1_.z, (int)b1_.w, 0, 0, 0, 0}; \
            f32x4 c_ = __builtin_amdgcn_mfma_scale_f32_16x16x128_f8f6f4(ha0_, ub0_, (f32x4){0.f, 0.f, 0.f, 0.f}, 0, 4, 0, 0x7F7F7F7F, 0, 0x7F7F7F7F); \
            c_ = __builtin_amdgcn_mfma_scale_f32_16x16x128_f8f6f4(ha1_, ub1_, c_, 0, 4, 0, 0x7F7F7F7F, 0, 0x7F7F7F7F); D_[m] = c_[0]; } } while (0)
    Raw raw; v4u xa[8], xb[8];
    unsigned ea, eb; int h8[16];
    const float mk0 = (g == 0) ? 1.f / U4_SCALE : 0.f, mk1 = (g == 1) ? 1.f / U4_SCALE : 0.f, mk2 = (g == 2) ? 1.f / U4_SCALE : 0.f, mk3 = (g == 3) ? 1.f / U4_SCALE : 0.f;
    G1_OPS(u, raw);
    AWAIT(0);
    G1_LAND(raw, ea, eb, h8);
    G1_ROWS(ea, xa);
    { const int u1 = (u + ncw < T / 2) ? u + ncw : u; G1_OPS(u1, raw); }
    for (;;) {
        const int un = u + ncw; const bool more = un < T / 2;
        float d[4];
        G1_ROWS(eb, xb);
        AWAIT(19);
        G1_STAGE(xa, 0);
        __builtin_amdgcn_sched_barrier(0);
        G1_MMA(0, h8, d);
        float s0 = d[0] * mk0 + d[2] * mk1, s1 = d[1] * mk0 + d[3] * mk1;
        asm volatile("" : "+v"(s0), "+v"(s1));
        __builtin_amdgcn_sched_barrier(0);
        AWAIT(8);
        unsigned nea, neb; int nh8[16];
        G1_LAND(raw, nea, neb, nh8);
        G1_ROWS(nea, xa);
        { const int u2 = (un + ncw < T / 2) ? un + ncw : u; G1_OPS(u2, raw); }
        AWAIT(19);
        G1_STAGE(xb, 1);
        __builtin_amdgcn_sched_barrier(0);
        G1_MMA(1, h8, d);
        s0 += d[0] * mk2 + d[2] * mk3; s1 += d[1] * mk2 + d[3] * mk3;
        { bf16* pd_ = (bf16*)F.PD + ((size_t)(2 * u + par) * 128 + 32 * g + jj) * 4 + c4; pd_[0] = (bf16)f2bf(s0); pd_[64] = (bf16)f2bf(s1); }
        __builtin_amdgcn_sched_barrier(0);
        if (!more) break;
        u = un; eb = neb;
#pragma unroll
        for (int q = 0; q < 16; ++q) h8[q] = nh8[q];
    }
    AWAIT(0);
#undef G1_OPS
#undef G1_F8
#undef G1_F8B
#undef G1_L2
#undef G1_LAND
#undef G1_ROWS
#undef G1_STAGE
#undef G1_MMA
}
__device__ __forceinline__ void phase_gather_axpy(Ctx& F) {
    typedef int v8i __attribute__((ext_vector_type(8)));
    const int lane = hw_lane(), c4 = F.cls & 3, par = F.cls >> 2, cw = F.crank * NWAVES + F.wave, ncw = F.cnb * NWAVES;
    const int sub = lane & 7, rg = lane >> 3, jj = lane & 15, g = lane >> 4;
    const unsigned toff = (unsigned)c4 * (16384u * 128u) + 16u * (unsigned)sub;
    const void* V4 = F.VB; const void* EI = F.EIDX; const void* GT = F.GATE; const void* PDp = F.PD; const void* OUTp = F.out; const void* H1p = HB_OF(F);
    const unsigned wbase = (unsigned)(size_t)(LAS unsigned char*)F.lds + (unsigned)F.wave * 16384u;
    const unsigned wofs0 = wbase + (unsigned)rg * 128u + 16u * (unsigned)(sub ^ (rg >> 1)), wofs1 = wbase + (unsigned)rg * 128u + 16u * (unsigned)(sub ^ (4 + (rg >> 1)));
    const unsigned wtab = (unsigned)(size_t)(LAS unsigned char*)F.lds + 131072u + (unsigned)F.wave * 128u;
    unsigned rc[8];
#pragma unroll
    for (int c = 0; c < 8; ++c) rc[c] = wbase + (unsigned)(32 * g + jj) * 128u + 16u * (unsigned)(c ^ (jj >> 1));
    const unsigned ocol4 = (unsigned)(256 * c4 + 4 * lane);
    const unsigned xofs = (unsigned)(size_t)(LAS unsigned char*)F.lds + 132096u + (unsigned)F.wave * 1024u;
    const float mk0 = (g == 0) ? 1.f : 0.f, mk1 = (g == 1) ? 1.f : 0.f, mk2 = (g == 2) ? 1.f : 0.f, mk3 = (g == 3) ? 1.f : 0.f;
    if (cw >= T / 2) return;
    int u = cw;
    struct Ops { unsigned e0, e1, g0, g1; v2u p0, p1, o; };
#define G2_OPS(uu, Q) do { const unsigned tt_ = 2u * (unsigned)(uu) + (unsigned)par, eo_ = (tt_ * 128u + (unsigned)lane) * 4u, po_ = (tt_ * 128u + (unsigned)lane) * 8u, oo_ = (tt_ * 1024u + ocol4) * 2u; \
        ald4(Q.e0, eo_, EI); ald4(Q.e1, eo_ + 256u, EI); ald4(Q.g0, eo_, GT); ald4(Q.g1, eo_ + 256u, GT); ald8(Q.p0, po_, PDp); ald8(Q.p1, po_ + 512u, PDp); \
        ald8(Q.o, oo_, H1p); } while (0)
#define G2_LAND(Q, E0, E1, WA, WB, O0, O1, O2, O3) do { E0 = amov(Q.e0); E1 = amov(Q.e1); const unsigned g0_ = amov(Q.g0), g1_ = amov(Q.g1); v2u a_, b_; a_.x = amov(Q.p0.x); a_.y = amov(Q.p0.y); b_.x = amov(Q.p1.x); b_.y = amov(Q.p1.y); \
        { const unsigned ox_ = amov(Q.o.x), oy_ = amov(Q.o.y); O0 = __uint_as_float(ox_ << 16); O1 = __uint_as_float(ox_ & 0xffff0000u); O2 = __uint_as_float(oy_ << 16); O3 = __uint_as_float(oy_ & 0xffff0000u); } WA = G2_W(g0_, a_); WB = G2_W(g1_, b_); } while (0)
#define G2_W(G, P) (__uint_as_float(G) * gelu_exact((bflo(P.x) + bfhi(P.x)) + (bflo(P.y) + bfhi(P.y))) * W8_SCALE)
#define G2_STAGE(XW, HF) do { _Pragma("unroll") for (int i = 0; i < 8; ++i) asm volatile("ds_write_b128 %0, %1 offset:%2" :: "v"((i & 1) ? wofs1 : wofs0), "v"(XW[i]), "i"((HF) * 8192 + i * 1024) : "memory"); } while (0)
#define G2_TR(dst, addr, off) asm volatile("ds_read_b64_tr_b4 %0, %1 offset:%2" : "=&v"(dst) : "v"(addr), "i"(off) : "memory")
    constexpr float W8_SCALE = 64.f;
    Ops raw; v4u xa[8], xb[8];
    unsigned ea, eb; float wa, wb, o0, o1, o2, o3;
    G2_OPS(u, raw);
    AWAIT(0);
    G2_LAND(raw, ea, eb, wa, wb, o0, o1, o2, o3);
    GROWS(V4, ea, xa); GROWS(V4, eb, xb);
    { const int u1 = (u + ncw < T / 2) ? u + ncw : u; G2_OPS(u1, raw); }
    for (;;) {
        const int un = u + ncw; const bool more = un < T / 2;
        AWAIT(15);
        G2_STAGE(xa, 0);
        AWAIT(7);
        G2_STAGE(xb, 1);
        { const unsigned w8 = (unsigned)__builtin_amdgcn_cvt_pk_fp8_f32(wa, wb, 0, false);
          asm volatile("ds_write_b8 %0, %1\n\tds_write_b8_d16_hi %0, %2 offset:64" :: "v"(wtab + (unsigned)lane), "v"(w8), "v"(w8 << 8) : "memory"); }
        LDS_WAIT();
        AWAIT(0);
        unsigned nea, neb; float nwa, nwb, no0, no1, no2, no3;
        G2_LAND(raw, nea, neb, nwa, nwb, no0, no1, no2, no3);
        GROWS(V4, nea, xa); GROWS(V4, neb, xb);
        { const int u2 = (un + ncw < T / 2) ? un + ncw : u; G2_OPS(u2, raw); }
        const v4u wlo = *(const LAS v4u*)((LAS unsigned char*)F.lds + 131072 + F.wave * 128 + 16 * g), whi = *(const LAS v4u*)((LAS unsigned char*)F.lds + 131072 + F.wave * 128 + 64 + 16 * g);
        const v8i wa8 = {(int)wlo.x, (int)wlo.y, (int)wlo.z, (int)wlo.w, (int)whi.x, (int)whi.y, (int)whi.z, (int)whi.w};
        float r0 = 0.f, r1 = 0.f, r2 = 0.f, r3 = 0.f;
#pragma unroll
        for (int gq = 0; gq < 4; ++gq) {
            v2u bl[4], bh[4];
#pragma unroll
            for (int j = 0; j < 4; ++j) { const int m = 4 * gq + j; G2_TR(bl[j], rc[m >> 1], 8 * (m & 1)); G2_TR(bh[j], rc[m >> 1], 8 * (m & 1) + 2048); }
            asm volatile("s_waitcnt lgkmcnt(0)" ::: "memory"); __builtin_amdgcn_sched_barrier(0);
            float d[4];
#pragma unroll
            for (int j = 0; j < 4; ++j) { const v8i vb = {(int)bl[j].x, (int)bl[j].y, (int)bh[j].x, (int)bh[j].y, 0, 0, 0, 0};
                const f32x4 c_ = __builtin_amdgcn_mfma_scale_f32_16x16x128_f8f6f4(wa8, vb, (f32x4){0.f, 0.f, 0.f, 0.f}, 0, 4, 0, 0x7F7F7F7F, 0, 0x7F7F7F7F); d[j] = c_[0]; }
            const float mk = (gq == 0) ? mk0 : (gq == 1) ? mk1 : (gq == 2) ? mk2 : mk3;
            r0 += d[0] * mk; r1 += d[1] * mk; r2 += d[2] * mk; r3 += d[3] * mk;
            asm volatile("" : "+v"(r0), "+v"(r1), "+v"(r2), "+v"(r3));
            __builtin_amdgcn_sched_barrier(0);
        }
        { constexpr float SC = 1.f / (V4_SCALE * W8_SCALE); const unsigned oo_ = ((2u * (unsigned)u + (unsigned)par) * 1024u + ocol4) * 4u;
          LAS float* xw_ = (LAS float*)(size_t)0 + ((xofs >> 2) + 64 * g + jj); xw_[0] = r0; xw_[16] = r1; xw_[32] = r2; xw_[48] = r3;
          const f32x4 rr = *(const LAS f32x4*)((LAS float*)(size_t)0 + ((xofs >> 2) + 4 * lane));
          v4u st; st.x = __float_as_uint(o0 + rr[0] * SC); st.y = __float_as_uint(o1 + rr[1] * SC); st.z = __float_as_uint(o2 + rr[2] * SC); st.w = __float_as_uint(o3 + rr[3] * SC);
          asm volatile("global_store_dwordx4 %0, %1, %2\n\ts_nop 3" :: "v"(oo_), "v"(st), "s"(OUTp) : "memory"); }
        if (!more) break;
        u = un; wa = nwa; wb = nwb; o0 = no0; o1 = no1; o2 = no2; o3 = no3;
    }
    AWAIT(0);
#undef G2_OPS
#undef G2_LAND
#undef G2_W
#undef G2_STAGE
#undef G2_TR
}
#undef GROWS

#define XB_TMO      128
#define XB_XCNT(j)  (256  + 64 * (j))
#define XB_XSUB(j)  (1280 + 64 * (j))
#define XB_XGEN(j)  (2304 + 64 * (j))
#define XB_TOP      3328
#define XB_TOPGEN   3392
#define XCD_BAR_WORDS 3456
#define XB_SPIN_CAP (1u << 18)

__device__ __forceinline__ unsigned xb_ld(unsigned* p)              { return __hip_atomic_load(p, __ATOMIC_RELAXED, __HIP_MEMORY_SCOPE_AGENT); }
__device__ __forceinline__ unsigned xb_add(unsigned* p, unsigned v) { return __hip_atomic_fetch_add(p, v, __ATOMIC_RELAXED, __HIP_MEMORY_SCOPE_AGENT); }
__device__ __forceinline__ unsigned xb_xcc_id() { return (unsigned)__builtin_amdgcn_s_getreg((3 << 11) | 20) & 0xFu; }
#define XB_SPIN(cond, bar) do { unsigned _sp = 0; while (cond) { __builtin_amdgcn_s_sleep(1); \
    if ((++_sp & 255u) == 0u) { if (xb_ld(&(bar)[XB_TMO])) break; if (_sp > XB_SPIN_CAP) { atomicAdd(&(bar)[XB_TMO], 1u); break; } } } } while (0)

struct XcdBarrier {
    unsigned* bar; unsigned x; int wave;
    volatile LAS unsigned* st;
};

__device__ __forceinline__ XcdBarrier xcd_barrier_post(unsigned* bar, volatile LAS unsigned* st, int wave) {
    XcdBarrier b; b.bar = bar; b.x = xb_xcc_id(); b.st = st; b.wave = wave;
    if (b.wave == 0 && hw_lane() == 0) (void)xb_add(&bar[XB_XCNT(b.x)], 1u);
    return b;
}
__device__ __forceinline__ void xcd_barrier_complete(unsigned* bar, unsigned x, unsigned& nloc, unsigned& nx) {
    const unsigned G = gridDim.x * gridDim.y * gridDim.z;
    unsigned sum, cnt, mine, sp = 0u;
    for (;;) {
        sum = 0u; cnt = 0u; mine = 0u;
#pragma unroll
        for (unsigned j = 0; j < 16; ++j) { const unsigned c = xb_ld(&bar[XB_XCNT(j)]); sum += c; cnt += (c > 0u) ? 1u : 0u; mine = (j == x) ? c : mine; }
        if (sum == G) break;
        __builtin_amdgcn_s_sleep(1);
        if ((++sp & 255u) == 0u) { if (xb_ld(&bar[XB_TMO])) break; if (sp > XB_SPIN_CAP) { atomicAdd(&bar[XB_TMO], 1u); break; } }
    }
    nloc = mine > 0u ? mine : 1u; nx = cnt > 0u ? cnt : 1u;
}

__device__ __forceinline__ void xcd_barrier(const XcdBarrier& b) {
    asm volatile("s_waitcnt vmcnt(0)" ::: "memory");
    __syncthreads();
    if (b.wave == 0 && hw_lane() == 0) {
        unsigned* bar = b.bar;
        __builtin_amdgcn_s_waitcnt(0);
        unsigned nloc = b.st[0], nx = b.st[1];
        if (nloc == 0u) { xcd_barrier_complete(bar, b.x, nloc, nx); b.st[0] = nloc; b.st[1] = nx; }
        const unsigned old = xb_add(&bar[XB_XSUB(b.x)], 1u);
        const unsigned gen = old / nloc;
        if (old + 1u == (gen + 1u) * nloc) {
            __builtin_amdgcn_fence(__ATOMIC_RELEASE, "agent");
            asm volatile("s_waitcnt vmcnt(0)" ::: "memory");
            const unsigned og = xb_add(&bar[XB_TOP], 1u);
            const unsigned tg = og / nx;
            if (og + 1u == (tg + 1u) * nx) xb_add(&bar[XB_TOPGEN], 1u);
            else XB_SPIN(xb_ld(&bar[XB_TOPGEN]) == tg, bar);
            __builtin_amdgcn_fence(__ATOMIC_ACQUIRE, "agent");
            xb_add(&bar[XB_XGEN(b.x)], 1u);
            asm volatile("s_waitcnt vmcnt(0)" ::: "memory");
        } else {
            XB_SPIN(xb_ld(&bar[XB_XGEN(b.x)]) == gen, bar);
            __builtin_amdgcn_fence(__ATOMIC_ACQUIRE, "agent");
            asm volatile("s_waitcnt vmcnt(0)" ::: "memory");
        }
    }
    __syncthreads();
}

constexpr int NPHASE = 11;
__global__ void __launch_bounds__(NTHR, 2) mk_fwd(Args args) {
    extern __shared__ __attribute__((aligned(16))) unsigned char lds[];
    Ctx F;
    F.lds = lds; F.wave = __builtin_amdgcn_readfirstlane((int)threadIdx.x >> 6); F.G = gridDim.x; F.bid = blockIdx.x;
    F.x = args.in[0]; F.g1 = args.in[1]; F.w_in = args.in[2]; F.conv_w = args.in[3]; F.qg = args.in[4]; F.kg = args.in[5]; F.w_o = args.in[6]; F.g2 = args.in[7];
    F.pwq = args.in[8]; F.pk1 = args.in[9]; F.pk2 = args.in[10]; F.pu = args.in[11]; F.pv = args.in[12]; F.out = args.out;
    unsigned char* ws = args.ws;
    F.WIN = (bf16*)(ws + WS_WIN); F.WO = (bf16*)(ws + WS_WO); F.WQ = (bf16*)(ws + WS_WQ); F.K1 = (bf16*)(ws + WS_K1); F.K2 = (bf16*)(ws + WS_K2);
    F.UB = (bf16*)(ws + WS_UB); F.VB = (bf16*)(ws + WS_VB); F.XN = (bf16*)(ws + WS_XN); F.P1 = (bf16*)(ws + WS_P1); F.U = (bf16*)(ws + WS_U);
    F.Q = (bf16*)(ws + WS_Q); F.K = (bf16*)(ws + WS_K); F.V = (bf16*)(ws + WS_V); F.QI = (bf16*)(ws + WS_QI); F.KI = (bf16*)(ws + WS_KI);
    F.SGB = (bf16*)args.out; F.PQ = (bf16*)(ws + WS_PQ); F.WI = (float*)(ws + WS_WI); F.GATE = (float*)(ws + WS_GATE); F.MASK = (unsigned*)(ws + WS_MASK); F.EIDX = (int*)(ws + WS_EIDX); F.PD = (float*)(ws + WS_PQ);
    volatile LAS unsigned* MISC = (volatile LAS unsigned*)((LAS unsigned char*)lds + MISC_OFF);
    if ((F.wave * 64 + hw_lane()) < 64) MISC[(F.wave * 64 + hw_lane())] = 0u;
    __syncthreads();
    XcdBarrier xbar = xcd_barrier_post((unsigned*)(ws + WS_CTL) + CW_BAR, MISC + 8, F.wave);
    if ((F.wave * 64 + hw_lane()) == 0) MISC[16] = xb_add((unsigned*)(ws + WS_CTL) + CW_RANK + 64 * xbar.x, 1u);
    F.cls = F.bid & 7; F.crank = F.bid >> 3; F.cnb = (F.G - F.cls + 7) >> 3;
    const int lo = args.ph_lo, hi = args.ph_hi;
    F.late_jobs = (lo == 0 && hi == NPHASE);
#define IN(k) (lo <= (k) && (k) < hi)
#define SEAM(k) do { if (IN(k) && IN((k) + 1)) { if (hi > NPHASE) cg::this_grid().sync();   else xcd_barrier(xbar); } } while (0)
    PG8_LAS unsigned char* lds3 = (PG8_LAS unsigned char*)lds;
    if (IN(0)) { phase_prologue(F); } SEAM(0);
    if (IN(1)) { pg8::Gemm g{F.XN, F.WIN, T, NPROJ, D}; pg8::StaticOrder S; S.init(T, NPROJ, F.G, F.bid);
        pg8::EpiProj E{F.U, F.P1, F.Q, F.K, F.V, F.QI, F.SGB};
        pg8::gemm_phase<pg8::EpiProj, pg8::StaticOrder, true, true>(lds3, g, S, E, F.wave);
        phase_ki(F); } SEAM(1);
    if (IN(2) && IN(3)) { const int gw_ = F.bid * NWAVES + F.wave, NGW_ = F.G * NWAVES; const size_t gt_ = (size_t)F.bid * NTHR + (F.wave * 64 + hw_lane()), NGT_ = (size_t)F.G * NTHR;
        float* scr_ = (float*)(F.lds + 16384 + F.wave * 8704);
        if (F.wave < 4) { phase_post(F); if (F.late_jobs) { late_weights_job(F, scr_, gw_, NGW_, gt_, NGT_); } }
        phase_indexer(F);
        if (F.wave >= 4) { phase_post(F); if (F.late_jobs) { late_weights_job(F, scr_, gw_, NGW_, gt_, NGT_); } } }
    else { if (IN(2)) phase_post(F); if (IN(3)) phase_indexer_simple(F); }
    SEAM(3);
    if (IN(4)) { phase_attn(F); } SEAM(4);
    if (IN(5)) { pg8::Gemm g{F.XN, F.WO, T, D, D}; pg8::StaticOrder S; S.init(T, D, F.G, F.bid);
        pg8::EpiResNorm E{F.x, HB_OF(F), SSQ_OF(F), D};
        pg8::gemm_phase<pg8::EpiResNorm, pg8::StaticOrder, true, true>(lds3, g, S, E, F.wave); } SEAM(5);
    if (IN(7)) { pg8::Gemm g{HB_OF(F), F.WQ, T, 2048, D}; pg8::StaticOrder S; S.init(T, 2048, F.G, F.bid);
        pg8::Unit u0, u1, u2; const bool h0 = S.next(0, u0), h1 = S.next(1, u1), h2 = S.next(2, u2); const bool use_tab = h0 && !h2;
        PG8_LAS float* rtab = (PG8_LAS float*)(lds3 + 140288);
        if (use_tab) { const int slot = (F.wave * 64 + hw_lane()) >> 8, rr = (F.wave * 64 + hw_lane()) & 255; const int upm = slot ? u1.pm : u0.pm, upn = slot ? u1.pn : u0.pn;
            if (slot == 0 || h1) { const int row = upm * 256 + rr; const f32x4* sp = (const f32x4*)(SSQ_OF(F) + (size_t)row * 16); const f32x4 s4 = (sp[0] + sp[1]) + (sp[2] + sp[3]);
                const float r = __builtin_amdgcn_rsqf(((s4[0] + s4[1]) + (s4[2] + s4[3])) * (1.f / 1024.f) + 1e-6f); rtab[slot * 256 + rr] = r; if (upn == 0) RSTD_OF(F)[row] = r; }
            __syncthreads(); }
        pg8::EpiBf16Scale E{F.PQ, 2048, SSQ_OF(F), RSTD_OF(F), rtab, u0.pm, u0.pn, use_tab};
        pg8::gemm_phase<pg8::EpiBf16Scale, pg8::StaticOrder, true, true>(lds3, g, S, E, F.wave); } SEAM(7);
    if (IN(8)) { const size_t gt_ = (size_t)F.bid * NTHR + (F.wave * 64 + hw_lane()), NGT_ = (size_t)F.G * NTHR;
        phase_route(F);
        if (F.late_jobs && F.wave >= 4) tables_job<true, false>(F, gt_, NGT_); } SEAM(8);
    if (IN(9) || IN(10)) {
        unsigned* bw = (unsigned*)(ws + WS_CTL) + CW_BAR; bool ok = (lo == 0);
        for (int j = 0; j < 16; ++j) { const unsigned c = xb_ld(&bw[XB_XCNT(j)]); ok = ok && ((j < 8) ? (c > 0u) : (c == 0u)); }
        if (ok) { F.cls = (int)xbar.x; F.crank = (int)MISC[16]; F.cnb = (int)xb_ld(&bw[XB_XCNT(xbar.x)]); }
    }
    if (IN(9)) { const size_t gt_ = (size_t)F.bid * NTHR + (F.wave * 64 + hw_lane()), NGT_ = (size_t)F.G * NTHR;
        if (F.late_jobs && F.wave < 4) tables_job<false, true>(F, gt_, NGT_);
        phase_gather_dots(F);
        if (F.late_jobs && F.wave >= 4) tables_job<false, true>(F, gt_, NGT_); } SEAM(9);
    if (IN(10)) { phase_gather_axpy(F); }
#undef IN
#undef SEAM
}

#ifndef MK_ONE_LAUNCH
#define MK_ONE_LAUNCH 1
#endif
extern "C" void kernel_launch(void* const* d_in, const int* in_sizes, int n_in, void* d_out, int out_size, void* d_ws, size_t ws_size, hipStream_t stream) {
    static int grid = 0;
    if (grid == 0) {
        if (n_in != 13 || in_sizes[0] != T * D || out_size != T * D || ws_size < WS_END) { fprintf(stderr, "kernel_launch: unexpected shapes (n_in %d, in0 %d, out %d, ws %zu); nothing launched\n", n_in, n_in > 0 ? in_sizes[0] : -1, out_size, ws_size); grid = -1; return; }
        int dev = 0, cus = 0, per_cu = 0;
        if (hipGetDevice(&dev) != hipSuccess || hipDeviceGetAttribute(&cus, hipDeviceAttributeMultiprocessorCount, dev) != hipSuccess) { fprintf(stderr, "kernel_launch: device query failed\n"); grid = -1; return; }
        if (hipFuncSetAttribute((const void*)mk_fwd, hipFuncAttributeMaxDynamicSharedMemorySize, LDS_BYTES) != hipSuccess) { fprintf(stderr, "kernel_launch: hipFuncSetAttribute failed\n"); grid = -1; return; }
        if (hipOccupancyMaxActiveBlocksPerMultiprocessor(&per_cu, (const void*)mk_fwd, NTHR, LDS_BYTES) != hipSuccess || per_cu < 1) { fprintf(stderr, "kernel_launch: occupancy query says %d blocks per CU\n", per_cu); per_cu = 1; }
        (void)hipGetLastError();
        grid = cus * (per_cu < 1 ? 1 : 1);
    }
    if (grid < 0) return;
    if (hipMemsetAsync((char*)d_ws + WS_CTL, 0, CTL_ZERO_BYTES, stream) != hipSuccess) { fprintf(stderr, "kernel_launch: memset of control words failed\n"); return; }
    Args a{};
    for (int i = 0; i < 13; ++i) a.in[i] = (const float*)d_in[i];
    a.out = (float*)d_out; a.ws = (unsigned char*)d_ws;
#if MK_ONE_LAUNCH
    a.ph_lo = 0; a.ph_hi = NPHASE;
    void* kargs[] = {&a};
    hipError_t e = hipLaunchCooperativeKernel((const void*)mk_fwd, dim3(grid), dim3(NTHR), kargs, LDS_BYTES, stream);
    if (e != hipSuccess) fprintf(stderr, "kernel_launch: cooperative launch failed: %s (grid %d)\n", hipGetErrorString(e), grid);
#else
    for (int p = 0; p < NPHASE; ++p) { a.ph_lo = p; a.ph_hi = p + 1; hipLaunchKernelGGL(mk_fwd, dim3(grid), dim3(NTHR), LDS_BYTES, stream, a); }
#endif
}
```
